# Optimizing an MI355X kernel written in HIP

```python
import jax, jax.numpy as jnp
from jax import lax
import numpy as np

D_MODEL = 1024
BATCH = 4
SEQ = 8192
DEPTH = 4

GRID_W = 64
CTX_LEN = 256
N_EVEN = (DEPTH + 1) // 2
N_ODD = DEPTH // 2
RWKV_WIDTH = D_MODEL // 2
HEAD_DIM = 64
RWKV_HEADS = RWKV_WIDTH // HEAD_DIM
R_DECAY = 64
R_LR = 64
R_GATE = 128
GN_EPS = 64e-5
POOL_WIDTH = D_MODEL // 2
POOL_WINDOWS = (2, 4, 8, 16)
POOL_GROUP = POOL_WIDTH // len(POOL_WINDOWS)
IN_WIDTH = 3 * RWKV_WIDTH + POOL_WIDTH
MIX_WIDTH = RWKV_WIDTH + POOL_WIDTH
FOURIER_GROUPS = 4
MOE_GROUPS = 4
EXPERTS_PER_GROUP = 8
N_EXPERTS = MOE_GROUPS * EXPERTS_PER_GROUP
TOP_K = 2
D_EXPERT = 512
MOE_BLOCK = 128
NORM_EPS = 1e-6

kernel_name = "hybrid_rwkv7_pool_fnet_hmoe_dit"


def rms_norm(x, g):
    xf = x.astype(jnp.float32)
    y = xf * lax.rsqrt(jnp.mean(xf * xf, axis=-1, keepdims=True) + NORM_EPS)
    return y.astype(x.dtype) * g


def modulate(x, g, shift, scale):
    return rms_norm(x, g) * (1 + scale) + shift


def grid_shift(x):
    B, T, C = x.shape
    rows = T // GRID_W
    g = x.reshape(B, rows, GRID_W, 4, C // 4)
    zc = jnp.zeros_like(g[:, :, :1, 0])
    zr = jnp.zeros_like(g[:, :1, :, 2])
    left = jnp.concatenate([zc, g[:, :, :-1, 0]], axis=2)
    right = jnp.concatenate([g[:, :, 1:, 1], zc], axis=2)
    up = jnp.concatenate([zr, g[:, :-1, :, 2]], axis=1)
    down = jnp.concatenate([g[:, 1:, :, 3], zr], axis=1)
    return jnp.stack([left, right, up, down], axis=3).reshape(B, T, C)


def seq_shift(x):
    B, T, C = x.shape
    x2 = x.reshape(B, T, 2, C // 2)
    z = jnp.zeros_like(x2[:, :1, 0])
    prev = jnp.concatenate([z, x2[:, :-1, 0]], axis=1)
    nxt = jnp.concatenate([x2[:, 1:, 1], z], axis=1)
    return jnp.stack([prev, nxt], axis=2).reshape(B, T, C)


def to_heads(x):
    return x.reshape(*x.shape[:-1], RWKV_HEADS, HEAD_DIM).astype(jnp.float32)


def wkv_scan(r, w, k, v, a, b, s0, reverse):
    def step(s, inp):
        r_t, w_t, k_t, v_t, a_t, b_t = inp
        sa = jnp.einsum('bhvk,bhk->bhv', s, a_t)
        s = s * w_t[:, :, None, :] + sa[..., None] * b_t[:, :, None, :] + v_t[..., None] * k_t[:, :, None, :]
        return s, jnp.einsum('bhvk,bhk->bhv', s, r_t)
    xs = tuple(jnp.moveaxis(t, 1, 0) for t in (r, w, k, v, a, b))
    s_final, ys = lax.scan(step, s0, xs, reverse=reverse)
    return jnp.moveaxis(ys, 0, 1), s_final


def rwkv_mix(h, p_rkv, shift_fn, init_states, need_out,
             mu_x, mu_p, decay_w0, decay_w1, decay_w2, lr_a0, lr_a1, lr_a2,
             gate_g1, gate_g2, k_k, k_a, r_k, gn_w, gn_b):
    B, T, _ = h.shape
    f32 = jnp.float32
    hx = shift_fn(h) - h
    x_w = h + hx * mu_x[0]
    x_a = h + hx * mu_x[1]
    r, k, v = [p + (shift_fn(p) - p) * mu_p[n] for n, p in enumerate(jnp.split(p_rkv, 3, axis=-1))]
    kk = to_heads(k * k_k)
    kk = kk * lax.rsqrt(jnp.maximum(jnp.sum(kk * kk, axis=-1, keepdims=True), 1e-12))
    r_h, v_h, k_h, ka_h = to_heads(r), to_heads(v), to_heads(k), to_heads(k_a)
    if init_states is None:
        z = jnp.zeros((B, RWKV_HEADS, HEAD_DIM, HEAD_DIM), f32)
        init_states = (z, z)
    ys, k_dirs, states = [], [], []
    for d in range(2):
        z_w = (decay_w0[d] + jnp.tanh(x_w @ decay_w1[d]) @ decay_w2[d]).astype(f32)
        decay = jnp.exp(-jnp.exp(-jax.nn.softplus(-z_w) - 0.5))
        a = to_heads(jax.nn.sigmoid(lr_a0[d] + (x_a @ lr_a1[d]) @ lr_a2[d]))
        k_d = k_h * (1 + (a - 1) * ka_h)
        y_d, s_d = wkv_scan(r_h, to_heads(decay), k_d, v_h, -kk, kk * a, init_states[d], reverse=(d == 1))
        ys.append(y_d)
        k_dirs.append(k_d)
        states.append(s_d)
    if not need_out:
        return None, (states[0], states[1])
    y = ys[0] + ys[1]
    mu = jnp.mean(y, axis=-1, keepdims=True)
    var = jnp.mean(jnp.square(y - mu), axis=-1, keepdims=True)
    yn = ((y - mu) * lax.rsqrt(var + GN_EPS)).reshape(B, T, RWKV_WIDTH) * gn_w + gn_b
    bonus = (jnp.sum(r_h * (k_dirs[0] + k_dirs[1]) * r_k, axis=-1, keepdims=True) * v_h).reshape(B, T, RWKV_WIDTH)
    x_g = h + hx * mu_x[2]
    g = jax.nn.sigmoid(x_g @ gate_g1) @ gate_g2
    return (yn + bonus).astype(h.dtype) * g, (states[0], states[1])


def pool_mix(u, pool_w, pool_scale):
    B, T, _ = u.shape
    ug = u.reshape(B, T, len(POOL_WINDOWS), POOL_GROUP).astype(jnp.float32)
    cs = jnp.concatenate([jnp.zeros_like(ug[:, :1]), jnp.cumsum(ug, axis=1)], axis=1)
    pos = jnp.arange(T)
    pooled = []
    for gi, win in enumerate(POOL_WINDOWS):
        half = win // 2
        hi = jnp.minimum(pos + half, T)
        lo = jnp.maximum(pos - half, 0)
        cg = cs[:, :, gi]
        pooled.append((cg[:, hi] - cg[:, lo]) / (hi - lo).astype(jnp.float32)[None, :, None])
    diff = (jnp.stack(pooled, axis=2) - ug).astype(u.dtype)
    y = jnp.einsum('btgc,gcd->btgd', diff, pool_w).reshape(B, T, POOL_WIDTH)
    return y * pool_scale


def even_mixer(h, shift_fn, init_states, need_out, w_in, w_out, pool_w, pool_scale, rwkv_params):
    proj = h @ w_in if need_out else h @ w_in[:, :3 * RWKV_WIDTH]
    y_a, states = rwkv_mix(h, proj[..., :3 * RWKV_WIDTH], shift_fn, init_states, need_out, *rwkv_params)
    if not need_out:
        return None, states
    y_b = pool_mix(proj[..., 3 * RWKV_WIDTH:], pool_w, pool_scale)
    return jnp.concatenate([y_a, y_b], axis=-1) @ w_out, states


def fourier_mix(h, w_f):
    B, T, D = h.shape
    hg = h.reshape(B, T, FOURIER_GROUPS, D // FOURIER_GROUPS).astype(jnp.float32)
    f = jnp.fft.fftn(hg, axes=(1, 3), norm='ortho').real
    return f.reshape(B, T, D).astype(h.dtype) @ w_f


def hier_moe(rows, router_c, router_c_b, router_f, router_f_b, w1, w3, w2):
    n, d = rows.shape
    f32 = jnp.float32
    p_group = jax.nn.softmax((rows @ router_c).astype(f32) + router_c_b, axis=-1)
    g_val, g_idx = lax.top_k(p_group, 1)
    logits_f = ((rows @ router_f).astype(f32) + router_f_b).reshape(n, MOE_GROUPS, EXPERTS_PER_GROUP)
    sel = jnp.broadcast_to(g_idx[:, :, None], (n, 1, EXPERTS_PER_GROUP))
    p_local = jax.nn.softmax(jnp.take_along_axis(logits_f, sel, axis=1)[:, 0], axis=-1)
    e_val, e_loc = lax.top_k(p_local, TOP_K)
    gate = g_val * e_val / jnp.sum(e_val, axis=-1, keepdims=True)
    expert = g_idx * EXPERTS_PER_GROUP + e_loc
    nk = n * TOP_K
    e_flat = expert.reshape(nk)
    order = jnp.argsort(e_flat)
    e_sorted = e_flat[order]
    tok_sorted = jnp.repeat(jnp.arange(n), TOP_K)[order]
    gate_sorted = gate.reshape(nk)[order]
    counts = jnp.bincount(e_flat, length=N_EXPERTS)
    padded = (counts + MOE_BLOCK - 1) // MOE_BLOCK * MOE_BLOCK
    start = jnp.cumsum(counts) - counts
    pend = jnp.cumsum(padded)
    pstart = pend - padded
    dest = pstart[e_sorted] + (jnp.arange(nk) - start[e_sorted])
    n_blocks = -(-nk // MOE_BLOCK) + N_EXPERTS
    buf = jnp.zeros((n_blocks * MOE_BLOCK, d), rows.dtype).at[dest].set(rows[tok_sorted])
    block_e = jnp.minimum(jnp.searchsorted(pend, jnp.arange(n_blocks) * MOE_BLOCK, side='right'), N_EXPERTS - 1)

    def expert_ffn(args):
        xb, e = args
        return (jax.nn.silu(xb @ w1[e]) * (xb @ w3[e])) @ w2[e]

    y_buf = lax.map(expert_ffn, (buf.reshape(n_blocks, MOE_BLOCK, d), block_e)).reshape(n_blocks * MOE_BLOCK, d)
    y = y_buf[dest] * gate_sorted[:, None].astype(rows.dtype)
    return jnp.zeros((n, d), rows.dtype).at[tok_sorted].add(y)


def setup_inputs(seed: int = 0) -> dict:
    key = jax.random.key(seed)
    ks = iter(jax.random.split(key, 64))
    f32 = jnp.float32
    D, DA = D_MODEL, RWKV_WIDTH

    def nrm(shape, scale):
        return jax.random.normal(next(ks), shape, f32) * scale

    def unif(shape):
        return jax.random.uniform(next(ks), shape, f32)

    decay_base = -6.0 + 5.0 * jnp.arange(DA, dtype=f32) / (DA - 1)
    return {
        "x": nrm((BATCH, SEQ, D), 1.0),
        "c": nrm((BATCH, D), 1.0),
        "ctx": nrm((BATCH, CTX_LEN, D), 1.0),
        "c_ctx": nrm((D,), 1.0),
        "ada_w": nrm((DEPTH, D, 6 * D), 0.5 * D ** -0.5),
        "ada_b": nrm((DEPTH, 6 * D), 0.1),
        "norm_mix": 1.0 + nrm((DEPTH, D), 0.05),
        "norm_ffn": 1.0 + nrm((DEPTH, D), 0.05),
        "w_in": nrm((N_EVEN, D, IN_WIDTH), D ** -0.5),
        "mu_x": unif((N_EVEN, 3, D)),
        "mu_p": unif((N_EVEN, 3, DA)),
        "decay_w0": decay_base + nrm((N_EVEN, 2, DA), 0.1),
        "decay_w1": nrm((N_EVEN, 2, D, R_DECAY), D ** -0.5),
        "decay_w2": nrm((N_EVEN, 2, R_DECAY, DA), 0.5 * R_DECAY ** -0.5),
        "lr_a0": nrm((N_EVEN, 2, DA), 0.1),
        "lr_a1": nrm((N_EVEN, 2, D, R_LR), D ** -0.5),
        "lr_a2": nrm((N_EVEN, 2, R_LR, DA), 0.5 * R_LR ** -0.5),
        "gate_g1": nrm((N_EVEN, D, R_GATE), D ** -0.5),
        "gate_g2": nrm((N_EVEN, R_GATE, DA), R_GATE ** -0.5),
        "k_k": 0.85 + nrm((N_EVEN, DA), 0.05),
        "k_a": 1.0 + nrm((N_EVEN, DA), 0.05),
        "r_k": nrm((N_EVEN, RWKV_HEADS, HEAD_DIM), 0.1),
        "gn_w": 1.0 + nrm((N_EVEN, DA), 0.05),
        "gn_b": nrm((N_EVEN, DA), 0.02),
        "pool_w": nrm((N_EVEN, len(POOL_WINDOWS), POOL_GROUP, POOL_GROUP), POOL_GROUP ** -0.5),
        "pool_scale": 1.0 + nrm((N_EVEN, POOL_WIDTH), 0.1),
        "w_out": nrm((N_EVEN, MIX_WIDTH, D), MIX_WIDTH ** -0.5),
        "w_fourier": nrm((N_ODD, D, D), D ** -0.5),
        "router_c": nrm((DEPTH, D, MOE_GROUPS), D ** -0.5),
        "router_c_b": nrm((DEPTH, MOE_GROUPS), 0.01),
        "router_f": nrm((DEPTH, D, N_EXPERTS), D ** -0.5),
        "router_f_b": nrm((DEPTH, N_EXPERTS), 0.01),
        "moe_w1": nrm((DEPTH, N_EXPERTS, D, D_EXPERT), D ** -0.5),
        "moe_w3": nrm((DEPTH, N_EXPERTS, D, D_EXPERT), D ** -0.5),
        "moe_w2": nrm((DEPTH, N_EXPERTS, D_EXPERT, D), D_EXPERT ** -0.5),
        "final_norm": 1.0 + nrm((D,), 0.05),
    }


def reference(x, c, ctx, c_ctx, ada_w, ada_b, norm_mix, norm_ffn, w_in, mu_x, mu_p,
              decay_w0, decay_w1, decay_w2, lr_a0, lr_a1, lr_a2, gate_g1, gate_g2,
              k_k, k_a, r_k, gn_w, gn_b, pool_w, pool_scale, w_out, w_fourier,
              router_c, router_c_b, router_f, router_f_b, moe_w1, moe_w3, moe_w2, final_norm):
    B = x.shape[0]
    D = D_MODEL
    s_lat = jax.nn.silu(c)
    s_ctx = jax.nn.silu(c_ctx)
    last_read = 2 * ((DEPTH - 1) // 2)
    lat, cx = x, ctx
    for i in range(DEPTH):
        ctx_in = i <= last_read
        ctx_out = i < last_read
        m = (s_lat @ ada_w[i] + ada_b[i]).reshape(B, 6, 1, D)
        if ctx_in:
            mc = (s_ctx @ ada_w[i] + ada_b[i]).reshape(6, 1, 1, D)
        h = modulate(lat, norm_mix[i], m[:, 0], m[:, 1])
        j = i // 2
        if i % 2 == 0:
            rw = (mu_x[j], mu_p[j], decay_w0[j], decay_w1[j], decay_w2[j], lr_a0[j], lr_a1[j], lr_a2[j],
                  gate_g1[j], gate_g2[j], k_k[j], k_a[j], r_k[j], gn_w[j], gn_b[j])
            hc = modulate(cx, norm_mix[i], mc[0], mc[1])
            yc, ctx_states = even_mixer(hc, seq_shift, None, ctx_out, w_in[j], w_out[j], pool_w[j], pool_scale[j], rw)
            yl, _ = even_mixer(h, grid_shift, ctx_states, True, w_in[j], w_out[j], pool_w[j], pool_scale[j], rw)
            lat = lat + m[:, 2] * yl
            if ctx_out:
                cx = cx + mc[2] * yc
        else:
            lat = lat + m[:, 2] * fourier_mix(h, w_fourier[j])
            if ctx_out:
                hc = modulate(cx, norm_mix[i], mc[0], mc[1])
                cx = cx + mc[2] * fourier_mix(hc, w_fourier[j])
        h2 = modulate(lat, norm_ffn[i], m[:, 3], m[:, 4])
        moe_p = (router_c[i], router_c_b[i], router_f[i], router_f_b[i], moe_w1[i], moe_w3[i], moe_w2[i])
        if ctx_out:
            hc2 = modulate(cx, norm_ffn[i], mc[3], mc[4])
            n_lat = h2.shape[0] * h2.shape[1]
            y = hier_moe(jnp.concatenate([h2.reshape(-1, D), hc2.reshape(-1, D)], axis=0), *moe_p)
            lat = lat + m[:, 5] * y[:n_lat].reshape(lat.shape)
            cx = cx + mc[5] * y[n_lat:].reshape(cx.shape)
        else:
            lat = lat + m[:, 5] * hier_moe(h2.reshape(-1, D), *moe_p).reshape(lat.shape)
    return rms_norm(lat, final_norm)
```

```cpp
#include <hip/hip_runtime.h>
#include <stdint.h>
#include <stdio.h>

#ifndef DIAG
#define DIAG 0
#endif
#ifndef MEGA
#define MEGA 1
#endif

typedef unsigned short bf16_t;
typedef short bf16x8 __attribute__((ext_vector_type(8)));
typedef short s16x4 __attribute__((ext_vector_type(4)));
typedef float f32x4 __attribute__((ext_vector_type(4)));
typedef unsigned u32x4 __attribute__((ext_vector_type(4)));
typedef unsigned u32x2 __attribute__((ext_vector_type(2)));
#define LAS __attribute__((address_space(3)))

#define NL 32768
#define NCX 1024
#define NT 33792
#define DM 1024
#define TOKCAP NT
#define YM_ROWS 71680

#define MBY(x) ((size_t)(x) << 20)
constexpr size_t OFF_BAR = 0, OFF_CNT = 16384, OFF_ZERO = 16384 + 1024, ZERO_REGION = 32768;
constexpr size_t OFF_POFF = 32768, OFF_MOD = 65536;
constexpr size_t OFF_ROUTEI = MBY(1), OFF_ROUTEG = MBY(1) + 270336, OFF_TOKL = MBY(2);
constexpr size_t OFF_WTS = MBY(8);
constexpr size_t W_WIN = 0, W_WOUT = W_WIN + 8388608, W_WF = W_WOUT + 4194304, W_LR1 = W_WF + 4194304, W_LR2 = W_LR1 + 3145728,
                 W_POOL = W_LR2 + 786432, W_RW = W_POOL + 262144, W_DFTC = W_RW + 3145728, W_TW = W_DFTC + 262144, W_CS128 = W_TW + 4194304,
                 W_CS256 = W_CS128 + 65536, W_END = W_CS256 + 262144;
static_assert(W_END < MBY(32), "weights region");
constexpr size_t OFF_RES = MBY(40), OFF_HREG = MBY(172), OFF_PREG = MBY(238), OFF_LR1 = MBY(378), OFF_RKVK = MBY(403), OFF_DIFF = MBY(535),
                 OFF_WREG = MBY(568), OFF_KD = MBY(700), OFF_BB = MBY(766), OFF_G = MBY(836), WS_END = MBY(869);

struct Params {
    const float *x, *c, *ctx, *c_ctx, *ada_w, *ada_b, *norm_mix, *norm_ffn, *w_in, *mu_x, *mu_p, *decay_w0, *decay_w1, *decay_w2, *lr_a0, *lr_a1, *lr_a2,
        *gate_g1, *gate_g2, *k_k, *k_a, *r_k, *gn_w, *gn_b, *pool_w, *pool_scale, *w_out, *w_fourier, *router_c, *router_c_b, *router_f, *router_f_b,
        *moe_w1, *moe_w3, *moe_w2, *final_norm;
    float* out;
    char* ws;
};

typedef float f32x2_ __attribute__((ext_vector_type(2)));
typedef __bf16 bf16x2_ __attribute__((ext_vector_type(2)));
__device__ __forceinline__ unsigned pk2(float lo, float hi) { const f32x2_ v = {lo, hi}; const bf16x2_ r = __builtin_convertvector(v, bf16x2_); return __builtin_bit_cast(unsigned, r); }
__device__ __forceinline__ bf16_t f2bf(float f) { return (bf16_t)(pk2(f, 0.f) & 0xffffu); }
__device__ __forceinline__ float bf2f(bf16_t h) { return __uint_as_float((unsigned)h << 16); }
__device__ __forceinline__ float bflo(unsigned u) { return __uint_as_float(u << 16); }
__device__ __forceinline__ float bfhi(unsigned u) { return __uint_as_float(u & 0xffff0000u); }
__device__ __forceinline__ float wave_sum(float v) {
#pragma unroll
    for (int o = 1; o < 64; o <<= 1) v += __shfl_xor(v, o);
    return v;
}
__device__ __forceinline__ float sigmoidf_(float x) { return 1.f / (1.f + expf(-x)); }
__device__ __forceinline__ int shift_src(int r, int q) {
    if (r < NL) {
        const int t = r & 8191, col = t & 63, row = t >> 6;
        if (q == 0) return col > 0 ? r - 1 : -1;
        if (q == 1) return col < 63 ? r + 1 : -1;
        if (q == 2) return row > 0 ? r - 64 : -1;
        return row < 127 ? r + 64 : -1;
    } else {
        const int t = (r - NL) & 255;
        if (q < 2) return t > 0 ? r - 1 : -1;
        return t < 255 ? r + 1 : -1;
    }
}

__device__ __forceinline__ int ltid() { int t = threadIdx.x; asm volatile("" : "+v"(t)); return t; }

#define XB_TMO      128
#define XB_XCNT(j)  (256  + 64 * (j))
#define XB_XSUB(j)  (1280 + 64 * (j))
#define XB_XGEN(j)  (2304 + 64 * (j))
#define XB_TOP      3328
#define XB_TOPGEN   3392
#define XCD_BAR_WORDS 3456
#define XB_SPIN_CAP (1u << 22)
__device__ __forceinline__ unsigned xb_ld(unsigned* p)              { return __hip_atomic_load(p, __ATOMIC_RELAXED, __HIP_MEMORY_SCOPE_AGENT); }
__device__ __forceinline__ unsigned xb_add(unsigned* p, unsigned v) { return __hip_atomic_fetch_add(p, v, __ATOMIC_RELAXED, __HIP_MEMORY_SCOPE_AGENT); }
__device__ __forceinline__ unsigned xb_xcc_id() { return (unsigned)__builtin_amdgcn_s_getreg((3 << 11) | 20) & 0xFu; }
#define XB_SPIN(cond, bar) do { unsigned _sp = 0; while (cond) { __builtin_amdgcn_s_sleep(1); \
    if ((++_sp & 255u) == 0u) { if (xb_ld(&(bar)[XB_TMO])) break; if (_sp > XB_SPIN_CAP) { atomicAdd(&(bar)[XB_TMO], 1u); break; } } } } while (0)
struct XcdBarrier { unsigned* bar; unsigned x; volatile LAS unsigned* st; };
__device__ __forceinline__ XcdBarrier xcd_barrier_post(unsigned* bar, volatile LAS unsigned* st) {
    XcdBarrier b; b.bar = bar; b.x = xb_xcc_id(); b.st = st;
    if (threadIdx.x == 0) (void)xb_add(&bar[XB_XCNT(b.x)], 1u);
    return b;
}
__device__ __forceinline__ void xcd_barrier_complete(unsigned* bar, unsigned x, unsigned& nloc, unsigned& nx) {
    const unsigned G = gridDim.x * gridDim.y * gridDim.z;
    unsigned sum, cnt, mine, sp = 0u;
    for (;;) {
        sum = 0u; cnt = 0u; mine = 0u;
#pragma unroll
        for (unsigned j = 0; j < 16; ++j) { const unsigned c = xb_ld(&bar[XB_XCNT(j)]); sum += c; cnt += (c > 0u) ? 1u : 0u; mine = (j == x) ? c : mine; }
        if (sum == G) break;
        __builtin_amdgcn_s_sleep(1);
        if ((++sp & 255u) == 0u) { if (xb_ld(&bar[XB_TMO])) break; if (sp > XB_SPIN_CAP) { atomicAdd(&bar[XB_TMO], 1u); break; } }
    }
    nloc = mine > 0u ? mine : 1u; nx = cnt > 0u ? cnt : 1u;
}
__device__ __forceinline__ void xcd_barrier(const XcdBarrier& b) {
    asm volatile("s_waitcnt vmcnt(0)" ::: "memory");
    __syncthreads();
    if (threadIdx.x == 0) {
        unsigned* bar = b.bar;
        __builtin_amdgcn_s_waitcnt(0);
        unsigned nloc = b.st[0], nx = b.st[1];
        if (nloc == 0u) { xcd_barrier_complete(bar, b.x, nloc, nx); b.st[0] = nloc; b.st[1] = nx; }
        const unsigned old = xb_add(&bar[XB_XSUB(b.x)], 1u);
        const unsigned gen = old / nloc;
        if (old + 1u == (gen + 1u) * nloc) {
            __builtin_amdgcn_fence(__ATOMIC_RELEASE, "agent");
            asm volatile("s_waitcnt vmcnt(0)" ::: "memory");
            const unsigned og = xb_add(&bar[XB_TOP], 1u);
            const unsigned tg = og / nx;
            if (og + 1u == (tg + 1u) * nx) xb_add(&bar[XB_TOPGEN], 1u);
            else XB_SPIN(xb_ld(&bar[XB_TOPGEN]) == tg, bar);
            __builtin_amdgcn_fence(__ATOMIC_ACQUIRE, "agent");
            xb_add(&bar[XB_XGEN(b.x)], 1u);
            asm volatile("s_waitcnt vmcnt(0)" ::: "memory");
        } else {
            XB_SPIN(xb_ld(&bar[XB_XGEN(b.x)]) == gen, bar);
            __builtin_amdgcn_fence(__ATOMIC_ACQUIRE, "agent");
            asm volatile("s_waitcnt vmcnt(0)" ::: "memory");
        }
    }
    __syncthreads();
}

#define G_PA 72
#define G_PB 136
#define G_ABYTES (128 * G_PA * 2)
#define G_BBYTES (64 * G_PB * 2)
#define G_STAGE (G_ABYTES + G_BBYTES)
#define SM_BAR (2 * G_STAGE)
#define SM_TAB (SM_BAR + 16)
#define SMEM_BYTES (SM_TAB + 512)

template <class AF, class BF>
__device__ __forceinline__ void gemm_tile(char* smem, int nk, const AF& af, const BF& bf, f32x4 (&acc)[4][4]) {
    const int tid = ltid(), lane = tid & 63, wid = tid >> 6, wm = wid >> 1, wn = wid & 1;
#pragma unroll
    for (int i = 0; i < 4; ++i)
#pragma unroll
        for (int j = 0; j < 4; ++j) acc[i][j] = (f32x4){0.f, 0.f, 0.f, 0.f};
    const int arow = tid >> 3, akc = (tid & 7) * 8, brow = tid >> 4, bnc = (tid & 15) * 8;
    int ainfo[4];
#pragma unroll
    for (int i = 0; i < 4; ++i) ainfo[i] = af.info(arow + 32 * i);
    u32x4 ra[4], rb[4];
    auto gload = [&](int kt) {
#pragma unroll
        for (int i = 0; i < 4; ++i) ra[i] = *(const u32x4*)af.ptr(ainfo[i], arow + 32 * i, kt * 64 + akc);
#pragma unroll
        for (int i = 0; i < 4; ++i) rb[i] = *(const u32x4*)bf.ptr(kt * 64 + brow + 16 * i, bnc);
    };
    auto sstore = [&](int buf) {
        char* base = smem + buf * G_STAGE;
#pragma unroll
        for (int i = 0; i < 4; ++i) *(u32x4*)(base + (arow + 32 * i) * (G_PA * 2) + akc * 2) = ra[i];
#pragma unroll
        for (int i = 0; i < 4; ++i) *(u32x4*)(base + G_ABYTES + (brow + 16 * i) * (G_PB * 2) + bnc * 2) = rb[i];
    };
    const int aoff = (wm * 64 + (lane & 15)) * (G_PA * 2) + (lane >> 4) * 16;
    const int boff = G_ABYTES + ((lane >> 4) * 8 + ((lane & 15) >> 2)) * (G_PB * 2) + (wn * 64 + (lane & 3) * 4) * 2;
    __syncthreads();
    gload(0); sstore(0);
    for (int kt = 0; kt < nk; ++kt) {
        __syncthreads();
        if (kt + 1 < nk) gload(kt + 1);
        const char* sb = smem + (kt & 1) * G_STAGE;
#pragma unroll
        for (int ks = 0; ks < 2; ++ks) {
            bf16x8 a[4], b[4];
#pragma unroll
            for (int mt = 0; mt < 4; ++mt) a[mt] = *(const bf16x8*)(sb + aoff + mt * 16 * (G_PA * 2) + ks * 64);
#pragma unroll
            for (int nt = 0; nt < 4; ++nt) {
                const s16x4 lo = __builtin_amdgcn_ds_read_tr16_b64_v4i16((LAS s16x4*)(sb + boff + (ks * 32) * (G_PB * 2) + nt * 32));
                const s16x4 hi = __builtin_amdgcn_ds_read_tr16_b64_v4i16((LAS s16x4*)(sb + boff + (ks * 32 + 4) * (G_PB * 2) + nt * 32));
                b[nt] = __builtin_shufflevector(lo, hi, 0, 1, 2, 3, 4, 5, 6, 7);
            }
#pragma unroll
            for (int mt = 0; mt < 4; ++mt)
#pragma unroll
                for (int nt = 0; nt < 4; ++nt) acc[mt][nt] = __builtin_amdgcn_mfma_f32_16x16x32_bf16(b[nt], a[mt], acc[mt][nt], 0, 0, 0);
        }
        if (kt + 1 < nk) sstore((kt + 1) & 1);
    }
}
#define EPI_FOR(acc, ...) do { const int _l = ltid() & 63, _w = ltid() >> 6, _wm = _w >> 1, _wn = _w & 1; \
    _Pragma("unroll") for (int _mt = 0; _mt < 4; ++_mt) _Pragma("unroll") for (int _nt = 0; _nt < 4; ++_nt) { \
        const int row = _wm * 64 + _mt * 16 + (_l & 15), col = _wn * 64 + _nt * 16 + 4 * (_l >> 4); const f32x4 v = acc[_mt][_nt]; __VA_ARGS__ } } while (0)

__device__ __forceinline__ void st_bf4(bf16_t* p, f32x4 v) { u32x2 w; w.x = pk2(v[0], v[1]); w.y = pk2(v[2], v[3]); *(u32x2*)p = w; }

struct APlain { const bf16_t* base; int lda; int m0; __device__ __forceinline__ int info(int row) const { return m0 + row; }
    __device__ __forceinline__ const bf16_t* ptr(int gr, int, int k) const { return base + (size_t)gr * lda + k; } };
struct BPlain { const bf16_t* base; int ldb; __device__ __forceinline__ const bf16_t* ptr(int k, int n) const { return base + (size_t)k * ldb + n; } };

enum { PH_PROLOGUE = 0, PH_MOD_MIX, PH_E2, PH_E3, PH_E4, PH_SCAN, PH_POST, PH_WOUT, PH_F1, PH_F2, PH_F3, PH_WF, PH_MOD_FFN, PH_ROUTER, PH_MOE1, PH_MOE2, PH_FINAL };

#define WSP(T, off) ((T*)(p.ws + (off)))

__device__ __forceinline__ void phase_prologue(const Params& p, char* smem, int wg, int nwg) {
    const int tid = ltid(), lane = tid & 63, wv = tid >> 6;
    float* S = (float*)smem;
    float* RED = S + 5 * 1024;
    for (int idx = tid; idx < 5 * 1024; idx += 256) { const int rb = idx >> 10, k = idx & 1023; const float cv = rb < 4 ? p.c[rb * 1024 + k] : p.c_ctx[k]; S[idx] = cv / (1.f + expf(-cv)); }
    __syncthreads();
    float* mod = WSP(float, OFF_MOD);
    for (int task = wg; task < 384; task += nwg) {
        const int i = task / 96, n0 = (task % 96) * 64;
        const float* W = p.ada_w + (size_t)i * 1024 * 6144 + n0 + lane;
        float a0 = 0.f, a1 = 0.f, a2 = 0.f, a3 = 0.f, a4 = 0.f;
        for (int k = wv * 256; k < wv * 256 + 256; k += 8) {
            float w[8];
#pragma unroll
            for (int u = 0; u < 8; ++u) w[u] = W[(size_t)(k + u) * 6144];
#pragma unroll
            for (int u = 0; u < 8; ++u) { a0 += S[k + u] * w[u]; a1 += S[1024 + k + u] * w[u]; a2 += S[2048 + k + u] * w[u]; a3 += S[3072 + k + u] * w[u]; a4 += S[4096 + k + u] * w[u]; }
        }
        RED[(wv * 5 + 0) * 64 + lane] = a0; RED[(wv * 5 + 1) * 64 + lane] = a1; RED[(wv * 5 + 2) * 64 + lane] = a2; RED[(wv * 5 + 3) * 64 + lane] = a3; RED[(wv * 5 + 4) * 64 + lane] = a4;
        __syncthreads();
        for (int o = tid; o < 320; o += 256) { const int r = o >> 6, l = o & 63;
            const float s = RED[(0 * 5 + r) * 64 + l] + RED[(1 * 5 + r) * 64 + l] + RED[(2 * 5 + r) * 64 + l] + RED[(3 * 5 + r) * 64 + l];
            mod[(size_t)(r * 4 + i) * 6144 + n0 + l] = s + p.ada_b[i * 6144 + n0 + l]; }
        __syncthreads();
    }
    const size_t gt = (size_t)wg * 256 + tid, gs = (size_t)nwg * 256;
    char* wts = p.ws + OFF_WTS;
    auto cast4 = [&](const float* src, bf16_t* dst, size_t n4) { for (size_t i = gt; i < n4; i += gs) { const f32x4 v = *(const f32x4*)(src + 4 * i); st_bf4(dst + 4 * i, v); } };
    cast4(p.w_in, (bf16_t*)(wts + W_WIN), (size_t)2 * 1024 * 2048 / 4);
    cast4(p.w_out, (bf16_t*)(wts + W_WOUT), (size_t)2 * 1024 * 1024 / 4);
    cast4(p.w_fourier, (bf16_t*)(wts + W_WF), (size_t)2 * 1024 * 1024 / 4);
    cast4(p.pool_w, (bf16_t*)(wts + W_POOL), (size_t)2 * 512 * 128 / 4);
    {
        bf16_t* d = (bf16_t*)(wts + W_LR1);
        for (size_t i = gt; i < (size_t)2 * 2048 * 384; i += gs) {
            const int n = (int)(i % 384), kk = (int)((i / 384) % 2048), j = (int)(i / (384 * 2048)); const int k = kk & 1023;
            float w, mu;
            if (n < 128) { const int dd = n >> 6; w = p.decay_w1[((size_t)(j * 2 + dd) * 1024 + k) * 64 + (n & 63)]; mu = p.mu_x[(j * 3 + 0) * 1024 + k]; }
            else if (n < 256) { const int dd = (n - 128) >> 6; w = p.lr_a1[((size_t)(j * 2 + dd) * 1024 + k) * 64 + (n & 63)]; mu = p.mu_x[(j * 3 + 1) * 1024 + k]; }
            else { w = p.gate_g1[((size_t)j * 1024 + k) * 128 + (n - 256)]; mu = p.mu_x[(j * 3 + 2) * 1024 + k]; }
            d[i] = f2bf(kk < 1024 ? (1.f - mu) * w : mu * w);
        }
    }
    {
        bf16_t* d = (bf16_t*)(wts + W_LR2);
        for (size_t i = gt; i < (size_t)2 * 384 * 512; i += gs) {
            const int n = (int)(i % 512), k = (int)((i / 512) % 384), j = (int)(i / (512 * 384));
            float w;
            if (k < 128) w = p.decay_w2[((size_t)(j * 2 + (k >> 6)) * 64 + (k & 63)) * 512 + n];
            else if (k < 256) w = p.lr_a2[((size_t)(j * 2 + ((k - 128) >> 6)) * 64 + (k & 63)) * 512 + n];
            else w = p.gate_g2[((size_t)j * 128 + (k - 256)) * 512 + n];
            d[i] = f2bf(w);
        }
    }
    {
        bf16_t* d = (bf16_t*)(wts + W_RW);
        for (size_t i = gt; i < (size_t)4 * 3072 * 128; i += gs) {
            const int n = (int)(i & 127), kk = (int)((i >> 7) % 3072), l = (int)(i / (3072 * 128)); const int k = kk & 1023, part = kk >> 10;
            float w = 0.f;
            if (n < 4) w = p.router_c[((size_t)l * 1024 + k) * 4 + n]; else if (n < 36) w = p.router_f[((size_t)l * 1024 + k) * 32 + (n - 4)];
            const bf16_t hi = f2bf(w); const bf16_t lo = f2bf(w - bf2f(hi));
            d[i] = part == 1 ? lo : hi;
        }
    }
    {
        bf16_t* d = (bf16_t*)(wts + W_DFTC);
        for (size_t i = gt; i < (size_t)256 * 512; i += gs) { const int n = (int)(i & 511), c = (int)(i >> 9); const int idx = (c * (n & 255)) & 255; float sn, cs; sincospif((float)idx / 128.f, &sn, &cs); d[i] = f2bf(n < 256 ? cs : -sn); }
    }
    {
        bf16_t* d = (bf16_t*)(wts + W_TW);
        for (size_t i = gt; i < (size_t)128 * 128 * 128; i += gs) {
            const int col = (int)(i & 127), row = (int)((i >> 7) & 127), t2 = (int)(i >> 14);
            const int pp = row >> 6, f1 = row & 63, pi = col >> 6, t1 = col & 63; const int idx = (t1 * f1 * 128 + t2 * f1) & 8191;
            float sn, cs; sincospif((float)idx / 4096.f, &sn, &cs);
            d[i] = f2bf(pp == 0 ? (pi == 0 ? cs : sn) : (pi == 0 ? -sn : cs));
        }
    }
    {
        bf16_t* d = (bf16_t*)(wts + W_CS128);
        for (size_t i = gt; i < (size_t)128 * 256; i += gs) { const int col = (int)(i & 255), f2 = (int)(i >> 8); const int pi = col >> 7, t2 = col & 127, idx = (t2 * f2) & 127; float sn, cs; sincospif((float)idx / 64.f, &sn, &cs); d[i] = f2bf(pi == 0 ? cs : sn); }
    }
    {
        bf16_t* d = (bf16_t*)(wts + W_CS256);
        for (size_t i = gt; i < (size_t)256 * 512; i += gs) { const int col = (int)(i & 511), f = (int)(i >> 9); const int pi = col >> 8, t = col & 255, idx = (t * f) & 255; float sn, cs; sincospif((float)idx / 128.f, &sn, &cs); d[i] = f2bf(pi == 0 ? cs : sn); }
    }
}

template <int MODE>
__device__ __forceinline__ void phase_modulate(const Params& p, int layer, int nrows, bool first, bool combine, int wg, int nwg) {
    const int lane = ltid() & 63, wv = ltid() >> 6;
    float* RES = WSP(float, OFF_RES);
    const float* mod = WSP(float, OFF_MOD);
    bf16_t* H = WSP(bf16_t, OFF_HREG); bf16_t* HLO = WSP(bf16_t, OFF_KD);
    const bf16_t* YM = WSP(bf16_t, OFF_PREG);
    const int* routei = WSP(int, OFF_ROUTEI); const float* routeg = WSP(float, OFF_ROUTEG);
    const int* poff = WSP(int, OFF_POFF) + (MODE == 2 ? 3 : layer - 1) * 64;
    const int lprev = MODE == 2 ? 3 : layer - 1;
    for (int r = wg * 4 + wv; r < nrows; r += nwg * 4) {
        const float* src = first ? (r < NL ? p.x + (size_t)r * 1024 : p.ctx + (size_t)(r - NL) * 1024) : RES + (size_t)r * 1024;
        f32x4 v[4];
#pragma unroll
        for (int j = 0; j < 4; ++j) v[j] = *(const f32x4*)(src + 4 * lane + 256 * j);
        const int mb = r < NL ? (r >> 13) : 4;
        if (combine) {
            const int i0 = routei[2 * r], i1 = routei[2 * r + 1]; const float g0 = routeg[2 * r], g1 = routeg[2 * r + 1];
            const size_t row0 = (size_t)poff[i0 & 31] + (i0 >> 5), row1 = (size_t)poff[i1 & 31] + (i1 >> 5);
            const float* m5 = mod + (size_t)(mb * 4 + lprev) * 6144 + 5 * 1024;
#pragma unroll
            for (int j = 0; j < 4; ++j) {
                const u32x2 y0 = *(const u32x2*)(YM + row0 * 1024 + 4 * lane + 256 * j), y1 = *(const u32x2*)(YM + row1 * 1024 + 4 * lane + 256 * j);
                const f32x4 g = *(const f32x4*)(m5 + 4 * lane + 256 * j);
                v[j][0] += g[0] * (g0 * bflo(y0.x) + g1 * bflo(y1.x)); v[j][1] += g[1] * (g0 * bfhi(y0.x) + g1 * bfhi(y1.x));
                v[j][2] += g[2] * (g0 * bflo(y0.y) + g1 * bflo(y1.y)); v[j][3] += g[3] * (g0 * bfhi(y0.y) + g1 * bfhi(y1.y));
            }
        }
        if ((first || combine) && MODE != 2) {
#pragma unroll
            for (int j = 0; j < 4; ++j) *(f32x4*)(RES + (size_t)r * 1024 + 4 * lane + 256 * j) = v[j];
        }
        float ss = 0.f;
#pragma unroll
        for (int j = 0; j < 4; ++j) ss += (v[j][0] * v[j][0] + v[j][1] * v[j][1]) + (v[j][2] * v[j][2] + v[j][3] * v[j][3]);
        ss = wave_sum(ss);
        const float rinv = 1.0f / sqrtf(ss * (1.f / 1024.f) + 1e-6f);
        if (MODE == 2) {
#if DIAG
            if (!(ss < 3.0e38f)) {
#pragma unroll
                for (int j = 0; j < 4; ++j) *(f32x4*)(p.out + (size_t)r * 1024 + 4 * lane + 256 * j) = (f32x4){3.f, 3.f, 3.f, 3.f};
                continue;
            }
#endif
#pragma unroll
            for (int j = 0; j < 4; ++j) { const f32x4 g = *(const f32x4*)(p.final_norm + 4 * lane + 256 * j); f32x4 o; o[0] = v[j][0] * rinv * g[0]; o[1] = v[j][1] * rinv * g[1]; o[2] = v[j][2] * rinv * g[2]; o[3] = v[j][3] * rinv * g[3];
                *(f32x4*)(p.out + (size_t)r * 1024 + 4 * lane + 256 * j) = o; }
        } else {
            const float* gn = (MODE == 0 ? p.norm_mix : p.norm_ffn) + layer * 1024;
            const float* sh = mod + (size_t)(mb * 4 + layer) * 6144 + (MODE == 0 ? 0 : 3) * 1024;
            const float* sc = sh + 1024;
#pragma unroll
            for (int j = 0; j < 4; ++j) {
                const int c = 4 * lane + 256 * j;
                const f32x4 g = *(const f32x4*)(gn + c), s1 = *(const f32x4*)(sh + c), s2 = *(const f32x4*)(sc + c);
                f32x4 h;
#pragma unroll
                for (int e = 0; e < 4; ++e) h[e] = (v[j][e] * rinv * g[e]) * (1.f + s2[e]) + s1[e];
                u32x2 w; w.x = pk2(h[0], h[1]); w.y = pk2(h[2], h[3]);
                *(u32x2*)(H + (size_t)r * 1024 + c) = w;
                if (MODE == 1) { u32x2 w2; w2.x = pk2(h[0] - bflo(w.x), h[1] - bfhi(w.x)); w2.y = pk2(h[2] - bflo(w.y), h[3] - bfhi(w.y)); *(u32x2*)(HLO + (size_t)r * 1024 + c) = w2; }
            }
        }
    }
}

struct AShift { const bf16_t* H; const bf16_t* zero; int m0;
    __device__ __forceinline__ int info(int row) const { return m0 + row; }
    __device__ __forceinline__ const bf16_t* ptr(int gr, int, int k) const {
        if (k < 1024) return H + (size_t)gr * 1024 + k;
        const int kk = k - 1024; const int s = shift_src(gr, kk >> 8);
        return s >= 0 ? H + (size_t)s * 1024 + kk : zero; } };

__device__ __forceinline__ void phase_e2(const Params& p, char* smem, int j, int nrows, int wg, int nwg) {
    const bf16_t* H = WSP(bf16_t, OFF_HREG); bf16_t* P = WSP(bf16_t, OFF_PREG); bf16_t* LR1 = WSP(bf16_t, OFF_LR1);
    const bf16_t* WIN = (const bf16_t*)(p.ws + OFF_WTS + W_WIN) + (size_t)j * 1024 * 2048;
    const bf16_t* WL1 = (const bf16_t*)(p.ws + OFF_WTS + W_LR1) + (size_t)j * 2048 * 384;
    const int nrt = nrows / 128, nproj = nrt * 16, ntot = nproj + nrt * 3;
    f32x4 acc[4][4];
    for (int t = wg; t < ntot; t += nwg) {
        if (t < nproj) {
            const int mt = t >> 4, nt = t & 15, m0 = mt * 128, n0 = nt * 128;
            gemm_tile(smem, 16, APlain{H, 1024, m0}, BPlain{WIN + n0, 2048}, acc);
            EPI_FOR(acc, { st_bf4(P + (size_t)(m0 + row) * 2048 + n0 + col, v); });
        } else {
            const int u = t - nproj, mt = u / 3, nt = u % 3, m0 = mt * 128, n0 = nt * 128;
            gemm_tile(smem, 32, AShift{H, WSP(bf16_t, OFF_ZERO), m0}, BPlain{WL1 + n0, 384}, acc);
            EPI_FOR(acc, { f32x4 o;
                _Pragma("unroll") for (int e = 0; e < 4; ++e) { const float z = v[e]; o[e] = nt == 0 ? tanhf(z) : (nt == 1 ? z : sigmoidf_(z)); }
                st_bf4(LR1 + (size_t)(m0 + row) * 384 + n0 + col, o); });
        }
    }
}

__device__ __forceinline__ void phase_e3(const Params& p, int j, int nrows, int wg, int nwg) {
    const int lane = ltid() & 63, wv = ltid() >> 6;
    const bf16_t* P = WSP(bf16_t, OFF_PREG);
    bf16_t* R = WSP(bf16_t, OFF_RKVK); bf16_t* K = R + (size_t)NT * 512; bf16_t* V = K + (size_t)NT * 512; bf16_t* KK = V + (size_t)NT * 512;
    bf16_t* DIFF = WSP(bf16_t, OFF_DIFF);
    const int c = 8 * lane, q = lane >> 4;
    for (int r = wg * 4 + wv; r < nrows; r += nwg * 4) {
        const int s = shift_src(r, q); const int sc = s >= 0 ? s : r;
        float val[3][8];
#pragma unroll
        for (int n = 0; n < 3; ++n) {
            const u32x4 a = *(const u32x4*)(P + (size_t)r * 2048 + n * 512 + c); u32x4 b = *(const u32x4*)(P + (size_t)sc * 2048 + n * 512 + c);
            if (s < 0) b = (u32x4){0u, 0u, 0u, 0u};
            const f32x4 m0 = *(const f32x4*)(p.mu_p + (size_t)(j * 3 + n) * 512 + c), m1 = *(const f32x4*)(p.mu_p + (size_t)(j * 3 + n) * 512 + c + 4);
#pragma unroll
            for (int e = 0; e < 4; ++e) {
                const float pa0 = bflo(a[e]), pa1 = bfhi(a[e]), pb0 = bflo(b[e]), pb1 = bfhi(b[e]);
                const float mu0 = (2 * e < 4) ? m0[2 * e] : m1[2 * e - 4], mu1 = (2 * e + 1 < 4) ? m0[2 * e + 1] : m1[2 * e + 1 - 4];
                val[n][2 * e] = pa0 + (pb0 - pa0) * mu0; val[n][2 * e + 1] = pa1 + (pb1 - pa1) * mu1;
            }
        }
        const f32x4 kk0 = *(const f32x4*)(p.k_k + j * 512 + c), kk1 = *(const f32x4*)(p.k_k + j * 512 + c + 4);
        float kkv[8]; float ss = 0.f;
#pragma unroll
        for (int e = 0; e < 8; ++e) { kkv[e] = val[1][e] * (e < 4 ? kk0[e] : kk1[e - 4]); ss += kkv[e] * kkv[e]; }
        ss += __shfl_xor(ss, 1); ss += __shfl_xor(ss, 2); ss += __shfl_xor(ss, 4);
        const float rn = 1.0f / sqrtf(fmaxf(ss, 1e-12f));
        u32x4 o;
#pragma unroll
        for (int e = 0; e < 4; ++e) o[e] = pk2(val[0][2 * e], val[0][2 * e + 1]);
        *(u32x4*)(R + (size_t)r * 512 + c) = o;
#pragma unroll
        for (int e = 0; e < 4; ++e) o[e] = pk2(val[1][2 * e], val[1][2 * e + 1]);
        *(u32x4*)(K + (size_t)r * 512 + c) = o;
#pragma unroll
        for (int e = 0; e < 4; ++e) o[e] = pk2(val[2][2 * e], val[2][2 * e + 1]);
        *(u32x4*)(V + (size_t)r * 512 + c) = o;
#pragma unroll
        for (int e = 0; e < 4; ++e) o[e] = pk2(kkv[2 * e] * rn, kkv[2 * e + 1] * rn);
        *(u32x4*)(KK + (size_t)r * 512 + c) = o;
        int t, T, base;
        if (r < NL) { t = r & 8191; T = 8192; base = r - t; } else { t = (r - NL) & 255; T = 256; base = r - t; }
        const int half = 1 << q; const int lo = max(t - half, 0), hi = min(t + half, T);
        float sum[8];
#pragma unroll
        for (int e = 0; e < 8; ++e) sum[e] = 0.f;
        for (int tt = lo; tt < hi; ++tt) {
            const u32x4 a = *(const u32x4*)(P + (size_t)(base + tt) * 2048 + 1536 + c);
#pragma unroll
            for (int e = 0; e < 4; ++e) { sum[2 * e] += bflo(a[e]); sum[2 * e + 1] += bfhi(a[e]); }
        }
        const float inv = 1.0f / (float)(hi - lo);
        const u32x4 u = *(const u32x4*)(P + (size_t)r * 2048 + 1536 + c);
#pragma unroll
        for (int e = 0; e < 4; ++e) o[e] = pk2(sum[2 * e] * inv - bflo(u[e]), sum[2 * e + 1] * inv - bfhi(u[e]));
        *(u32x4*)(DIFF + (size_t)r * 512 + c) = o;
    }
}

__device__ __forceinline__ void phase_e4(const Params& p, char* smem, int j, int nrows, bool need_out, int wg, int nwg) {
    const bf16_t* LR1 = WSP(bf16_t, OFF_LR1); const bf16_t* DIFF = WSP(bf16_t, OFF_DIFF);
    const bf16_t* K = WSP(bf16_t, OFF_RKVK) + (size_t)NT * 512; const bf16_t* KK = WSP(bf16_t, OFF_RKVK) + (size_t)3 * NT * 512;
    float* W = WSP(float, OFF_WREG); bf16_t* KD = WSP(bf16_t, OFF_KD); bf16_t* BB = WSP(bf16_t, OFF_BB); bf16_t* G = WSP(bf16_t, OFF_G); bf16_t* YAB = WSP(bf16_t, OFF_HREG);
    const bf16_t* WL2 = (const bf16_t*)(p.ws + OFF_WTS + W_LR2) + (size_t)j * 384 * 512;
    const bf16_t* WP = (const bf16_t*)(p.ws + OFF_WTS + W_POOL) + (size_t)j * 512 * 128;
    const int nrt = nrows / 128, nlr = nrt * 20, ntot = nlr + (need_out ? nrt * 4 : 0);
    f32x4 acc[4][4];
    for (int t = wg; t < ntot; t += nwg) {
        if (t < nlr) {
            const int mt = t / 20, u = t % 20, ob = u >> 2, n4 = u & 3, m0 = mt * 128, n0 = n4 * 128;
            const int koff = ob < 4 ? ob * 64 : 256, nk = ob < 4 ? 1 : 2;
            gemm_tile(smem, nk, APlain{LR1 + koff, 384, m0}, BPlain{WL2 + (size_t)koff * 512 + n0, 512}, acc);
            if (ob < 2) {
                const float* w0 = p.decay_w0 + (size_t)(j * 2 + ob) * 512 + n0;
                EPI_FOR(acc, { const f32x4 b0 = *(const f32x4*)(w0 + col); f32x4 o;
                    _Pragma("unroll") for (int e = 0; e < 4; ++e) o[e] = expf(-0.60653065971f * sigmoidf_(v[e] + b0[e]));
                    *(f32x4*)(W + ((size_t)ob * NT + m0 + row) * 512 + n0 + col) = o; });
            } else if (ob < 4) {
                const int d = ob - 2; const float* a0 = p.lr_a0 + (size_t)(j * 2 + d) * 512 + n0; const float* ka = p.k_a + (size_t)j * 512 + n0;
                EPI_FOR(acc, { const f32x4 b0 = *(const f32x4*)(a0 + col), kav = *(const f32x4*)(ka + col);
                    const u32x2 kr = *(const u32x2*)(K + (size_t)(m0 + row) * 512 + n0 + col), kkr = *(const u32x2*)(KK + (size_t)(m0 + row) * 512 + n0 + col);
                    const float kf[4] = {bflo(kr.x), bfhi(kr.x), bflo(kr.y), bfhi(kr.y)}, kkf[4] = {bflo(kkr.x), bfhi(kkr.x), bflo(kkr.y), bfhi(kkr.y)};
                    f32x4 okd, ob_;
                    _Pragma("unroll") for (int e = 0; e < 4; ++e) { const float al = sigmoidf_(v[e] + b0[e]); okd[e] = kf[e] * (1.f + (al - 1.f) * kav[e]); ob_[e] = kkf[e] * al; }
                    st_bf4(KD + ((size_t)d * NT + m0 + row) * 512 + n0 + col, okd); st_bf4(BB + ((size_t)d * NT + m0 + row) * 512 + n0 + col, ob_); });
            } else {
                EPI_FOR(acc, { st_bf4(G + (size_t)(m0 + row) * 512 + n0 + col, v); });
            }
        } else {
            const int u = t - nlr, mt = u >> 2, g = u & 3, m0 = mt * 128;
            gemm_tile(smem, 2, APlain{DIFF + g * 128, 512, m0}, BPlain{WP + (size_t)g * 128 * 128, 128}, acc);
            const float* ps = p.pool_scale + (size_t)j * 512 + g * 128;
            EPI_FOR(acc, { const f32x4 s = *(const f32x4*)(ps + col); f32x4 o; o[0] = v[0] * s[0]; o[1] = v[1] * s[1]; o[2] = v[2] * s[2]; o[3] = v[3] * s[3];
                st_bf4(YAB + (size_t)(m0 + row) * 1024 + 512 + g * 128 + col, o); });
        }
    }
}

#define SC_STEP 336
#define SC_BLK 16
__device__ __forceinline__ float dpp_ror_add(float x, int) { return x; }
template <int CTRL> __device__ __forceinline__ float dpp_mov(float x) { return __builtin_bit_cast(float, __builtin_amdgcn_mov_dpp(__builtin_bit_cast(int, x), CTRL, 0xf, 0xf, true)); }
__device__ __forceinline__ float row16_sum(float x) { x += dpp_mov<0x128>(x); x += dpp_mov<0x124>(x); x += dpp_mov<0x122>(x); x += dpp_mov<0x121>(x); return x; }

__device__ __forceinline__ void phase_scan(const Params& p, char* smem, int wg, int nwg) {
    const int tid = ltid(), lane = tid & 63, wv = tid >> 6;
    const bf16_t* R = WSP(bf16_t, OFF_RKVK); const bf16_t* V = R + (size_t)2 * NT * 512; const bf16_t* KK = R + (size_t)3 * NT * 512;
    const float* W = WSP(float, OFF_WREG); const bf16_t* KD = WSP(bf16_t, OFF_KD); const bf16_t* BB = WSP(bf16_t, OFF_BB);
    float* Y = WSP(float, OFF_PREG);
    float* L = (float*)smem;
    for (int task = wg; task < 512; task += nwg) {
        const int chain = task & 63, part = task >> 6;
        const int b = chain >> 4, h = (chain >> 1) & 7, d = chain & 1;
        const int nblk = (256 + 8192) / SC_BLK;
        const bf16_t* KDd = KD + (size_t)d * NT * 512; const bf16_t* BBd = BB + (size_t)d * NT * 512; const float* Wd = W + (size_t)d * NT * 512;
        float* Yd = Y + (size_t)d * NT * 512;
        auto rowof = [&](int s) -> int { if (s < 256) return NL + b * 256 + (d ? 255 - s : s); const int tl = s - 256; return b * 8192 + (d ? 8191 - tl : tl); };
        const int lt = tid - 128;
        u32x4 l0, l1, l2, l3; f32x4 l4, l5; unsigned lv = 0;
        auto gl = [&](int blk) {
            const int s0 = blk * SC_BLK; const int r0 = rowof(s0); const int dir = d ? -1 : 1;
            const int st = lt >> 3, c8 = (lt & 7) * 8;
            const size_t ro = (size_t)(r0 + dir * st) * 512 + h * 64;
            l0 = *(const u32x4*)(R + ro + c8); l1 = *(const u32x4*)(KK + ro + c8); l2 = *(const u32x4*)(KDd + ro + c8); l3 = *(const u32x4*)(BBd + ro + c8);
            const int st2 = lt >> 4, c4 = (lt & 15) * 4;
            l4 = *(const f32x4*)(Wd + (size_t)(r0 + dir * st2) * 512 + h * 64 + c4);
            l5 = *(const f32x4*)(Wd + (size_t)(r0 + dir * (st2 + 8)) * 512 + h * 64 + c4);
            lv = V[(size_t)(r0 + dir * st) * 512 + h * 64 + part * 8 + (lt & 7)];
        };
        auto ls = [&](int buf) {
            float* Bf = L + buf * (SC_BLK * SC_STEP);
            const int st = lt >> 3, c8 = (lt & 7) * 8; float* sp = Bf + st * SC_STEP;
            auto w8 = [&](float* dst, u32x4 x) { *(f32x4*)dst = (f32x4){bflo(x[0]), bfhi(x[0]), bflo(x[1]), bfhi(x[1])}; *(f32x4*)(dst + 4) = (f32x4){bflo(x[2]), bfhi(x[2]), bflo(x[3]), bfhi(x[3])}; };
            w8(sp + 256 + c8, l0); w8(sp + 0 + c8, l1); w8(sp + 192 + c8, l2); w8(sp + 128 + c8, l3);
            const int st2 = lt >> 4, c4 = (lt & 15) * 4;
            *(f32x4*)(Bf + st2 * SC_STEP + 64 + c4) = l4; *(f32x4*)(Bf + (st2 + 8) * SC_STEP + 64 + c4) = l5;
            sp[320 + (lt & 7)] = bf2f((bf16_t)lv);
        };
        __syncthreads();
        if (wv >= 2) { gl(0); ls(0); }
        __syncthreads();
        float s0 = 0.f, s1 = 0.f, s2 = 0.f, s3 = 0.f;
        const int g = lane >> 4, kq = lane & 15;
        for (int blk = 0; blk < nblk; ++blk) {
            if (wv >= 2) {
                if (blk + 1 < nblk) { gl(blk + 1); ls((blk + 1) & 1); }
            } else {
                const float* Bf = L + (blk & 1) * (SC_BLK * SC_STEP);
                const int r0 = rowof(blk * SC_BLK); const int dir = d ? -1 : 1;
                float* yo = Yd + (size_t)r0 * 512 + h * 64 + part * 8 + wv * 4 + g;
#pragma unroll
                for (int st = 0; st < SC_BLK; ++st) {
                    const float* sp = Bf + st * SC_STEP;
                    const f32x4 kk = *(const f32x4*)(sp + 4 * kq), w = *(const f32x4*)(sp + 64 + 4 * kq), bb = *(const f32x4*)(sp + 128 + 4 * kq),
                                kd = *(const f32x4*)(sp + 192 + 4 * kq), rr = *(const f32x4*)(sp + 256 + 4 * kq);
                    const float vv = sp[320 + wv * 4 + g];
                    float dot = (s0 * kk[0] + s1 * kk[1]) + (s2 * kk[2] + s3 * kk[3]);
                    dot = row16_sum(dot);
                    const float sa = -dot;
                    s0 = s0 * w[0] + (sa * bb[0] + vv * kd[0]); s1 = s1 * w[1] + (sa * bb[1] + vv * kd[1]);
                    s2 = s2 * w[2] + (sa * bb[2] + vv * kd[2]); s3 = s3 * w[3] + (sa * bb[3] + vv * kd[3]);
                    float y = (s0 * rr[0] + s1 * rr[1]) + (s2 * rr[2] + s3 * rr[3]);
                    y = row16_sum(y);
                    if (kq == 0) yo[(ptrdiff_t)dir * st * 512] = y;
                }
            }
            __syncthreads();
        }
    }
}

__device__ __forceinline__ void phase_post(const Params& p, int j, int nrows, int wg, int nwg) {
    const int lane = ltid() & 63, wv = ltid() >> 6;
    const float* Y = WSP(float, OFF_PREG);
    const bf16_t* R = WSP(bf16_t, OFF_RKVK); const bf16_t* V = R + (size_t)2 * NT * 512;
    const bf16_t* KD = WSP(bf16_t, OFF_KD); const bf16_t* G = WSP(bf16_t, OFF_G); bf16_t* YAB = WSP(bf16_t, OFF_HREG);
    const int c = 8 * lane;
    for (int r = wg * 4 + wv; r < nrows; r += nwg * 4) {
        float y[8];
        {
            const f32x4 a0 = *(const f32x4*)(Y + (size_t)r * 512 + c), a1 = *(const f32x4*)(Y + (size_t)r * 512 + c + 4);
            const f32x4 b0 = *(const f32x4*)(Y + ((size_t)NT + r) * 512 + c), b1 = *(const f32x4*)(Y + ((size_t)NT + r) * 512 + c + 4);
#pragma unroll
            for (int e = 0; e < 4; ++e) { y[e] = a0[e] + b0[e]; y[4 + e] = a1[e] + b1[e]; }
        }
        float s = 0.f;
#pragma unroll
        for (int e = 0; e < 8; ++e) s += y[e];
        s += __shfl_xor(s, 1); s += __shfl_xor(s, 2); s += __shfl_xor(s, 4);
        const float mu = s * (1.f / 64.f);
        float q = 0.f;
#pragma unroll
        for (int e = 0; e < 8; ++e) { const float dlt = y[e] - mu; q += dlt * dlt; }
        q += __shfl_xor(q, 1); q += __shfl_xor(q, 2); q += __shfl_xor(q, 4);
        const float rstd = 1.0f / sqrtf(q * (1.f / 64.f) + 64e-5f);
        const u32x4 rr = *(const u32x4*)(R + (size_t)r * 512 + c), vv = *(const u32x4*)(V + (size_t)r * 512 + c), gg = *(const u32x4*)(G + (size_t)r * 512 + c);
        const u32x4 k0 = *(const u32x4*)(KD + (size_t)r * 512 + c), k1 = *(const u32x4*)(KD + ((size_t)NT + r) * 512 + c);
        const f32x4 rk0 = *(const f32x4*)(p.r_k + (size_t)j * 512 + c), rk1 = *(const f32x4*)(p.r_k + (size_t)j * 512 + c + 4);
        float dot = 0.f;
#pragma unroll
        for (int e = 0; e < 4; ++e) {
            dot += bflo(rr[e]) * (bflo(k0[e]) + bflo(k1[e])) * (2 * e < 4 ? rk0[2 * e] : rk1[2 * e - 4]);
            dot += bfhi(rr[e]) * (bfhi(k0[e]) + bfhi(k1[e])) * (2 * e + 1 < 4 ? rk0[2 * e + 1] : rk1[2 * e + 1 - 4]);
        }
        dot += __shfl_xor(dot, 1); dot += __shfl_xor(dot, 2); dot += __shfl_xor(dot, 4);
        const f32x4 gw0 = *(const f32x4*)(p.gn_w + (size_t)j * 512 + c), gw1 = *(const f32x4*)(p.gn_w + (size_t)j * 512 + c + 4);
        const f32x4 gb0 = *(const f32x4*)(p.gn_b + (size_t)j * 512 + c), gb1 = *(const f32x4*)(p.gn_b + (size_t)j * 512 + c + 4);
        float o[8];
#pragma unroll
        for (int e = 0; e < 8; ++e) {
            const float gw = e < 4 ? gw0[e] : gw1[e - 4], gb = e < 4 ? gb0[e] : gb1[e - 4];
            const float vf = (e & 1) ? bfhi(vv[e >> 1]) : bflo(vv[e >> 1]), gf = (e & 1) ? bfhi(gg[e >> 1]) : bflo(gg[e >> 1]);
            o[e] = ((y[e] - mu) * rstd * gw + gb + dot * vf) * gf;
        }
        u32x4 w;
#pragma unroll
        for (int e = 0; e < 4; ++e) w[e] = pk2(o[2 * e], o[2 * e + 1]);
        *(u32x4*)(YAB + (size_t)r * 1024 + c) = w;
    }
}

__device__ __forceinline__ void phase_resgemm(const Params& p, char* smem, const bf16_t* A, const bf16_t* B, int layer, int nrows, int wg, int nwg) {
    float* RES = WSP(float, OFF_RES); const float* mod = WSP(float, OFF_MOD);
    const int ntot = (nrows / 128) * 8;
    f32x4 acc[4][4];
    for (int t = wg; t < ntot; t += nwg) {
        const int mt = t >> 3, nt = t & 7, m0 = mt * 128, n0 = nt * 128;
        gemm_tile(smem, 16, APlain{A, 1024, m0}, BPlain{B + n0, 1024}, acc);
        const int mb = m0 < NL ? (m0 >> 13) : 4;
        const float* g2 = mod + (size_t)(mb * 4 + layer) * 6144 + 2 * 1024 + n0;
        EPI_FOR(acc, { float* rp = RES + (size_t)(m0 + row) * 1024 + n0 + col; const f32x4 g = *(const f32x4*)(g2 + col); f32x4 o = *(const f32x4*)rp;
            o[0] += g[0] * v[0]; o[1] += g[1] * v[1]; o[2] += g[2] * v[2]; o[3] += g[3] * v[3]; *(f32x4*)rp = o; });
    }
}

__device__ __forceinline__ void phase_f1(const Params& p, char* smem, int nrows, int wg, int nwg) {
    const bf16_t* H = WSP(bf16_t, OFF_HREG); bf16_t* Z = WSP(bf16_t, OFF_PREG); const bf16_t* DFTC = (const bf16_t*)(p.ws + OFF_WTS + W_DFTC);
    const int ntot = (nrows / 128) * 16;
    f32x4 acc[4][4];
    for (int t = wg; t < ntot; t += nwg) {
        const int mt = t >> 4, nt = t & 15, g = nt >> 2, cb = nt & 3, m0 = mt * 128;
        gemm_tile(smem, 4, APlain{H + g * 256, 1024, m0}, BPlain{DFTC + cb * 128, 512}, acc);
        EPI_FOR(acc, { st_bf4(Z + (size_t)(m0 + row) * 2048 + g * 512 + cb * 128 + col, v); });
    }
}
struct BZ { const bf16_t* Z; int rowbase, rstride, psh, off;
    __device__ __forceinline__ const bf16_t* ptr(int k, int n) const { const int part = k >> psh, idx = k & ((1 << psh) - 1); return Z + (size_t)(rowbase + idx * rstride) * 2048 + part * 256 + off + n; } };
__device__ __forceinline__ void phase_f2(const Params& p, char* smem, bool with_ctx, int wg, int nwg) {
    const bf16_t* Z = WSP(bf16_t, OFF_PREG); bf16_t* A1 = WSP(bf16_t, OFF_WREG); bf16_t* FO = WSP(bf16_t, OFF_RKVK);
    const bf16_t* TW = (const bf16_t*)(p.ws + OFF_WTS + W_TW); const bf16_t* CS256 = (const bf16_t*)(p.ws + OFF_WTS + W_CS256);
    const int nlat = 512 * 8, ntot = nlat + (with_ctx ? 64 : 0);
    f32x4 acc[4][4];
    for (int t = wg; t < ntot; t += nwg) {
        if (t < nlat) {
            const int bt = t >> 3, nt = t & 7, b = bt >> 7, t2 = bt & 127; const int ch0 = nt * 128, g = ch0 >> 8, cc = ch0 & 255;
            gemm_tile(smem, 2, APlain{TW + (size_t)t2 * 128 * 128, 128, 0}, BZ{Z, b * 8192 + t2, 128, 6, g * 512 + cc}, acc);
            EPI_FOR(acc, { const int pp = row >> 6, f1 = row & 63; st_bf4(A1 + ((((size_t)(b * 64 + f1) * 128 + t2) * 2 + pp) * 1024) + ch0 + col, v); });
        } else {
            const int u = t - nlat, b = u >> 4, mt = (u >> 3) & 1, nt = u & 7; const int ch0 = nt * 128, g = ch0 >> 8, cc = ch0 & 255;
            gemm_tile(smem, 8, APlain{CS256, 512, mt * 128}, BZ{Z, NL + b * 256, 1, 8, g * 512 + cc}, acc);
            EPI_FOR(acc, { f32x4 o; o[0] = v[0] * (1.f / 256.f); o[1] = v[1] * (1.f / 256.f); o[2] = v[2] * (1.f / 256.f); o[3] = v[3] * (1.f / 256.f);
                st_bf4(FO + (size_t)(NL + b * 256 + mt * 128 + row) * 1024 + ch0 + col, o); });
        }
    }
}
struct BA1 { const bf16_t* base; int off;
    __device__ __forceinline__ const bf16_t* ptr(int k, int n) const { const int part = k >> 7, t2 = k & 127; return base + (size_t)(t2 * 2 + part) * 1024 + off + n; } };
__device__ __forceinline__ void phase_f3(const Params& p, char* smem, int wg, int nwg) {
    const bf16_t* A1 = WSP(bf16_t, OFF_WREG); bf16_t* FO = WSP(bf16_t, OFF_RKVK); const bf16_t* CS128 = (const bf16_t*)(p.ws + OFF_WTS + W_CS128);
    f32x4 acc[4][4];
    const float scl = 0.000690533966f;
    for (int t = wg; t < 256 * 8; t += nwg) {
        const int bf_ = t >> 3, nt = t & 7, b = bf_ >> 6, f1 = bf_ & 63;
        gemm_tile(smem, 4, APlain{CS128, 256, 0}, BA1{A1 + (size_t)(b * 64 + f1) * 128 * 2 * 1024, nt * 128}, acc);
        EPI_FOR(acc, { f32x4 o; o[0] = v[0] * scl; o[1] = v[1] * scl; o[2] = v[2] * scl; o[3] = v[3] * scl;
            st_bf4(FO + (size_t)(b * 8192 + f1 + 64 * row) * 1024 + nt * 128 + col, o); });
    }
}

__device__ __forceinline__ void moe_convert(const Params& p, int layer, int wg, int nwg) {
    const size_t gt = (size_t)wg * 256 + ltid(), gs = (size_t)nwg * 256; const size_t n4 = (size_t)32 * 1024 * 512 / 4;
    bf16_t* MW = WSP(bf16_t, OFF_WREG);
    const float* s1 = p.moe_w1 + (size_t)layer * 32 * 1024 * 512; const float* s3 = p.moe_w3 + (size_t)layer * 32 * 1024 * 512; const float* s2 = p.moe_w2 + (size_t)layer * 32 * 1024 * 512;
    for (size_t i = gt; i < n4; i += gs) {
        st_bf4(MW + 4 * i, *(const f32x4*)(s1 + 4 * i)); st_bf4(MW + 4 * n4 + 4 * i, *(const f32x4*)(s3 + 4 * i)); st_bf4(MW + 8 * n4 + 4 * i, *(const f32x4*)(s2 + 4 * i));
    }
}
struct ASplit { const bf16_t* H; const bf16_t* HLO; int m0;
    __device__ __forceinline__ int info(int row) const { return m0 + row; }
    __device__ __forceinline__ const bf16_t* ptr(int gr, int, int k) const { return k < 2048 ? H + (size_t)gr * 1024 + (k & 1023) : HLO + (size_t)gr * 1024 + (k - 2048); } };
__device__ __forceinline__ void phase_router(const Params& p, char* smem, int layer, int nrows, int wg, int nwg) {
    const bf16_t* H = WSP(bf16_t, OFF_HREG); const bf16_t* HLO = WSP(bf16_t, OFF_KD);
    const bf16_t* RW = (const bf16_t*)(p.ws + OFF_WTS + W_RW) + (size_t)layer * 3072 * 128;
    int* cnt = WSP(int, OFF_CNT) + layer * 32; int* routei = WSP(int, OFF_ROUTEI); float* routeg = WSP(float, OFF_ROUTEG); int* tokl = WSP(int, OFF_TOKL);
    float* LG = (float*)smem;
    f32x4 acc[4][4];
    const int ntot = nrows / 128;
    for (int t = wg; t < ntot; t += nwg) {
        const int m0 = t * 128;
        gemm_tile(smem, 48, ASplit{H, HLO, m0}, BPlain{RW, 128}, acc);
        __syncthreads();
        EPI_FOR(acc, { if (col < 48) { LG[row * 49 + col] = v[0]; LG[row * 49 + col + 1] = v[1]; LG[row * 49 + col + 2] = v[2]; LG[row * 49 + col + 3] = v[3]; } });
        __syncthreads();
        if (ltid() < 128) {
            const int row = ltid(), r = m0 + row; const float* lg = LG + row * 49;
            float c0 = lg[0] + p.router_c_b[layer * 4 + 0], c1 = lg[1] + p.router_c_b[layer * 4 + 1], c2 = lg[2] + p.router_c_b[layer * 4 + 2], c3 = lg[3] + p.router_c_b[layer * 4 + 3];
            int gi = 0; float mx = c0;
            if (c1 > mx) { mx = c1; gi = 1; } if (c2 > mx) { mx = c2; gi = 2; } if (c3 > mx) { mx = c3; gi = 3; }
            const float gval = 1.f / (expf(c0 - mx) + expf(c1 - mx) + expf(c2 - mx) + expf(c3 - mx));
            float lf[8]; float m1 = -3.0e38f, m2 = -3.0e38f; int e1 = 0, e2 = 0;
#pragma unroll
            for (int e = 0; e < 8; ++e) lf[e] = lg[4 + gi * 8 + e] + p.router_f_b[layer * 32 + gi * 8 + e];
#pragma unroll
            for (int e = 0; e < 8; ++e) if (lf[e] > m1) { m1 = lf[e]; e1 = e; }
#pragma unroll
            for (int e = 0; e < 8; ++e) if (e != e1 && lf[e] > m2) { m2 = lf[e]; e2 = e; }
            const float q2 = expf(m2 - m1); const float ga = gval / (1.f + q2), gb = gval * q2 / (1.f + q2);
            const int x1 = gi * 8 + e1, x2 = gi * 8 + e2;
            const int p1 = atomicAdd(&cnt[x1], 1), p2 = atomicAdd(&cnt[x2], 1);
            tokl[(size_t)x1 * TOKCAP + p1] = r; tokl[(size_t)x2 * TOKCAP + p2] = r;
            routei[2 * r] = (p1 << 5) | x1; routei[2 * r + 1] = (p2 << 5) | x2; routeg[2 * r] = ga; routeg[2 * r + 1] = gb;
        }
    }
    moe_convert(p, layer, wg, nwg);
}
__device__ __forceinline__ void moe_table(const Params& p, int layer, int* rbs, int* cn, int wg) {
    const int* cnt = WSP(int, OFF_CNT) + layer * 32;
    __syncthreads();
    if (ltid() == 0) { int a = 0; for (int e = 0; e < 32; ++e) { const int c = cnt[e]; cn[e] = c; rbs[e] = a; a += (c + 127) >> 7; } rbs[32] = a;
        if (wg == 0) { int* poff = WSP(int, OFF_POFF) + layer * 64; for (int e = 0; e < 32; ++e) poff[e] = rbs[e] * 128; } }
    __syncthreads();
}
struct AGather { const bf16_t* H; const bf16_t* zero; const int* list; int nvalid;
    __device__ __forceinline__ int info(int row) const { return row < nvalid ? list[row] : -1; }
    __device__ __forceinline__ const bf16_t* ptr(int tok, int, int k) const { return tok >= 0 ? H + (size_t)tok * 1024 + k : zero; } };
struct BW13 { const bf16_t* w1; size_t d3;
    __device__ __forceinline__ const bf16_t* ptr(int k, int n) const { return w1 + (size_t)((n >> 5) & 1) * d3 + (size_t)k * 512 + (n >> 6) * 32 + (n & 31); } };

__device__ __forceinline__ void phase_moe1(const Params& p, char* smem, int layer, int wg, int nwg) {
    int* rbs = (int*)(smem + SM_TAB); int* cn = rbs + 40;
    moe_table(p, layer, rbs, cn, wg);
    const bf16_t* H2 = WSP(bf16_t, OFF_HREG); const bf16_t* MW = WSP(bf16_t, OFF_WREG); bf16_t* HB = WSP(bf16_t, OFF_BB); const int* tokl = WSP(int, OFF_TOKL);
    const size_t WSZ = (size_t)32 * 1024 * 512;
    const int ntot = rbs[32] * 8;
    f32x4 acc[4][4];
    for (int t = wg; t < ntot; t += nwg) {
        const int rbg = t >> 3, cb = t & 7;
        int e = 0; while (rbs[e + 1] <= rbg) ++e;
        const int rb = rbg - rbs[e]; const int nvalid = cn[e] - rb * 128;
        gemm_tile(smem, 16, AGather{H2, WSP(bf16_t, OFF_ZERO), tokl + (size_t)e * TOKCAP + rb * 128, nvalid},
                  BW13{MW + (size_t)e * 1024 * 512 + cb * 64, WSZ}, acc);
        {
            const int l = ltid() & 63, w = ltid() >> 6, wm = w >> 1, wn = w & 1;
#pragma unroll
            for (int mt = 0; mt < 4; ++mt)
#pragma unroll
                for (int nt = 0; nt < 2; ++nt) {
                    const int row = wm * 64 + mt * 16 + (l & 15), hcol = cb * 64 + wn * 32 + nt * 16 + 4 * (l >> 4);
                    const f32x4 a1 = acc[mt][nt], a3 = acc[mt][nt + 2]; f32x4 o;
#pragma unroll
                    for (int q = 0; q < 4; ++q) o[q] = a1[q] / (1.f + expf(-a1[q])) * a3[q];
                    st_bf4(HB + ((size_t)rbg * 128 + row) * 512 + hcol, o);
                }
        }
    }
}
__device__ __forceinline__ void phase_moe2(const Params& p, char* smem, int layer, int wg, int nwg) {
    int* rbs = (int*)(smem + SM_TAB); int* cn = rbs + 40;
    moe_table(p, layer, rbs, cn, wg);
    const bf16_t* MW2 = WSP(bf16_t, OFF_WREG) + (size_t)2 * 32 * 1024 * 512; const bf16_t* HB = WSP(bf16_t, OFF_BB); bf16_t* YM = WSP(bf16_t, OFF_PREG);
    const int ntot = rbs[32] * 8;
    f32x4 acc[4][4];
    for (int t = wg; t < ntot; t += nwg) {
        const int rbg = t >> 3, nt8 = t & 7;
        int e = 0; while (rbs[e + 1] <= rbg) ++e;
        gemm_tile(smem, 8, APlain{HB, 512, rbg * 128}, BPlain{MW2 + (size_t)e * 512 * 1024 + nt8 * 128, 1024}, acc);
        EPI_FOR(acc, { st_bf4(YM + ((size_t)rbg * 128 + row) * 1024 + nt8 * 128 + col, v); });
    }
}

template <int PH>
__device__ __forceinline__ void do_phase(const Params& pin, char* smem, int layer, int wg, int nwg) {
    Params p = pin; asm volatile("" : "+s"(p.ws)); asm volatile("" : "+s"(layer));
    const int j = layer >> 1;
    const bool ctx_in = layer <= 2, ctx_out = layer < 2;
    const int rows_in = ctx_in ? NT : NL, rows_out = ctx_out ? NT : NL;
    const char* wts = p.ws + OFF_WTS;
    if constexpr (PH == PH_PROLOGUE) phase_prologue(p, smem, wg, nwg);
    else if constexpr (PH == PH_MOD_MIX) phase_modulate<0>(p, layer, rows_in, layer == 0, layer > 0, wg, nwg);
    else if constexpr (PH == PH_E2) phase_e2(p, smem, j, rows_in, wg, nwg);
    else if constexpr (PH == PH_E3) phase_e3(p, j, rows_in, wg, nwg);
    else if constexpr (PH == PH_E4) phase_e4(p, smem, j, rows_in, true, wg, nwg);
    else if constexpr (PH == PH_SCAN) phase_scan(p, smem, wg, nwg);
    else if constexpr (PH == PH_POST) phase_post(p, j, rows_out, wg, nwg);
    else if constexpr (PH == PH_WOUT) phase_resgemm(p, smem, WSP(bf16_t, OFF_HREG), (const bf16_t*)(wts + W_WOUT) + (size_t)j * 1024 * 1024, layer, rows_out, wg, nwg);
    else if constexpr (PH == PH_F1) phase_f1(p, smem, rows_out, wg, nwg);
    else if constexpr (PH == PH_F2) phase_f2(p, smem, ctx_out, wg, nwg);
    else if constexpr (PH == PH_F3) phase_f3(p, smem, wg, nwg);
    else if constexpr (PH == PH_WF) phase_resgemm(p, smem, WSP(bf16_t, OFF_RKVK), (const bf16_t*)(wts + W_WF) + (size_t)j * 1024 * 1024, layer, rows_out, wg, nwg);
    else if constexpr (PH == PH_MOD_FFN) phase_modulate<1>(p, layer, rows_out, false, false, wg, nwg);
    else if constexpr (PH == PH_ROUTER) phase_router(p, smem, layer, rows_out, wg, nwg);
    else if constexpr (PH == PH_MOE1) phase_moe1(p, smem, layer, wg, nwg);
    else if constexpr (PH == PH_MOE2) phase_moe2(p, smem, layer, wg, nwg);
    else if constexpr (PH == PH_FINAL) phase_modulate<2>(p, 4, NL, false, DIAG == 0, wg, nwg);
}

#if MEGA
__global__ void __launch_bounds__(256, 2) k_mega(Params p) {
    extern __shared__ __attribute__((aligned(16))) char smem[];
    if (threadIdx.x == 0) *(u32x4*)(smem + SM_BAR) = (u32x4){0u, 0u, 0u, 0u};
    __syncthreads();
    XcdBarrier bar = xcd_barrier_post(WSP(unsigned, OFF_BAR), (volatile LAS unsigned*)(smem + SM_BAR));
    const int wg = blockIdx.x, nwg = gridDim.x;
    do_phase<PH_PROLOGUE>(p, smem, 0, wg, nwg); xcd_barrier(bar);
    for (int layer = 0; layer < 4; ++layer) {
        do_phase<PH_MOD_MIX>(p, smem, layer, wg, nwg); xcd_barrier(bar);
        if ((layer & 1) == 0) {
            do_phase<PH_E2>(p, smem, layer, wg, nwg); xcd_barrier(bar);
            do_phase<PH_E3>(p, smem, layer, wg, nwg); xcd_barrier(bar);
            do_phase<PH_E4>(p, smem, layer, wg, nwg); xcd_barrier(bar);
            do_phase<PH_SCAN>(p, smem, layer, wg, nwg); xcd_barrier(bar);
            do_phase<PH_POST>(p, smem, layer, wg, nwg); xcd_barrier(bar);
            do_phase<PH_WOUT>(p, smem, layer, wg, nwg); xcd_barrier(bar);
        } else {
            do_phase<PH_F1>(p, smem, layer, wg, nwg); xcd_barrier(bar);
            do_phase<PH_F2>(p, smem, layer, wg, nwg); xcd_barrier(bar);
            do_phase<PH_F3>(p, smem, layer, wg, nwg); xcd_barrier(bar);
            do_phase<PH_WF>(p, smem, layer, wg, nwg); xcd_barrier(bar);
        }
        do_phase<PH_MOD_FFN>(p, smem, layer, wg, nwg); xcd_barrier(bar);
        do_phase<PH_ROUTER>(p, smem, layer, wg, nwg); xcd_barrier(bar);
        do_phase<PH_MOE1>(p, smem, layer, wg, nwg); xcd_barrier(bar);
        do_phase<PH_MOE2>(p, smem, layer, wg, nwg); xcd_barrier(bar);
    }
    do_phase<PH_FINAL>(p, smem, 4, wg, nwg);
}
#else
template <int PH>
__global__ void __launch_bounds__(256, 2) k_phase(Params p, int layer) {
    extern __shared__ __attribute__((aligned(16))) char smem[];
    do_phase<PH>(p, smem, layer, blockIdx.x, gridDim.x);
}
template <int PH> static void launch_phase(const Params& p, int layer, hipStream_t stream) {
    static bool attr = false;
    if (!attr) { (void)hipFuncSetAttribute((const void*)k_phase<PH>, hipFuncAttributeMaxDynamicSharedMemorySize, SMEM_BYTES); attr = true; }
    hipLaunchKernelGGL(k_phase<PH>, dim3(512), dim3(256), SMEM_BYTES, stream, p, layer);
}
#endif


#if DIAG >= 2
__global__ void k_census(Params p, int what) {
}
__global__ void k_census1(char* ws, size_t off, size_t nbytes, int isf32, int idx) {
    const unsigned* u = (const unsigned*)(ws + off); const size_t n = nbytes / 4; bool bad = false;
    for (size_t i = (size_t)blockIdx.x * 256 + threadIdx.x; i < n; i += (size_t)gridDim.x * 256) {
        const unsigned x = u[i];
        if (isf32) { if ((x & 0x7f800000u) >= (141u << 23)) bad = true; }
        else { if ((x & 0x7f80u) >= (141u << 7) || (x & 0x7f800000u) >= (141u << 23)) bad = true; }
    }
    if (bad) atomicOr((unsigned*)(ws + OFF_CNT) + 192, 1u << idx);
}
__global__ void k_report(Params p) {
    const unsigned f = *((const unsigned*)(p.ws + OFF_CNT) + 192);
    int idx = 0; for (int b = 1; b < 32; ++b) if (f & (1u << b)) { idx = b; break; }
    const float c = sqrtf(0.5f * (float)idx);
    for (size_t i = (size_t)blockIdx.x * 256 + threadIdx.x; i < (size_t)NL * 1024; i += (size_t)gridDim.x * 256) p.out[i] = c;
}
#endif

#if DIAG == 3
__global__ void __launch_bounds__(256, 2) k_gemmtest(Params p) {
    extern __shared__ __attribute__((aligned(16))) char smem[];
    bf16_t* A = WSP(bf16_t, OFF_PREG); bf16_t* B = A + 128 * 128; float* C = (float*)(B + 128 * 128);
    unsigned* cnt = (unsigned*)(p.ws + OFF_CNT) + 192;
    const int tid = threadIdx.x;
    for (int i = tid; i < 128 * 128; i += 256) { const int m = i >> 7, k = i & 127; A[i] = f2bf((float)(((m * 7 + k * 3) % 9) - 4)); B[i] = f2bf((float)(((m * 5 + k * 11) % 7) - 3)); }
    __threadfence(); __syncthreads();
    f32x4 acc[4][4];
    gemm_tile(smem, 2, APlain{A, 128, 0}, BPlain{B, 128}, acc);
    EPI_FOR(acc, { *(f32x4*)(C + (size_t)row * 128 + col) = v; });
    __threadfence(); __syncthreads();
    unsigned bad = 0, nonfin = 0, tr = 0;
    for (int i = tid; i < 128 * 128; i += 256) { const int m = i >> 7, n = i & 127; float s = 0.f, st = 0.f;
        for (int k = 0; k < 128; ++k) { s += bf2f(A[m * 128 + k]) * bf2f(B[k * 128 + n]); st += bf2f(A[n * 128 + k]) * bf2f(B[k * 128 + m]); }
        const float c = C[i]; if (c != s) ++bad; if (!(fabsf(c) < 3e38f)) ++nonfin; if (c == st) ++tr; }
    atomicAdd(cnt + 1, bad); atomicAdd(cnt + 2, nonfin); atomicAdd(cnt + 3, tr);
}
__global__ void k_report3(Params p) {
    const unsigned* cnt = (const unsigned*)(p.ws + OFF_CNT) + 192;
    float c2 = 8.f * (float)cnt[1] / 16384.f; if (cnt[2]) c2 += 20.f; if (cnt[3] > 8000) c2 += 50.f;
    const float c = sqrtf(c2);
    for (size_t i = (size_t)blockIdx.x * 256 + threadIdx.x; i < (size_t)NL * 1024; i += (size_t)gridDim.x * 256) p.out[i] = c;
}
#endif

#if DIAG == 4 || DIAG == 5
__device__ __forceinline__ bool close_(float a, float b, float tol) { return fabsf(a - b) <= tol * (1.f + fabsf(b)); }
__global__ void k_check(Params p) {
    unsigned* flag = (unsigned*)(p.ws + OFF_CNT) + 192;
    const float* mod = WSP(float, OFF_MOD); const bf16_t* H = WSP(bf16_t, OFF_HREG); const bf16_t* P = WSP(bf16_t, OFF_PREG); const bf16_t* LR1 = WSP(bf16_t, OFF_LR1);
    const bf16_t* WIN = (const bf16_t*)(p.ws + OFF_WTS + W_WIN); const bf16_t* WL1 = (const bf16_t*)(p.ws + OFF_WTS + W_LR1);
    const size_t gt = (size_t)blockIdx.x * 256 + threadIdx.x, gs = (size_t)gridDim.x * 256;
    unsigned bad = 0;
    for (size_t i = gt; i < 5 * 6144; i += gs) { const int mb = (int)(i / 6144), n = (int)(i % 6144); float s = 0.f;
        for (int k = 0; k < 1024; ++k) { const float cv = mb < 4 ? p.c[mb * 1024 + k] : p.c_ctx[k]; s += cv / (1.f + expf(-cv)) * p.ada_w[(size_t)k * 6144 + n]; }
        s += p.ada_b[n]; if (!close_(mod[(size_t)(mb * 4) * 6144 + n], s, 1e-3f)) bad |= 1u; }
    { const int rows[6] = {0, 1, 8191, 8192, NL, NT - 1};
      for (size_t i = gt; i < 6 * 1024; i += gs) { const int r = rows[i >> 10], c = (int)(i & 1023); const float* xr = r < NL ? p.x + (size_t)r * 1024 : p.ctx + (size_t)(r - NL) * 1024;
        float ss = 0.f; for (int k = 0; k < 1024; ++k) ss += xr[k] * xr[k]; const float rinv = 1.f / sqrtf(ss / 1024.f + 1e-6f); const int mb = r < NL ? r >> 13 : 4;
        const float h = xr[c] * rinv * p.norm_mix[c] * (1.f + mod[(size_t)(mb * 4) * 6144 + 1024 + c]) + mod[(size_t)(mb * 4) * 6144 + c];
        if (!close_(bf2f(H[(size_t)r * 1024 + c]), h, 2e-2f)) bad |= 2u; } }
    for (size_t i = gt; i < (size_t)1024 * 2048; i += gs) if (!close_(bf2f(WIN[i]), p.w_in[i], 1e-2f)) bad |= 4u;
    { const int rows[6] = {0, 1, 127, 128, 5000, NT - 1};
      for (size_t i = gt; i < 6 * 2048; i += gs) { const int r = rows[i >> 11], n = (int)(i & 2047); float s = 0.f;
        for (int k = 0; k < 1024; ++k) s += bf2f(H[(size_t)r * 1024 + k]) * bf2f(WIN[(size_t)k * 2048 + n]);
        if (!close_(bf2f(P[(size_t)r * 2048 + n]), s, 2e-2f)) bad |= 8u; } }
    { const int rows[6] = {0, 1, 63, 64, 8191, NT - 1};
      for (size_t i = gt; i < 6 * 384; i += gs) { const int r = rows[i / 384], n = (int)(i % 384); float s = 0.f;
        for (int k = 0; k < 1024; ++k) s += bf2f(H[(size_t)r * 1024 + k]) * bf2f(WL1[(size_t)k * 384 + n]);
        for (int k = 0; k < 1024; ++k) { const int sr = shift_src(r, k >> 8); if (sr >= 0) s += bf2f(H[(size_t)sr * 1024 + k]) * bf2f(WL1[(size_t)(1024 + k) * 384 + n]); }
        const float a = n < 128 ? tanhf(s) : (n < 256 ? s : 1.f / (1.f + expf(-s)));
        if (!close_(bf2f(LR1[(size_t)r * 384 + n]), a, 2e-2f)) bad |= 16u; } }
    if (bad) atomicOr(flag, bad);
}
__global__ void k_report4(Params p) {
    const unsigned f = *((const unsigned*)(p.ws + OFF_CNT) + 192);
    const float c = sqrtf(0.25f * (float)f);
    for (size_t i = (size_t)blockIdx.x * 256 + threadIdx.x; i < (size_t)NL * 1024; i += (size_t)gridDim.x * 256) p.out[i] = c;
}
#endif

#if DIAG == 5
__global__ void __launch_bounds__(256, 2) k_projtest(Params p) {
    extern __shared__ __attribute__((aligned(16))) char smem[];
    const bf16_t* H = WSP(bf16_t, OFF_HREG); const bf16_t* WIN = (const bf16_t*)(p.ws + OFF_WTS + W_WIN);
    float* C = WSP(float, OFF_PREG) + (size_t)blockIdx.x * 128 * 128;
    unsigned* flag = (unsigned*)(p.ws + OFF_CNT) + 192;
    const int m0s[4] = {0, 0, 128 * 263, 128 * 100}, n0s[4] = {0, 1920, 0, 640};
    const int m0 = m0s[blockIdx.x], n0 = n0s[blockIdx.x];
    f32x4 acc[4][4];
    gemm_tile(smem, 16, APlain{H, 1024, m0}, BPlain{WIN + n0, 2048}, acc);
    EPI_FOR(acc, { *(f32x4*)(C + (size_t)row * 128 + col) = v; });
    __threadfence(); __syncthreads();
    unsigned bad = 0;
    for (int i = threadIdx.x; i < 128 * 128; i += 256) { const int m = i >> 7, n = i & 127; float s = 0.f;
        for (int k = 0; k < 1024; ++k) s += bf2f(H[(size_t)(m0 + m) * 1024 + k]) * bf2f(WIN[(size_t)k * 2048 + n0 + n]);
        if (!(fabsf(C[i] - s) <= 1e-2f * (1.f + fabsf(s)))) bad = 1; }
    if (bad) atomicOr(flag, 1u << blockIdx.x);
}
#endif

extern "C" void kernel_launch(void* const* d_in, const int* in_sizes, int n_in, void* d_out, int out_size, void* d_ws, size_t ws_size, hipStream_t stream) {
    if (n_in != 36 || ws_size < WS_END) { fprintf(stderr, "kernel_launch: unexpected n_in %d or workspace %zu < %zu\n", n_in, ws_size, (size_t)WS_END); return; }
    Params p{};
    const float** pf = (const float**)&p;
    for (int i = 0; i < 36; ++i) pf[i] = (const float*)d_in[i];
    p.out = (float*)d_out; p.ws = (char*)d_ws;
    (void)hipMemsetAsync(d_ws, 0, ZERO_REGION, stream);
#if MEGA
    static int grid = 0;
    if (grid == 0) {
        int dev = 0, cus = 0, per_cu = 0;
        (void)hipGetDevice(&dev); (void)hipDeviceGetAttribute(&cus, hipDeviceAttributeMultiprocessorCount, dev);
        (void)hipFuncSetAttribute((const void*)k_mega, hipFuncAttributeMaxDynamicSharedMemorySize, SMEM_BYTES);
        (void)hipOccupancyMaxActiveBlocksPerMultiprocessor(&per_cu, (const void*)k_mega, 256, SMEM_BYTES);
        (void)hipGetLastError();
        if (per_cu < 1) per_cu = 1;
        grid = cus * (per_cu < 2 ? per_cu : 2);
    }
    hipLaunchKernelGGL(k_mega, dim3(grid), dim3(256), SMEM_BYTES, stream, p);
#else
#if DIAG == 1
    launch_phase<PH_MOD_MIX>(p, 0, stream); launch_phase<PH_FINAL>(p, 4, stream); return;
#endif
#if DIAG == 5
    launch_phase<PH_PROLOGUE>(p, 0, stream); launch_phase<PH_MOD_MIX>(p, 0, stream);
    (void)hipFuncSetAttribute((const void*)k_projtest, hipFuncAttributeMaxDynamicSharedMemorySize, SMEM_BYTES);
    hipLaunchKernelGGL(k_projtest, dim3(4), dim3(256), SMEM_BYTES, stream, p);
    hipLaunchKernelGGL(k_report4, dim3(1024), dim3(256), 0, stream, p); return;
#endif
#if DIAG == 4
    launch_phase<PH_PROLOGUE>(p, 0, stream); launch_phase<PH_MOD_MIX>(p, 0, stream); launch_phase<PH_E2>(p, 0, stream);
    hipLaunchKernelGGL(k_check, dim3(512), dim3(256), 0, stream, p);
    hipLaunchKernelGGL(k_report4, dim3(1024), dim3(256), 0, stream, p); return;
#endif
#if DIAG == 3
    (void)hipFuncSetAttribute((const void*)k_gemmtest, hipFuncAttributeMaxDynamicSharedMemorySize, SMEM_BYTES);
    hipLaunchKernelGGL(k_gemmtest, dim3(1), dim3(256), SMEM_BYTES, stream, p);
    hipLaunchKernelGGL(k_report3, dim3(1024), dim3(256), 0, stream, p); return;
#endif
#if DIAG == 2
#define CEN(off, bytes, isf, idx) hipLaunchKernelGGL(k_census1, dim3(1024), dim3(256), 0, stream, p.ws, (size_t)(off), (size_t)(bytes), isf, idx)
    launch_phase<PH_PROLOGUE>(p, 0, stream); launch_phase<PH_MOD_MIX>(p, 0, stream);
    CEN(OFF_MOD, 491520, 1, 1); CEN(OFF_HREG, (size_t)NT * 2048, 0, 2); CEN(OFF_WTS, W_END, 0, 3);
    launch_phase<PH_E2>(p, 0, stream);
    CEN(OFF_PREG, (size_t)NT * 4096, 0, 4); CEN(OFF_LR1, (size_t)NT * 768, 0, 5);
    launch_phase<PH_E3>(p, 0, stream);
    CEN(OFF_RKVK, (size_t)NT * 1024, 0, 6); CEN(OFF_RKVK + (size_t)NT * 1024, (size_t)NT * 1024, 0, 7); CEN(OFF_RKVK + (size_t)NT * 2048, (size_t)NT * 1024, 0, 8);
    CEN(OFF_RKVK + (size_t)NT * 3072, (size_t)NT * 1024, 0, 9); CEN(OFF_DIFF, (size_t)NT * 1024, 0, 10);
    launch_phase<PH_E4>(p, 0, stream);
    CEN(OFF_WREG, (size_t)NT * 4096, 1, 11); CEN(OFF_KD, (size_t)NT * 2048, 0, 12); CEN(OFF_BB, (size_t)NT * 2048, 0, 13); CEN(OFF_G, (size_t)NT * 1024, 0, 14);
    launch_phase<PH_SCAN>(p, 0, stream);
    CEN(OFF_PREG, (size_t)NT * 4096, 1, 15);
    launch_phase<PH_POST>(p, 0, stream);
    CEN(OFF_HREG, (size_t)NT * 2048, 0, 16);
    launch_phase<PH_WOUT>(p, 0, stream);
    CEN(OFF_RES, (size_t)NT * 4096, 1, 17);
    hipLaunchKernelGGL(k_report, dim3(1024), dim3(256), 0, stream, p); return;
#endif
    launch_phase<PH_PROLOGUE>(p, 0, stream);
    for (int layer = 0; layer < 4; ++layer) {
        launch_phase<PH_MOD_MIX>(p, layer, stream);
        if ((layer & 1) == 0) {
            launch_phase<PH_E2>(p, layer, stream); launch_phase<PH_E3>(p, layer, stream); launch_phase<PH_E4>(p, layer, stream);
            launch_phase<PH_SCAN>(p, layer, stream); launch_phase<PH_POST>(p, layer, stream); launch_phase<PH_WOUT>(p, layer, stream);
        } else {
            launch_phase<PH_F1>(p, layer, stream); launch_phase<PH_F2>(p, layer, stream); launch_phase<PH_F3>(p, layer, stream); launch_phase<PH_WF>(p, layer, stream);
        }
        launch_phase<PH_MOD_FFN>(p, layer, stream); launch_phase<PH_ROUTER>(p, layer, stream); launch_phase<PH_MOE1>(p, layer, stream); launch_phase<PH_MOE2>(p, layer, stream);
    }
    launch_phase<PH_FINAL>(p, 4, stream);
#endif
}
```

```cpp
#include <hip/hip_runtime.h>
#include <stdint.h>
#include <stdio.h>

#ifndef DIAG
#define DIAG 0
#endif
#ifndef CHUNKED
#define CHUNKED 1
#endif
#ifndef ROUTER_NK
#define ROUTER_NK 16
#endif
#ifndef MEGA
#define MEGA 1
#endif

typedef unsigned short bf16_t;
typedef short bf16x8 __attribute__((ext_vector_type(8)));
typedef short s16x4 __attribute__((ext_vector_type(4)));
typedef float f32x4 __attribute__((ext_vector_type(4)));
typedef unsigned u32x4 __attribute__((ext_vector_type(4)));
typedef unsigned u32x2 __attribute__((ext_vector_type(2)));
#define LAS __attribute__((address_space(3)))
#define GAS __attribute__((address_space(1)))

#define NL 32768
#define NCX 1024
#define NT 33792
#define DM 1024
#define TOKCAP NT
#define YM_ROWS 71680

#define MBY(x) ((size_t)(x) << 20)
constexpr size_t OFF_BAR = 0, OFF_CNT = 16384, OFF_ZERO = 16384 + 1024, ZERO_REGION = 32768;
constexpr size_t OFF_POFF = 32768, OFF_MOD = 65536;
constexpr size_t OFF_ROUTEI = MBY(1), OFF_ROUTEG = MBY(1) + 270336, OFF_TOKL = MBY(2);
constexpr size_t OFF_WTS = MBY(8);
constexpr size_t W_WIN = 0, W_WOUT = W_WIN + 8388608, W_WF = W_WOUT + 4194304, W_LR1 = W_WF + 4194304, W_LR2 = W_LR1 + 3145728,
                 W_POOL = W_LR2 + 786432, W_RW = W_POOL + 262144, W_DFTC = W_RW + 3145728, W_TW = W_DFTC + 262144, W_CS128 = W_TW + 4194304,
                 W_CS256 = W_CS128 + 65536, W_END = W_CS256 + 262144;
static_assert(W_END < MBY(32), "weights region");
constexpr size_t OFF_RES = MBY(40), OFF_HREG = MBY(172), OFF_PREG = MBY(238), OFF_LR1 = MBY(378), OFF_RKVK = MBY(403), OFF_DIFF = MBY(535),
                 OFF_WREG = MBY(568), OFF_KD = MBY(700), OFF_BB = MBY(766), OFF_G = MBY(836), WS_END = MBY(1001);
constexpr size_t OFF_W2 = OFF_RKVK + (size_t)3 * 33792 * 512 * 2;

struct Params {
    const float *x, *c, *ctx, *c_ctx, *ada_w, *ada_b, *norm_mix, *norm_ffn, *w_in, *mu_x, *mu_p, *decay_w0, *decay_w1, *decay_w2, *lr_a0, *lr_a1, *lr_a2,
        *gate_g1, *gate_g2, *k_k, *k_a, *r_k, *gn_w, *gn_b, *pool_w, *pool_scale, *w_out, *w_fourier, *router_c, *router_c_b, *router_f, *router_f_b,
        *moe_w1, *moe_w3, *moe_w2, *final_norm;
    float* out;
    char* ws;
};

typedef float f32x2_ __attribute__((ext_vector_type(2)));
typedef __bf16 bf16x2_ __attribute__((ext_vector_type(2)));
__device__ __forceinline__ unsigned pk2(float lo, float hi) { const f32x2_ v = {lo, hi}; const bf16x2_ r = __builtin_convertvector(v, bf16x2_); return __builtin_bit_cast(unsigned, r); }
__device__ __forceinline__ bf16_t f2bf(float f) { return (bf16_t)(pk2(f, 0.f) & 0xffffu); }
__device__ __forceinline__ float bf2f(bf16_t h) { return __uint_as_float((unsigned)h << 16); }
__device__ __forceinline__ float bflo(unsigned u) { return __uint_as_float(u << 16); }
__device__ __forceinline__ float bfhi(unsigned u) { return __uint_as_float(u & 0xffff0000u); }
__device__ __forceinline__ float rl_(float x, int l) { return __builtin_bit_cast(float, __builtin_amdgcn_readlane(__builtin_bit_cast(int, x), l)); }
template <int CTRL> __device__ __forceinline__ float dppf(float v) { return __builtin_bit_cast(float, __builtin_amdgcn_update_dpp(0, __builtin_bit_cast(int, v), CTRL, 0xf, 0xf, true)); }
__device__ __forceinline__ float sum8(float v) { v += dppf<0xB1>(v); v += dppf<0x4E>(v); v += dppf<0x141>(v); return v; }
__device__ __forceinline__ float sum16(float v) { v += dppf<0xB1>(v); v += dppf<0x4E>(v); v += dppf<0x141>(v); v += dppf<0x140>(v); return v; }
__device__ __forceinline__ float wave_sum(float v) {
    v += dppf<0xB1>(v); v += dppf<0x4E>(v); v += dppf<0x141>(v); v += dppf<0x140>(v);
    return (rl_(v, 0) + rl_(v, 16)) + (rl_(v, 32) + rl_(v, 48));
}
__device__ __forceinline__ float fexp(float x) { return __builtin_amdgcn_exp2f(x * 1.44269504089f); }
__device__ __forceinline__ float frcp(float x) { return __builtin_amdgcn_rcpf(x); }
__device__ __forceinline__ float frsq(float x) { return __builtin_amdgcn_rsqf(x); }
__device__ __forceinline__ float sigmoidf_(float x) { return frcp(1.f + fexp(-x)); }
__device__ __forceinline__ float tanhf_(float x) { return 1.f - 2.f * frcp(fexp(2.f * x) + 1.f); }
__device__ __forceinline__ int shift_src(int r, int q) {
    if (r < NL) {
        const int t = r & 8191, col = t & 63, row = t >> 6;
        if (q == 0) return col > 0 ? r - 1 : -1;
        if (q == 1) return col < 63 ? r + 1 : -1;
        if (q == 2) return row > 0 ? r - 64 : -1;
        return row < 127 ? r + 64 : -1;
    } else {
        const int t = (r - NL) & 255;
        if (q < 2) return t > 0 ? r - 1 : -1;
        return t < 255 ? r + 1 : -1;
    }
}

__device__ __forceinline__ int ltid() { int t = threadIdx.x; asm volatile("" : "+v"(t)); return t; }

#define XB_TMO      128
#define XB_XCNT(j)  (256  + 64 * (j))
#define XB_XSUB(j)  (1280 + 64 * (j))
#define XB_XGEN(j)  (2304 + 64 * (j))
#define XB_TOP      3328
#define XB_TOPGEN   3392
#define XCD_BAR_WORDS 3456
#define XB_SPIN_CAP (1u << 22)
__device__ __forceinline__ unsigned xb_ld(unsigned* p)              { return __hip_atomic_load(p, __ATOMIC_RELAXED, __HIP_MEMORY_SCOPE_AGENT); }
__device__ __forceinline__ unsigned xb_add(unsigned* p, unsigned v) { return __hip_atomic_fetch_add(p, v, __ATOMIC_RELAXED, __HIP_MEMORY_SCOPE_AGENT); }
__device__ __forceinline__ unsigned xb_xcc_id() { return (unsigned)__builtin_amdgcn_s_getreg((3 << 11) | 20) & 0xFu; }
#define XB_SPIN(cond, bar) do { unsigned _sp = 0; while (cond) { __builtin_amdgcn_s_sleep(1); \
    if ((++_sp & 255u) == 0u) { if (xb_ld(&(bar)[XB_TMO])) break; if (_sp > XB_SPIN_CAP) { atomicAdd(&(bar)[XB_TMO], 1u); break; } } } } while (0)
struct XcdBarrier { unsigned* bar; unsigned x; volatile LAS unsigned* st; };
__device__ __forceinline__ XcdBarrier xcd_barrier_post(unsigned* bar, volatile LAS unsigned* st) {
    XcdBarrier b; b.bar = bar; b.x = xb_xcc_id(); b.st = st;
    if (threadIdx.x == 0) (void)xb_add(&bar[XB_XCNT(b.x)], 1u);
    return b;
}
__device__ __forceinline__ void xcd_barrier_complete(unsigned* bar, unsigned x, unsigned& nloc, unsigned& nx) {
    const unsigned G = gridDim.x * gridDim.y * gridDim.z;
    unsigned sum, cnt, mine, sp = 0u;
    for (;;) {
        sum = 0u; cnt = 0u; mine = 0u;
#pragma unroll
        for (unsigned j = 0; j < 16; ++j) { const unsigned c = xb_ld(&bar[XB_XCNT(j)]); sum += c; cnt += (c > 0u) ? 1u : 0u; mine = (j == x) ? c : mine; }
        if (sum == G) break;
        __builtin_amdgcn_s_sleep(1);
        if ((++sp & 255u) == 0u) { if (xb_ld(&bar[XB_TMO])) break; if (sp > XB_SPIN_CAP) { atomicAdd(&bar[XB_TMO], 1u); break; } }
    }
    nloc = mine > 0u ? mine : 1u; nx = cnt > 0u ? cnt : 1u;
}
__device__ __forceinline__ void xcd_barrier(const XcdBarrier& b) {
    asm volatile("s_waitcnt vmcnt(0)" ::: "memory");
    __syncthreads();
    if (threadIdx.x == 0) {
        unsigned* bar = b.bar;
        __builtin_amdgcn_s_waitcnt(0);
        unsigned nloc = b.st[0], nx = b.st[1];
        if (nloc == 0u) { xcd_barrier_complete(bar, b.x, nloc, nx); b.st[0] = nloc; b.st[1] = nx; }
        const unsigned old = xb_add(&bar[XB_XSUB(b.x)], 1u);
        const unsigned gen = old / nloc;
        if (old + 1u == (gen + 1u) * nloc) {
            __builtin_amdgcn_fence(__ATOMIC_RELEASE, "agent");
            asm volatile("s_waitcnt vmcnt(0)" ::: "memory");
            const unsigned og = xb_add(&bar[XB_TOP], 1u);
            const unsigned tg = og / nx;
            if (og + 1u == (tg + 1u) * nx) xb_add(&bar[XB_TOPGEN], 1u);
            else XB_SPIN(xb_ld(&bar[XB_TOPGEN]) == tg, bar);
            __builtin_amdgcn_fence(__ATOMIC_ACQUIRE, "agent");
            xb_add(&bar[XB_XGEN(b.x)], 1u);
            asm volatile("s_waitcnt vmcnt(0)" ::: "memory");
        } else {
            XB_SPIN(xb_ld(&bar[XB_XGEN(b.x)]) == gen, bar);
            __builtin_amdgcn_fence(__ATOMIC_ACQUIRE, "agent");
            asm volatile("s_waitcnt vmcnt(0)" ::: "memory");
        }
    }
    __syncthreads();
}

#define G_ABYTES (128 * 128)
#define G_BBYTES (64 * 256)
#define G_STAGE (G_ABYTES + G_BBYTES)
#define SM_BAR 73728
#define SM_TAB (SM_BAR + 16)
#define SMEM_BYTES (SM_TAB + 512)
__device__ __forceinline__ int bswz(int k) { return ((k & 3) << 2) | ((k >> 2) & 3); }

__device__ __forceinline__ void glds16_asm(const void* gsrc, unsigned lds_dst) {
    unsigned keep;
    asm volatile("s_mov_b32 %0, m0\n\ts_mov_b32 m0, %2\n\ts_nop 0\n\tglobal_load_lds_dwordx4 %1, off\n\ts_mov_b32 m0, %0" : "=&s"(keep) : "v"(gsrc), "s"(lds_dst) : "memory");
}
template <class AF, class BF>
__device__ __forceinline__ void gemm_tile(char* smem, int nk, const AF& af, const BF& bf, f32x4 (&acc)[4][4]) {
    const int tid = ltid(), lane = tid & 63, wid = tid >> 6, wm = wid >> 1, wn = wid & 1;
#pragma unroll
    for (int i = 0; i < 4; ++i)
#pragma unroll
        for (int j = 0; j < 4; ++j) acc[i][j] = (f32x4){0.f, 0.f, 0.f, 0.f};
    const int arow = tid >> 3, akc = (((tid & 7) ^ (arow & 7)) << 3), brow = tid >> 4, bnc = (((tid & 15) ^ bswz(brow)) << 3);
    int ainfo[4];
#pragma unroll
    for (int i = 0; i < 4; ++i) ainfo[i] = af.info(arow + 32 * i);
    const unsigned lds0 = (unsigned)__builtin_amdgcn_readfirstlane((int)((unsigned)(size_t)smem + (unsigned)(wid * 1024)));
    auto issue = [&](int kt, int buf) {
        const unsigned dst = lds0 + (unsigned)(buf * G_STAGE);
#pragma unroll
        for (int i = 0; i < 4; ++i) glds16_asm(af.ptr(ainfo[i], arow + 32 * i, kt * 64 + akc), dst + i * 4096);
#pragma unroll
        for (int i = 0; i < 4; ++i) glds16_asm(bf.ptr(kt * 64 + brow + 16 * i, bnc), dst + G_ABYTES + i * 4096);
    };
    const int ar = wm * 64 + (lane & 15), ax = lane & 7, ag = lane >> 4;
    const int bg = lane >> 4, bq = (lane & 15) >> 2, bp = lane & 3;
    __syncthreads();
    issue(0, 0);
    asm volatile("s_waitcnt vmcnt(0)" ::: "memory");
    __syncthreads();
    for (int kt = 0; kt < nk; ++kt) {
        if (kt + 1 < nk) issue(kt + 1, (kt + 1) & 1);
        const char* sa = smem + (kt & 1) * G_STAGE; const char* sb = sa + G_ABYTES;
#pragma unroll
        for (int ks = 0; ks < 2; ++ks) {
            bf16x8 a[4], b[4];
#pragma unroll
            for (int mt = 0; mt < 4; ++mt) a[mt] = *(const bf16x8*)(sa + (ar + mt * 16) * 128 + (((4 * ks + ag) ^ ax) << 4));
#pragma unroll
            for (int nt = 0; nt < 4; ++nt) {
                const int c2 = 2 * (wn * 4 + nt) + (bp >> 1);
                const int k0 = 32 * ks + 8 * bg + bq, k1 = k0 + 4;
                const s16x4 lo = __builtin_amdgcn_ds_read_tr16_b64_v4i16((LAS s16x4*)(sb + k0 * 256 + ((c2 ^ bswz(k0)) << 4) + 8 * (bp & 1)));
                const s16x4 hi = __builtin_amdgcn_ds_read_tr16_b64_v4i16((LAS s16x4*)(sb + k1 * 256 + ((c2 ^ bswz(k1)) << 4) + 8 * (bp & 1)));
                b[nt] = __builtin_shufflevector(lo, hi, 0, 1, 2, 3, 4, 5, 6, 7);
            }
            __builtin_amdgcn_s_setprio(1);
#pragma unroll
            for (int mt = 0; mt < 4; ++mt)
#pragma unroll
                for (int nt = 0; nt < 4; ++nt) acc[mt][nt] = __builtin_amdgcn_mfma_f32_16x16x32_bf16(b[nt], a[mt], acc[mt][nt], 0, 0, 0);
            __builtin_amdgcn_s_setprio(0);
        }
        asm volatile("s_waitcnt vmcnt(0)" ::: "memory");
        __syncthreads();
    }
}
#define EPI_FOR(acc, ...) do { const int _l = ltid() & 63, _w = ltid() >> 6, _wm = _w >> 1, _wn = _w & 1; \
    _Pragma("unroll") for (int _mt = 0; _mt < 4; ++_mt) _Pragma("unroll") for (int _nt = 0; _nt < 4; ++_nt) { \
        const int row = _wm * 64 + _mt * 16 + (_l & 15), col = _wn * 64 + _nt * 16 + 4 * (_l >> 4); const f32x4 v = acc[_mt][_nt]; __VA_ARGS__ } } while (0)

__device__ __forceinline__ void st_bf4(bf16_t* p, f32x4 v) { u32x2 w; w.x = pk2(v[0], v[1]); w.y = pk2(v[2], v[3]); *(u32x2*)p = w; }

struct W2Conv {
    const float* src; bf16_t* dst; int nslices, wg, nwg; f32x4 r[8];
    static constexpr size_t N4 = (size_t)32 * 512 * 1024 / 4;
    __device__ __forceinline__ size_t item(int i, int k) const { return ((size_t)(k * nslices + i) * nwg + wg) * 256 + ltid(); }
    __device__ __forceinline__ void load(int i) {
        if (i >= nslices) return;
#pragma unroll
        for (int k = 0; k < 8; ++k) { const size_t it = item(i, k); if (it < N4) r[k] = *(const f32x4*)(src + 4 * it); }
    }
    __device__ __forceinline__ void store(int i) {
        if (i >= nslices) return;
#pragma unroll
        for (int k = 0; k < 8; ++k) { const size_t it = item(i, k); if (it < N4) st_bf4(dst + 4 * it, r[k]); }
    }
};

struct APlain { const bf16_t* base; int lda; int m0; __device__ __forceinline__ int info(int row) const { return m0 + row; }
    __device__ __forceinline__ const bf16_t* ptr(int gr, int, int k) const { return base + (size_t)gr * lda + k; } };
struct BPlain { const bf16_t* base; int ldb; __device__ __forceinline__ const bf16_t* ptr(int k, int n) const { return base + (size_t)k * ldb + n; } };

enum { PH_PROLOGUE = 0, PH_MOD_MIX, PH_E2, PH_E3, PH_E4, PH_SCAN, PH_POST, PH_WOUT, PH_F1, PH_F2, PH_F3, PH_WF, PH_MOD_FFN, PH_ROUTER, PH_MOE1, PH_MOE2, PH_FINAL, PH_SCANV, PH_ROUTERV, PH_WOUTV, PH_S1A, PH_S2A, PH_S1B, PH_S2B, PH_FFNR };

#ifndef SCANVAR
#define SCANVAR 0
#endif

#define WSP(T, off) ((T*)(p.ws + (off)))

__device__ __forceinline__ void phase_prologue(const Params& p, char* smem, int wg, int nwg) {
    const int tid = ltid(), lane = tid & 63, wv = tid >> 6;
    float* S = (float*)smem;
    float* RED = S + 5 * 1024;
    for (int idx = tid; idx < 5 * 1024; idx += 256) { const int rb = idx >> 10, k = idx & 1023; const float cv = rb < 4 ? p.c[rb * 1024 + k] : p.c_ctx[k]; S[idx] = cv / (1.f + expf(-cv)); }
    __syncthreads();
    float* mod = WSP(float, OFF_MOD);
    for (int task = wg; task < 384; task += nwg) {
        const int i = task / 96, n0 = (task % 96) * 64;
        const float* W = p.ada_w + (size_t)i * 1024 * 6144 + n0 + lane;
        float a0 = 0.f, a1 = 0.f, a2 = 0.f, a3 = 0.f, a4 = 0.f;
        for (int k = wv * 256; k < wv * 256 + 256; k += 8) {
            float w[8];
#pragma unroll
            for (int u = 0; u < 8; ++u) w[u] = W[(size_t)(k + u) * 6144];
#pragma unroll
            for (int u = 0; u < 8; ++u) { a0 += S[k + u] * w[u]; a1 += S[1024 + k + u] * w[u]; a2 += S[2048 + k + u] * w[u]; a3 += S[3072 + k + u] * w[u]; a4 += S[4096 + k + u] * w[u]; }
        }
        RED[(wv * 5 + 0) * 64 + lane] = a0; RED[(wv * 5 + 1) * 64 + lane] = a1; RED[(wv * 5 + 2) * 64 + lane] = a2; RED[(wv * 5 + 3) * 64 + lane] = a3; RED[(wv * 5 + 4) * 64 + lane] = a4;
        __syncthreads();
        for (int o = tid; o < 320; o += 256) { const int r = o >> 6, l = o & 63;
            const float s = RED[(0 * 5 + r) * 64 + l] + RED[(1 * 5 + r) * 64 + l] + RED[(2 * 5 + r) * 64 + l] + RED[(3 * 5 + r) * 64 + l];
            mod[(size_t)(r * 4 + i) * 6144 + n0 + l] = s + p.ada_b[i * 6144 + n0 + l]; }
        __syncthreads();
    }
    const size_t gt = (size_t)wg * 256 + tid, gs = (size_t)nwg * 256;
    char* wts = p.ws + OFF_WTS;
    auto cast4 = [&](const float* src, bf16_t* dst, size_t n4) { for (size_t i = gt; i < n4; i += gs) { const f32x4 v = *(const f32x4*)(src + 4 * i); st_bf4(dst + 4 * i, v); } };
    cast4(p.w_in, (bf16_t*)(wts + W_WIN), (size_t)2 * 1024 * 2048 / 4);
    cast4(p.w_out, (bf16_t*)(wts + W_WOUT), (size_t)2 * 1024 * 1024 / 4);
    cast4(p.w_fourier, (bf16_t*)(wts + W_WF), (size_t)2 * 1024 * 1024 / 4);
    cast4(p.pool_w, (bf16_t*)(wts + W_POOL), (size_t)2 * 512 * 128 / 4);
    {
        bf16_t* d = (bf16_t*)(wts + W_LR1);
        for (size_t i = gt; i < (size_t)2 * 2048 * 384; i += gs) {
            const int n = (int)(i % 384), kk = (int)((i / 384) % 2048), j = (int)(i / (384 * 2048)); const int k = kk & 1023;
            float w, mu;
            if (n < 128) { const int dd = n >> 6; w = p.decay_w1[((size_t)(j * 2 + dd) * 1024 + k) * 64 + (n & 63)]; mu = p.mu_x[(j * 3 + 0) * 1024 + k]; }
            else if (n < 256) { const int dd = (n - 128) >> 6; w = p.lr_a1[((size_t)(j * 2 + dd) * 1024 + k) * 64 + (n & 63)]; mu = p.mu_x[(j * 3 + 1) * 1024 + k]; }
            else { w = p.gate_g1[((size_t)j * 1024 + k) * 128 + (n - 256)]; mu = p.mu_x[(j * 3 + 2) * 1024 + k]; }
            d[i] = f2bf(kk < 1024 ? (1.f - mu) * w : mu * w);
        }
    }
    {
        bf16_t* d = (bf16_t*)(wts + W_LR2);
        for (size_t i = gt; i < (size_t)2 * 384 * 512; i += gs) {
            const int n = (int)(i % 512), k = (int)((i / 512) % 384), j = (int)(i / (512 * 384));
            float w;
            if (k < 128) w = p.decay_w2[((size_t)(j * 2 + (k >> 6)) * 64 + (k & 63)) * 512 + n];
            else if (k < 256) w = p.lr_a2[((size_t)(j * 2 + ((k - 128) >> 6)) * 64 + (k & 63)) * 512 + n];
            else w = p.gate_g2[((size_t)j * 128 + (k - 256)) * 512 + n];
            d[i] = f2bf(w);
        }
    }
    {
        uint32_t* d = (uint32_t*)(wts + W_RW);
        for (size_t i = gt; i < (size_t)4 * 4608 * 4; i += gs) {
            const int l = (int)(i / 18432), q = (int)(i % 18432) >> 2, k = (int)(i & 3);
            float w0, w1;
            if (q < 4096) { const int ln = q & 63, hf = (q >> 6) & 1, pp = (q >> 7) & 7, gi = q >> 10; const int c0 = 4 * ln + 256 * (pp >> 1) + 2 * (pp & 1), x = gi * 8 + hf * 4 + k;
                w0 = p.router_f[((size_t)l * 1024 + c0) * 32 + x]; w1 = p.router_f[((size_t)l * 1024 + c0 + 1) * 32 + x]; }
            else { const int q2 = q - 4096, ln = q2 & 63, pp = q2 >> 6; const int c0 = 4 * ln + 256 * (pp >> 1) + 2 * (pp & 1);
                w0 = p.router_c[((size_t)l * 1024 + c0) * 4 + k]; w1 = p.router_c[((size_t)l * 1024 + c0 + 1) * 4 + k]; }
            d[i] = pk2(w0, w1);
        }
    }
    {
        bf16_t* d = (bf16_t*)(wts + W_DFTC);
        for (size_t i = gt; i < (size_t)256 * 512; i += gs) { const int n = (int)(i & 511), c = (int)(i >> 9); const int idx = (c * (n & 255)) & 255; float sn, cs; sincospif((float)idx / 128.f, &sn, &cs); d[i] = f2bf(n < 256 ? cs : -sn); }
    }
    {
        bf16_t* d = (bf16_t*)(wts + W_TW);
        for (size_t i = gt; i < (size_t)128 * 128 * 128; i += gs) {
            const int col = (int)(i & 127), row = (int)((i >> 7) & 127), t2 = (int)(i >> 14);
            const int pp = row >> 6, f1 = row & 63, pi = col >> 6, t1 = col & 63; const int idx = (t1 * f1 * 128 + t2 * f1) & 8191;
            float sn, cs; sincospif((float)idx / 4096.f, &sn, &cs);
            d[i] = f2bf(pp == 0 ? (pi == 0 ? cs : sn) : (pi == 0 ? -sn : cs));
        }
    }
    {
        bf16_t* d = (bf16_t*)(wts + W_CS128);
        for (size_t i = gt; i < (size_t)128 * 256; i += gs) { const int col = (int)(i & 255), f2 = (int)(i >> 8); const int pi = col >> 7, t2 = col & 127, idx = (t2 * f2) & 127; float sn, cs; sincospif((float)idx / 64.f, &sn, &cs); d[i] = f2bf(pi == 0 ? cs : sn); }
    }
    {
        bf16_t* d = (bf16_t*)(wts + W_CS256);
        for (size_t i = gt; i < (size_t)256 * 512; i += gs) { const int col = (int)(i & 511), f = (int)(i >> 9); const int pi = col >> 8, t = col & 255, idx = (t * f) & 255; float sn, cs; sincospif((float)idx / 128.f, &sn, &cs); d[i] = f2bf(pi == 0 ? cs : sn); }
    }
}

template <int MODE>
__device__ __forceinline__ void phase_modulate(const Params& p, int layer, int nrows, bool first, bool combine, int wg, int nwg) {
    const int lane = ltid() & 63, wv = ltid() >> 6;
    float* RES = WSP(float, OFF_RES);
    const float* mod = WSP(float, OFF_MOD);
    bf16_t* H = WSP(bf16_t, OFF_HREG); bf16_t* HLO = WSP(bf16_t, OFF_KD);
    const bf16_t* YM = WSP(bf16_t, OFF_PREG);
    const int* routei = WSP(int, OFF_ROUTEI); const float* routeg = WSP(float, OFF_ROUTEG);
    const int* poff = WSP(int, OFF_POFF) + (MODE == 2 ? 3 : layer - 1) * 64;
    const int lprev = MODE == 2 ? 3 : layer - 1;
    for (int r = wg * 4 + wv; r < nrows; r += nwg * 4) {
        const float* src = first ? (r < NL ? p.x + (size_t)r * 1024 : p.ctx + (size_t)(r - NL) * 1024) : RES + (size_t)r * 1024;
        f32x4 v[4];
#pragma unroll
        for (int j = 0; j < 4; ++j) v[j] = *(const f32x4*)(src + 4 * lane + 256 * j);
        const int mb = r < NL ? (r >> 13) : 4;
        if (combine) {
            const int i0 = routei[2 * r], i1 = routei[2 * r + 1]; const float g0 = routeg[2 * r], g1 = routeg[2 * r + 1];
            const size_t row0 = (size_t)poff[i0 & 31] + (i0 >> 5), row1 = (size_t)poff[i1 & 31] + (i1 >> 5);
            const float* m5 = mod + (size_t)(mb * 4 + lprev) * 6144 + 5 * 1024;
#pragma unroll
            for (int j = 0; j < 4; ++j) {
                const u32x2 y0 = *(const u32x2*)(YM + row0 * 1024 + 4 * lane + 256 * j), y1 = *(const u32x2*)(YM + row1 * 1024 + 4 * lane + 256 * j);
                const f32x4 g = *(const f32x4*)(m5 + 4 * lane + 256 * j);
                v[j][0] += g[0] * (g0 * bflo(y0.x) + g1 * bflo(y1.x)); v[j][1] += g[1] * (g0 * bfhi(y0.x) + g1 * bfhi(y1.x));
                v[j][2] += g[2] * (g0 * bflo(y0.y) + g1 * bflo(y1.y)); v[j][3] += g[3] * (g0 * bfhi(y0.y) + g1 * bfhi(y1.y));
            }
        }
        if (combine && MODE != 2) {
#pragma unroll
            for (int j = 0; j < 4; ++j) *(f32x4*)(RES + (size_t)r * 1024 + 4 * lane + 256 * j) = v[j];
        }
        float ss = 0.f;
#pragma unroll
        for (int j = 0; j < 4; ++j) ss += (v[j][0] * v[j][0] + v[j][1] * v[j][1]) + (v[j][2] * v[j][2] + v[j][3] * v[j][3]);
        ss = wave_sum(ss);
        const float rinv = frsq(ss * (1.f / 1024.f) + 1e-6f);
        if (MODE == 2) {
#if DIAG
            if (!(ss < 3.0e38f)) {
#pragma unroll
                for (int j = 0; j < 4; ++j) *(f32x4*)(p.out + (size_t)r * 1024 + 4 * lane + 256 * j) = (f32x4){3.f, 3.f, 3.f, 3.f};
                continue;
            }
#endif
#pragma unroll
            for (int j = 0; j < 4; ++j) { const f32x4 g = *(const f32x4*)(p.final_norm + 4 * lane + 256 * j); f32x4 o; o[0] = v[j][0] * rinv * g[0]; o[1] = v[j][1] * rinv * g[1]; o[2] = v[j][2] * rinv * g[2]; o[3] = v[j][3] * rinv * g[3];
                *(f32x4*)(p.out + (size_t)r * 1024 + 4 * lane + 256 * j) = o; }
        } else {
            const float* gn = (MODE == 0 ? p.norm_mix : p.norm_ffn) + layer * 1024;
            const float* sh = mod + (size_t)(mb * 4 + layer) * 6144 + (MODE == 0 ? 0 : 3) * 1024;
            const float* sc = sh + 1024;
#pragma unroll
            for (int j = 0; j < 4; ++j) {
                const int c = 4 * lane + 256 * j;
                const f32x4 g = *(const f32x4*)(gn + c), s1 = *(const f32x4*)(sh + c), s2 = *(const f32x4*)(sc + c);
                f32x4 h;
#pragma unroll
                for (int e = 0; e < 4; ++e) h[e] = (v[j][e] * rinv * g[e]) * (1.f + s2[e]) + s1[e];
                u32x2 w; w.x = pk2(h[0], h[1]); w.y = pk2(h[2], h[3]);
                *(u32x2*)(H + (size_t)r * 1024 + c) = w;
                if (MODE == 1 && ROUTER_NK > 32) { u32x2 w2; w2.x = pk2(h[0] - bflo(w.x), h[1] - bfhi(w.x)); w2.y = pk2(h[2] - bflo(w.y), h[3] - bfhi(w.y)); *(u32x2*)(HLO + (size_t)r * 1024 + c) = w2; }
            }
        }
    }
}


template <int MODE, bool COMBINE>
__device__ __forceinline__ void phase_modpipe(const Params& p, int layer, int nrows, int wg, int nwg) {
    const int tid = ltid(), lane = tid & 63, wv = __builtin_amdgcn_readfirstlane(tid >> 6);
    float* RES = WSP(float, OFF_RES);
    const float* mod = WSP(float, OFF_MOD);
    bf16_t* H = WSP(bf16_t, OFF_HREG);
    const bf16_t* YM = WSP(bf16_t, OFF_PREG);
    const int* routei = WSP(int, OFF_ROUTEI); const float* routeg = WSP(float, OFF_ROUTEG);
    const int lprev = MODE == 2 ? 3 : layer - 1;
    int poffv = 0;
    if (COMBINE) poffv = (WSP(int, OFF_POFF) + lprev * 64)[lane & 31];
    const int rstep = nwg * 4, rlast = nrows - 1;
    int r = wg * 4 + wv;
    if (r >= nrows) return;
    const float* gn = MODE == 2 ? p.final_norm : p.norm_mix + layer * 1024;
    f32x4 A[4], B[4], G5[4]; int mbc = -1;
    u32x2 ri[2] = {{0u, 0u}, {0u, 0u}}; f32x2_ rg[2] = {{0.f, 0.f}, {0.f, 0.f}};
    f32x4 v[2][4]; u32x2 ya[2][4], yb[2][4]; float g0[2] = {0.f, 0.f}, g1[2] = {0.f, 0.f};
#define MP_SRC(rr) (COMBINE ? RES + (size_t)(rr) * 1024 : ((rr) < NL ? p.x + (size_t)(rr) * 1024 : p.ctx + (size_t)((rr) - NL) * 1024))
#define MP_ISSUE(rr, Q) do { \
        const float* src_ = MP_SRC(rr); \
        _Pragma("unroll") for (int j = 0; j < 4; ++j) v[Q][j] = *(const f32x4*)(src_ + 4 * lane + 256 * j); \
        if (COMBINE) { const int i0 = __builtin_amdgcn_readfirstlane((int)ri[Q].x), i1 = __builtin_amdgcn_readfirstlane((int)ri[Q].y); \
            const size_t row0 = (size_t)__builtin_amdgcn_readlane(poffv, i0 & 31) + (i0 >> 5), row1 = (size_t)__builtin_amdgcn_readlane(poffv, i1 & 31) + (i1 >> 5); \
            _Pragma("unroll") for (int j = 0; j < 4; ++j) { ya[Q][j] = *(const u32x2*)(YM + row0 * 1024 + 4 * lane + 256 * j); yb[Q][j] = *(const u32x2*)(YM + row1 * 1024 + 4 * lane + 256 * j); } \
            g0[Q] = rg[Q].x; g1[Q] = rg[Q].y; } } while (0)
    if (COMBINE) { ri[0] = *(const u32x2*)(routei + 2 * r); rg[0] = *(const f32x2_*)(routeg + 2 * r);
        const int r1 = min(r + rstep, rlast); ri[1] = *(const u32x2*)(routei + 2 * r1); rg[1] = *(const f32x2_*)(routeg + 2 * r1); }
    MP_ISSUE(r, 0);
#define MP_STEP(Q) { \
        if (r >= nrows) break; \
        const int mb = r < NL ? (r >> 13) : 4; \
        if (mb != mbc) { mbc = mb; \
            const float* sh = mod + (size_t)(mb * 4 + layer) * 6144; const float* sc = sh + 1024; \
            const float* m5 = mod + (size_t)(mb * 4 + lprev) * 6144 + 5 * 1024; \
            _Pragma("unroll") for (int j = 0; j < 4; ++j) { const int c = 4 * lane + 256 * j; const f32x4 g = *(const f32x4*)(gn + c); \
                if (COMBINE) G5[j] = *(const f32x4*)(m5 + c); \
                if (MODE == 2) A[j] = g; \
                else { const f32x4 s1 = *(const f32x4*)(sh + c), s2 = *(const f32x4*)(sc + c); \
                    _Pragma("unroll") for (int e = 0; e < 4; ++e) { A[j][e] = g[e] * (1.f + s2[e]); B[j][e] = s1[e]; } } } \
        } \
        { const int r1 = min(r + rstep, rlast); MP_ISSUE(r1, 1 - (Q)); }                    \
        if (COMBINE) { const int r2 = min(r + 2 * rstep, rlast); ri[Q] = *(const u32x2*)(routei + 2 * r2); rg[Q] = *(const f32x2_*)(routeg + 2 * r2); }     \
        __builtin_amdgcn_sched_barrier(0); \
        if (COMBINE) { \
            _Pragma("unroll") for (int j = 0; j < 4; ++j) { \
                v[Q][j][0] += G5[j][0] * (g0[Q] * bflo(ya[Q][j].x) + g1[Q] * bflo(yb[Q][j].x)); v[Q][j][1] += G5[j][1] * (g0[Q] * bfhi(ya[Q][j].x) + g1[Q] * bfhi(yb[Q][j].x)); \
                v[Q][j][2] += G5[j][2] * (g0[Q] * bflo(ya[Q][j].y) + g1[Q] * bflo(yb[Q][j].y)); v[Q][j][3] += G5[j][3] * (g0[Q] * bfhi(ya[Q][j].y) + g1[Q] * bfhi(yb[Q][j].y)); \
            } \
            if (MODE != 2) { _Pragma("unroll") for (int j = 0; j < 4; ++j) *(f32x4*)(RES + (size_t)r * 1024 + 4 * lane + 256 * j) = v[Q][j]; } \
        } \
        float ss = 0.f; \
        _Pragma("unroll") for (int j = 0; j < 4; ++j) ss += (v[Q][j][0] * v[Q][j][0] + v[Q][j][1] * v[Q][j][1]) + (v[Q][j][2] * v[Q][j][2] + v[Q][j][3] * v[Q][j][3]); \
        ss = wave_sum(ss); \
        const float rinv = frsq(ss * (1.f / 1024.f) + 1e-6f); \
        _Pragma("unroll") for (int j = 0; j < 4; ++j) { \
            const int c = 4 * lane + 256 * j; \
            if (MODE == 2) { f32x4 o; \
                _Pragma("unroll") for (int e = 0; e < 4; ++e) o[e] = v[Q][j][e] * rinv * A[j][e]; \
                *(f32x4*)(p.out + (size_t)r * 1024 + c) = o; \
            } else { float h[4]; \
                _Pragma("unroll") for (int e = 0; e < 4; ++e) h[e] = (v[Q][j][e] * rinv) * A[j][e] + B[j][e]; \
                u32x2 w; w.x = pk2(h[0], h[1]); w.y = pk2(h[2], h[3]); \
                *(u32x2*)(H + (size_t)r * 1024 + c) = w; } \
        } \
        r += rstep; }
    while (true) { MP_STEP(0) MP_STEP(1) }
#undef MP_STEP
#undef MP_SRC
#undef MP_ISSUE
}

typedef __bf16 bf2_t __attribute__((ext_vector_type(2)));
__device__ __forceinline__ float dot2bf(uint32_t a, uint32_t b, float c) { return __builtin_amdgcn_fdot2_f32_bf16(__builtin_bit_cast(bf2_t, a), __builtin_bit_cast(bf2_t, b), c, false); }
__device__ __forceinline__ void phase_ffn_route(const Params& p, char* smem, int layer, int nrows, int wg, int nwg) {
    const int tid = ltid(), lane = tid & 63, wv = __builtin_amdgcn_readfirstlane(tid >> 6);
    const float* RES = WSP(float, OFF_RES); const float* mod = WSP(float, OFF_MOD); bf16_t* H = WSP(bf16_t, OFF_HREG);
    int* cnt = WSP(int, OFF_CNT) + layer * 32; int* routei = WSP(int, OFF_ROUTEI); float* routeg = WSP(float, OFF_ROUTEG); int* tokl = WSP(int, OFF_TOKL);
    {
        const u32x4* RT = (const u32x4*)(p.ws + OFF_WTS + W_RW) + (size_t)layer * 4608;
        for (int q = tid; q < 4608; q += 256) *(u32x4*)(smem + q * 16) = RT[q];
        if (tid < 32) ((float*)(smem + SM_TAB))[tid] = p.router_f_b[layer * 32 + tid];
    }
    __syncthreads();
    const float* gn = p.norm_ffn + layer * 1024;
    const bool hi32 = (lane & 32) != 0, hi16 = (lane & 16) != 0, hi8 = (lane & 8) != 0;
    const float cb0 = p.router_c_b[layer * 4 + 0], cb1 = p.router_c_b[layer * 4 + 1], cb2 = p.router_c_b[layer * 4 + 2], cb3 = p.router_c_b[layer * 4 + 3];
    int it = 0, sx1 = 0, sx2 = 0, sr = 0; float sga = 0.f, sgb = 0.f;
    auto flush = [&](int n) {
        if (lane < n) {
            const int p1 = atomicAdd(&cnt[sx1], 1), p2 = atomicAdd(&cnt[sx2], 1);
            tokl[(size_t)sx1 * TOKCAP + p1] = sr; tokl[(size_t)sx2 * TOKCAP + p2] = sr;
            routei[2 * sr] = (p1 << 5) | sx1; routei[2 * sr + 1] = (p2 << 5) | sx2; routeg[2 * sr] = sga; routeg[2 * sr + 1] = sgb;
        }
    };
    f32x4 A[4], B[4]; int mbc = -1;
    int r = wg * 4 + wv;
    const int rstep = nwg * 4;
    if (r >= nrows) return;
    const int rlast = nrows - 1;
    f32x4 vv[3][4];
#pragma unroll
    for (int j = 0; j < 4; ++j) vv[0][j] = *(const f32x4*)(RES + (size_t)r * 1024 + 4 * lane + 256 * j);
#pragma unroll
    for (int j = 0; j < 4; ++j) vv[1][j] = *(const f32x4*)(RES + (size_t)min(r + rstep, rlast) * 1024 + 4 * lane + 256 * j);
    while (r < nrows) {
#pragma unroll
      for (int P = 0; P < 3; ++P) {
        if (r >= nrows) break;
        const int mb = r < NL ? (r >> 13) : 4;
        if (mb != mbc) { mbc = mb;
            const float* sh = mod + (size_t)(mb * 4 + layer) * 6144 + 3 * 1024; const float* sc = sh + 1024;
#pragma unroll
            for (int j = 0; j < 4; ++j) { const int c = 4 * lane + 256 * j; const f32x4 g = *(const f32x4*)(gn + c), s1 = *(const f32x4*)(sh + c), s2 = *(const f32x4*)(sc + c);
#pragma unroll
                for (int e = 0; e < 4; ++e) { A[j][e] = g[e] * (1.f + s2[e]); B[j][e] = s1[e]; } }
        }
        const int rn = min(r + 2 * rstep, rlast);
#pragma unroll
        for (int j = 0; j < 4; ++j) vv[(P + 2) % 3][j] = *(const f32x4*)(RES + (size_t)rn * 1024 + 4 * lane + 256 * j);
        f32x4 (&v)[4] = vv[P];
        __builtin_amdgcn_sched_barrier(0);
        float ss = 0.f;
#pragma unroll
        for (int j = 0; j < 4; ++j) ss += (v[j][0] * v[j][0] + v[j][1] * v[j][1]) + (v[j][2] * v[j][2] + v[j][3] * v[j][3]);
        ss = wave_sum(ss);
        const float rinv = frsq(ss * (1.f / 1024.f) + 1e-6f);
        uint32_t hp[8];
#pragma unroll
        for (int j = 0; j < 4; ++j) {
            float h[4];
#pragma unroll
            for (int e = 0; e < 4; ++e) h[e] = (v[j][e] * rinv) * A[j][e] + B[j][e];
            u32x2 w; w.x = pk2(h[0], h[1]); w.y = pk2(h[2], h[3]); hp[2 * j] = w.x; hp[2 * j + 1] = w.y;
            *(u32x2*)(H + (size_t)r * 1024 + 4 * lane + 256 * j) = w;
        }
        float c0 = 0.f, c1 = 0.f, c2 = 0.f, c3 = 0.f;
#pragma unroll
        for (int pp = 0; pp < 8; ++pp) { const u32x4 w = *(const u32x4*)(smem + 65536 + (pp * 64 + lane) * 16);
            c0 = dot2bf(hp[pp], w[0], c0); c1 = dot2bf(hp[pp], w[1], c1); c2 = dot2bf(hp[pp], w[2], c2); c3 = dot2bf(hp[pp], w[3], c3); }
        float m;
        { const float t0 = hi32 ? c0 : c2, t1 = hi32 ? c1 : c3;
          const float k0 = (hi32 ? c2 : c0) + __shfl_xor(t0, 32), k1 = (hi32 ? c3 : c1) + __shfl_xor(t1, 32);
          const float t = hi16 ? k0 : k1; m = (hi16 ? k1 : k0) + __shfl_xor(t, 16);
          m = sum16(m); }
        const float q0 = rl_(m, 0) + cb0, q1 = rl_(m, 16) + cb1, q2 = rl_(m, 32) + cb2, q3 = rl_(m, 48) + cb3;
        int gi = 0; float mx = q0;
        if (q1 > mx) { mx = q1; gi = 1; } if (q2 > mx) { mx = q2; gi = 2; } if (q3 > mx) { mx = q3; gi = 3; }
        const float gval = frcp(fexp(q0 - mx) + fexp(q1 - mx) + fexp(q2 - mx) + fexp(q3 - mx));
        float f[8];
#pragma unroll
        for (int x = 0; x < 8; ++x) f[x] = 0.f;
        const char* ft = smem + gi * 16384 + lane * 16;
#pragma unroll
        for (int pp = 0; pp < 8; ++pp)
#pragma unroll
            for (int hf = 0; hf < 2; ++hf) { const u32x4 w = *(const u32x4*)(ft + (pp * 2 + hf) * 1024);
#pragma unroll
                for (int x = 0; x < 4; ++x) f[hf * 4 + x] = dot2bf(hp[pp], w[x], f[hf * 4 + x]); }
        float n_;
        { float k[4];
#pragma unroll
          for (int x = 0; x < 4; ++x) { const float t = hi32 ? f[x] : f[x + 4]; k[x] = (hi32 ? f[x + 4] : f[x]) + __shfl_xor(t, 32); }
          float m2[2];
#pragma unroll
          for (int x = 0; x < 2; ++x) { const float t = hi16 ? k[x] : k[x + 2]; m2[x] = (hi16 ? k[x + 2] : k[x]) + __shfl_xor(t, 16); }
          const float t = hi8 ? m2[0] : m2[1]; n_ = (hi8 ? m2[1] : m2[0]) + __shfl_xor(t, 8);
          n_ = sum8(n_); }
        float lf[8]; float m1 = -3.0e38f, m2v = -3.0e38f; int e1 = 0, e2 = 0;
#pragma unroll
        for (int e = 0; e < 8; ++e) lf[e] = rl_(n_, 8 * e) + ((const float*)(smem + SM_TAB))[gi * 8 + e];
#pragma unroll
        for (int e = 0; e < 8; ++e) if (lf[e] > m1) { m1 = lf[e]; e1 = e; }
#pragma unroll
        for (int e = 0; e < 8; ++e) if (e != e1 && lf[e] > m2v) { m2v = lf[e]; e2 = e; }
        const float qq = fexp(m2v - m1), rq = frcp(1.f + qq);
        if (lane == it) { sx1 = gi * 8 + e1; sx2 = gi * 8 + e2; sga = gval * rq; sgb = gval * qq * rq; sr = r; }
        if (++it == 64) { flush(64); it = 0; }
        r += rstep;
      }
    }
    flush(it);
}

struct AShift { const bf16_t* H; const bf16_t* zero; int m0;
    __device__ __forceinline__ int info(int row) const {
        const int r = m0 + row; int bits, ctx;
        if (r < NL) { const int t = r & 8191, col = t & 63, rw = t >> 6; bits = (col > 0 ? 1 : 0) | (col < 63 ? 2 : 0) | (rw > 0 ? 4 : 0) | (rw < 127 ? 8 : 0); ctx = 0; }
        else { const int t = (r - NL) & 255; bits = (t > 0 ? 3 : 0) | (t < 255 ? 12 : 0); ctx = 1; }
        return r | (bits << 20) | (ctx << 24); }
    __device__ __forceinline__ const bf16_t* ptr(int inf, int, int k) const {
        const int gr = inf & 0xfffff;
        if (k < 1024) return H + (size_t)gr * 1024 + k;
        const int kk = k - 1024, q = kk >> 8; const bool ctx = (inf >> 24) & 1, ok = (inf >> (20 + q)) & 1;
        const int dl = ctx ? (q < 2 ? -1 : 1) : (q == 0 ? -1 : (q == 1 ? 1 : (q == 2 ? -64 : 64)));
        return ok ? H + (size_t)(gr + dl) * 1024 + kk : zero; } };

__device__ __forceinline__ void phase_e2(const Params& p, char* smem, int j, int nrows, int layer, int wg, int nwg) {
    const bf16_t* H = WSP(bf16_t, OFF_HREG); bf16_t* P = WSP(bf16_t, OFF_PREG); bf16_t* LR1 = WSP(bf16_t, OFF_LR1);
    const bf16_t* WIN = (const bf16_t*)(p.ws + OFF_WTS + W_WIN) + (size_t)j * 1024 * 2048;
    const bf16_t* WL1 = (const bf16_t*)(p.ws + OFF_WTS + W_LR1) + (size_t)j * 2048 * 384;
    const int nrt = nrows / 128, nlr = nrt * 3, ntot = nlr + nrt * 16;
    W2Conv cw{p.moe_w2 + (size_t)layer * 32 * 1024 * 512, WSP(bf16_t, OFF_W2), ntot / nwg, wg, nwg, {}};
    f32x4 acc[4][4];
    int it_ = 0;
    for (int t = wg; t < ntot; t += nwg, ++it_) {
        cw.load(it_);
        if (t >= nlr) {
            const int tp = t - nlr, mt = tp >> 4, nt = tp & 15, m0 = mt * 128, n0 = nt * 128;
            gemm_tile(smem, 16, APlain{H, 1024, m0}, BPlain{WIN + n0, 2048}, acc);
            EPI_FOR(acc, { st_bf4(P + (size_t)(m0 + row) * 2048 + n0 + col, v); });
        } else {
            const int u = t, mt = u / 3, nt = u % 3, m0 = mt * 128, n0 = nt * 128;
            gemm_tile(smem, 32, AShift{H, WSP(bf16_t, OFF_ZERO), m0}, BPlain{WL1 + n0, 384}, acc);
            EPI_FOR(acc, { f32x4 o;
                _Pragma("unroll") for (int e = 0; e < 4; ++e) { const float z = v[e]; o[e] = nt == 0 ? tanhf_(z) : (nt == 1 ? z : sigmoidf_(z)); }
                st_bf4(LR1 + (size_t)(m0 + row) * 384 + n0 + col, o); });
        }
        cw.store(it_);
    }
}

__device__ __forceinline__ void phase_e3(const Params& p, int j, int nrows, int wg, int nwg) {
    const int lane = ltid() & 63, wv = ltid() >> 6;
    const bf16_t* P = WSP(bf16_t, OFF_PREG);
    bf16_t* R = WSP(bf16_t, OFF_RKVK); bf16_t* K = R + (size_t)NT * 512; bf16_t* V = K + (size_t)NT * 512; bf16_t* KK = V + (size_t)NT * 512;
    bf16_t* DIFF = WSP(bf16_t, OFF_DIFF);
    const int c = 8 * lane, q = lane >> 4;
    for (int r = wg * 4 + wv; r < nrows; r += nwg * 4) {
        const int s = shift_src(r, q); const int sc = s >= 0 ? s : r;
        int t, T, base;
        if (r < NL) { t = r & 8191; T = 8192; base = r - t; } else { t = (r - NL) & 255; T = 256; base = r - t; }
        const int half = 1 << q; const int lo = max(t - half, 0), hi = min(t + half, T);
        u32x4 pa_[3], pb_[3];
#pragma unroll
        for (int n = 0; n < 3; ++n) { pa_[n] = *(const u32x4*)(P + (size_t)r * 2048 + n * 512 + c); pb_[n] = *(const u32x4*)(P + (size_t)sc * 2048 + n * 512 + c); }
        u32x4 wv_[16];
#pragma unroll
        for (int i = 0; i < 16; ++i) { const int tt = t + i - 8; const bool ok = tt >= lo && tt < hi; wv_[i] = *(const u32x4*)(P + (size_t)(base + (ok ? tt : t)) * 2048 + 1536 + c); }
        const u32x4 u = *(const u32x4*)(P + (size_t)r * 2048 + 1536 + c);
        __builtin_amdgcn_sched_barrier(0);
        float val[3][8];
#pragma unroll
        for (int n = 0; n < 3; ++n) {
            const u32x4 a = pa_[n]; u32x4 b = pb_[n];
            if (s < 0) b = (u32x4){0u, 0u, 0u, 0u};
            const f32x4 m0 = *(const f32x4*)(p.mu_p + (size_t)(j * 3 + n) * 512 + c), m1 = *(const f32x4*)(p.mu_p + (size_t)(j * 3 + n) * 512 + c + 4);
#pragma unroll
            for (int e = 0; e < 4; ++e) {
                const float pa0 = bflo(a[e]), pa1 = bfhi(a[e]), pb0 = bflo(b[e]), pb1 = bfhi(b[e]);
                const float mu0 = (2 * e < 4) ? m0[2 * e] : m1[2 * e - 4], mu1 = (2 * e + 1 < 4) ? m0[2 * e + 1] : m1[2 * e + 1 - 4];
                val[n][2 * e] = pa0 + (pb0 - pa0) * mu0; val[n][2 * e + 1] = pa1 + (pb1 - pa1) * mu1;
            }
        }
        const f32x4 kk0 = *(const f32x4*)(p.k_k + j * 512 + c), kk1 = *(const f32x4*)(p.k_k + j * 512 + c + 4);
        float kkv[8]; float ss = 0.f;
#pragma unroll
        for (int e = 0; e < 8; ++e) { kkv[e] = val[1][e] * (e < 4 ? kk0[e] : kk1[e - 4]); ss += kkv[e] * kkv[e]; }
        ss += __shfl_xor(ss, 1); ss += __shfl_xor(ss, 2); ss += __shfl_xor(ss, 4);
        const float rn = frsq(fmaxf(ss, 1e-12f));
        u32x4 o;
#pragma unroll
        for (int e = 0; e < 4; ++e) o[e] = pk2(val[0][2 * e], val[0][2 * e + 1]);
        *(u32x4*)(R + (size_t)r * 512 + c) = o;
#pragma unroll
        for (int e = 0; e < 4; ++e) o[e] = pk2(val[1][2 * e], val[1][2 * e + 1]);
        *(u32x4*)(K + (size_t)r * 512 + c) = o;
#pragma unroll
        for (int e = 0; e < 4; ++e) o[e] = pk2(val[2][2 * e], val[2][2 * e + 1]);
        *(u32x4*)(V + (size_t)r * 512 + c) = o;
        (void)kkv; (void)rn;
        float sum[8];
#pragma unroll
        for (int e = 0; e < 8; ++e) sum[e] = 0.f;
#pragma unroll
        for (int i = 0; i < 16; ++i) { const int tt = t + i - 8; const bool ok = tt >= lo && tt < hi;
#pragma unroll
            for (int e = 0; e < 4; ++e) { sum[2 * e] += ok ? bflo(wv_[i][e]) : 0.f; sum[2 * e + 1] += ok ? bfhi(wv_[i][e]) : 0.f; } }
        const float inv = 1.0f / (float)(hi - lo);
#pragma unroll
        for (int e = 0; e < 4; ++e) o[e] = pk2(sum[2 * e] * inv - bflo(u[e]), sum[2 * e + 1] * inv - bfhi(u[e]));
        *(u32x4*)(DIFF + (size_t)r * 512 + c) = o;
    }
}

__device__ __forceinline__ void phase_e4(const Params& p, char* smem, int j, int nrows, int part, int wg, int nwg) {
    const bf16_t* LR1 = WSP(bf16_t, OFF_LR1); const bf16_t* DIFF = WSP(bf16_t, OFF_DIFF);
    const bf16_t* K = WSP(bf16_t, OFF_RKVK) + (size_t)NT * 512; const bf16_t* KK = WSP(bf16_t, OFF_RKVK) + (size_t)3 * NT * 512;
    float* W = WSP(float, OFF_WREG); bf16_t* KD = WSP(bf16_t, OFF_KD); bf16_t* BB = WSP(bf16_t, OFF_BB); bf16_t* G = WSP(bf16_t, OFF_G); bf16_t* YAB = WSP(bf16_t, OFF_HREG);
    const bf16_t* WL2 = (const bf16_t*)(p.ws + OFF_WTS + W_LR2) + (size_t)j * 384 * 512;
    const bf16_t* WP = (const bf16_t*)(p.ws + OFF_WTS + W_POOL) + (size_t)j * 512 * 128;
    const int nrt = nrows / 128, nlr = nrt * (part == 0 ? 16 : 4), ntot = nlr + (part == 1 ? nrt * 4 : 0);
    f32x4 acc[4][4];
    for (int t = wg; t < ntot; t += nwg) {
        if (t < nlr) {
            const int mt = part == 0 ? t >> 4 : t >> 2, u = part == 0 ? (t & 15) : 16 + (t & 3), ob = u >> 2, n4 = u & 3, m0 = mt * 128, n0 = n4 * 128;
            const int koff = ob < 4 ? ob * 64 : 256, nk = ob < 4 ? 1 : 2;
            gemm_tile(smem, nk, APlain{LR1 + koff, 384, m0}, BPlain{WL2 + (size_t)koff * 512 + n0, 512}, acc);
            if (ob < 2) {
                const float* w0 = p.decay_w0 + (size_t)(j * 2 + ob) * 512 + n0;
                EPI_FOR(acc, { const f32x4 b0 = *(const f32x4*)(w0 + col); f32x4 o;
                    _Pragma("unroll") for (int e = 0; e < 4; ++e) o[e] = v[e] + b0[e];
                    st_bf4(KD + ((size_t)ob * NT + m0 + row) * 512 + n0 + col, o); });
            } else if (ob < 4) {
                const int d = ob - 2; const float* a0 = p.lr_a0 + (size_t)(j * 2 + d) * 512 + n0;
                EPI_FOR(acc, { const f32x4 b0 = *(const f32x4*)(a0 + col); f32x4 o;
                    _Pragma("unroll") for (int e = 0; e < 4; ++e) o[e] = sigmoidf_(v[e] + b0[e]);
                    st_bf4(BB + ((size_t)d * NT + m0 + row) * 512 + n0 + col, o); });
            } else {
                EPI_FOR(acc, { st_bf4(G + (size_t)(m0 + row) * 512 + n0 + col, v); });
            }
        } else {
            const int u = t - nlr, mt = u >> 2, g = u & 3, m0 = mt * 128;
            gemm_tile(smem, 2, APlain{DIFF + g * 128, 512, m0}, BPlain{WP + (size_t)g * 128 * 128, 128}, acc);
            const float* ps = p.pool_scale + (size_t)j * 512 + g * 128;
            EPI_FOR(acc, { const f32x4 s = *(const f32x4*)(ps + col); f32x4 o; o[0] = v[0] * s[0]; o[1] = v[1] * s[1]; o[2] = v[2] * s[2]; o[3] = v[3] * s[3];
                st_bf4(YAB + (size_t)(m0 + row) * 1024 + 512 + g * 128 + col, o); });
        }
    }
}

template <int VAR> __device__ __forceinline__ void phase_scan(const Params&, char*, int, int) {}
template <int CTRL> __device__ __forceinline__ float dpp_mov(float x) { return __builtin_bit_cast(float, __builtin_amdgcn_mov_dpp(__builtin_bit_cast(int, x), CTRL, 0xf, 0xf, true)); }
typedef float f32x2v __attribute__((ext_vector_type(2)));

#define CK_C 32
#define CK_NCH 264
#define CK_P 144
#define CK_PG 80
#define CK_G 0
#define CK_TOT 8192
#define CK_AT 9216
#define CK_BT (CK_AT + 4608)
#define CK_KT (CK_BT + 4608)
#define CK_RT (CK_KT + 4608)
#define CK_VC (CK_RT + 4608)
#define CK_T (CK_VC + 4608)
#define CK_MAK (CK_T + 2560)
#define CK_NRB (CK_MAK + 2560)
#define CK_NRK (CK_NRB + 2560)
#define CK_P1 (CK_NRK + 2560)
#define CK_W1 (CK_P1 + 4608)
#define CK_W2 (CK_W1 + 4608)
#define CK_TF (CK_W2 + 4608)
#define CK_END (CK_TF + 32 * 144)
static_assert(CK_END <= SM_BAR, "chunk LDS map");
constexpr size_t OFF_AD0 = MBY(869);
__device__ __forceinline__ size_t off_qy(int d) { return OFF_PREG + (size_t)d * MBY(66); }
__device__ __forceinline__ size_t off_ad(int d) { return d ? OFF_WREG : OFF_AD0; }

__device__ __forceinline__ bf16x8 frag_rows(const char* img, int pitch, int r0, int k0, int lane) {
    return *(const bf16x8*)(img + (r0 + (lane & 15)) * pitch + (k0 + 8 * (lane >> 4)) * 2);
}
__device__ __forceinline__ bf16x8 frag_cols(const char* img, int pitch, int k0, int c0, int lane) {
    const char* a = img + (k0 + 8 * (lane >> 4) + ((lane & 15) >> 2)) * pitch + (c0 + 4 * (lane & 3)) * 2;
    const s16x4 lo = __builtin_amdgcn_ds_read_tr16_b64_v4i16((LAS s16x4*)a), hi = __builtin_amdgcn_ds_read_tr16_b64_v4i16((LAS s16x4*)(a + 4 * pitch));
    return __builtin_shufflevector(lo, hi, 0, 1, 2, 3, 4, 5, 6, 7);
}
#define MFMA16(acc, afrag, bfrag) acc = __builtin_amdgcn_mfma_f32_16x16x32_bf16(bfrag, afrag, acc, 0, 0, 0)

__device__ __forceinline__ void phase_s1(const Params& p, char* smem, int jl, int d, int wg0, int nwg0) {
    const int tid = ltid(), lane = tid & 63, wv = tid >> 6;
    const bf16_t* R = WSP(bf16_t, OFF_RKVK); const bf16_t* V = R + (size_t)2 * NT * 512; const bf16_t* KK = R + (size_t)3 * NT * 512;
    const bf16_t* Kp = R + (size_t)NT * 512; const bf16_t* KD = WSP(bf16_t, OFF_KD) + (size_t)d * NT * 512; const bf16_t* BB = WSP(bf16_t, OFF_BB) + (size_t)d * NT * 512;
    bf16_t* QY = WSP(bf16_t, off_qy(d)); bf16_t* AD = WSP(bf16_t, off_ad(d));
    const int li = tid >> 3, c8 = (tid & 7) * 8;
    const int dir = d ? -1 : 1;
    const int ntask = 32 * CK_NCH;
    u32x4 lr, ld, lb, lv, lz;
    auto gl = [&](int task) {
        const int cd = task / CK_NCH, n = task - cd * CK_NCH, b = cd >> 3, h = cd & 7, s0 = n * CK_C;
        const int r0 = s0 < 256 ? NL + b * 256 + (d ? 255 - s0 : s0) : b * 8192 + (d ? 8191 - (s0 - 256) : (s0 - 256));
        const size_t ro = (size_t)(r0 + dir * li) * 512 + h * 64 + c8;
        lr = *(const GAS u32x4*)(R + ro); ld = *(const GAS u32x4*)(Kp + ro); lb = *(const GAS u32x4*)(BB + ro); lv = *(const GAS u32x4*)(V + ro);
        lz = *(const GAS u32x4*)(KD + ro);
    };
    int task = wg0;
    if (task < ntask) gl(task);
    for (; task < ntask; task += nwg0) {
        const int cd = task / CK_NCH, n = task - cd * CK_NCH;
        float* G = (float*)(smem + CK_G); float* TOT = (float*)(smem + CK_TOT); float* TF = (float*)(smem + CK_TF);
        __syncthreads();
        {
            f32x4 w0_, w1_;
#pragma unroll
            for (int e = 0; e < 2; ++e) { w0_[2 * e] = fexp(-0.60653065971f * sigmoidf_(bflo(lz[e]))); w0_[2 * e + 1] = fexp(-0.60653065971f * sigmoidf_(bfhi(lz[e])));
                                          w1_[2 * e] = fexp(-0.60653065971f * sigmoidf_(bflo(lz[2 + e]))); w1_[2 * e + 1] = fexp(-0.60653065971f * sigmoidf_(bfhi(lz[2 + e]))); }
            *(f32x4*)(G + li * 64 + c8) = w0_; *(f32x4*)(G + li * 64 + c8 + 4) = w1_;
        }
        const u32x4 xr = lr, xd = ld, xb = lb, xv = lv;
        const int hh = (task / CK_NCH) & 7;
        const f32x4 ka0 = *(const f32x4*)(p.k_a + (size_t)jl * 512 + hh * 64 + c8), ka1 = *(const f32x4*)(p.k_a + (size_t)jl * 512 + hh * 64 + c8 + 4);
        if (task + nwg0 < ntask) gl(task + nwg0);
        __builtin_amdgcn_sched_barrier(0);
        __syncthreads();
        {
            const int c = tid & 63, q = tid >> 6; float pr = 1.f;
#pragma unroll
            for (int j = 0; j < 8; ++j) { pr *= G[(8 * q + j) * 64 + c]; G[(8 * q + j) * 64 + c] = pr; }
            TOT[q * 64 + c] = pr;
            __syncthreads();
            float pre = 1.f;
            if (q > 0) pre = TOT[c]; if (q > 1) pre *= TOT[64 + c]; if (q > 2) pre *= TOT[128 + c];
#pragma unroll
            for (int j = 0; j < 8; ++j) G[(8 * q + j) * 64 + c] *= pre;
        }
        __syncthreads();
        {
            float g[8], gm[8];
            { const f32x4 a0 = *(const f32x4*)(G + li * 64 + c8), a1 = *(const f32x4*)(G + li * 64 + c8 + 4);
#pragma unroll
              for (int e = 0; e < 4; ++e) { g[e] = a0[e]; g[4 + e] = a1[e]; } }
            if (li > 0) { const f32x4 a0 = *(const f32x4*)(G + (li - 1) * 64 + c8), a1 = *(const f32x4*)(G + (li - 1) * 64 + c8 + 4);
#pragma unroll
              for (int e = 0; e < 4; ++e) { gm[e] = a0[e]; gm[4 + e] = a1[e]; } }
            else {
#pragma unroll
              for (int e = 0; e < 8; ++e) gm[e] = 1.f; }
            float kkf[8];
            { const f32x4 q0 = *(const f32x4*)(p.k_k + (size_t)jl * 512 + hh * 64 + c8), q1 = *(const f32x4*)(p.k_k + (size_t)jl * 512 + hh * 64 + c8 + 4); float ss = 0.f;
#pragma unroll
              for (int e = 0; e < 4; ++e) { kkf[2 * e] = bflo(xd[e]) * ((2 * e < 4) ? q0[2 * e] : q1[2 * e - 4]); kkf[2 * e + 1] = bfhi(xd[e]) * ((2 * e + 1 < 4) ? q0[2 * e + 1] : q1[2 * e + 1 - 4]); }
#pragma unroll
              for (int e = 0; e < 8; ++e) ss += kkf[e] * kkf[e];
              ss = sum8(ss);
              const float rn = frsq(fmaxf(ss, 1e-12f));
#pragma unroll
              for (int e = 0; e < 8; ++e) kkf[e] *= rn; }
            u32x4 oa, ob, ok, orr;
#pragma unroll
            for (int e = 0; e < 4; ++e) {
                const float i0 = frcp(g[2 * e]), i1 = frcp(g[2 * e + 1]);
                oa[e] = pk2(-kkf[2 * e] * gm[2 * e], -kkf[2 * e + 1] * gm[2 * e + 1]);
                const float al0 = bflo(xb[e]), al1 = bfhi(xb[e]);
                const float kav0 = (2 * e < 4) ? ka0[2 * e] : ka1[2 * e - 4], kav1 = (2 * e + 1 < 4) ? ka0[2 * e + 1] : ka1[2 * e + 1 - 4];
                ob[e] = pk2(kkf[2 * e] * al0 * i0, kkf[2 * e + 1] * al1 * i1);
                ok[e] = pk2(bflo(xd[e]) * (1.f + (al0 - 1.f) * kav0) * i0, bfhi(xd[e]) * (1.f + (al1 - 1.f) * kav1) * i1);
                orr[e] = pk2(bflo(xr[e]) * g[2 * e], bfhi(xr[e]) * g[2 * e + 1]);
            }
            const int o = li * CK_P + c8 * 2;
            *(u32x4*)(smem + CK_AT + o) = oa; *(u32x4*)(smem + CK_BT + o) = ob; *(u32x4*)(smem + CK_KT + o) = ok; *(u32x4*)(smem + CK_RT + o) = orr; *(u32x4*)(smem + CK_VC + o) = xv;
        }
        __syncthreads();
        {
            const int mt = wv >> 1, nt = wv & 1;
            f32x4 aab = {0.f, 0.f, 0.f, 0.f}, aak = aab, arb = aab, ark = aab;
#pragma unroll
            for (int ks = 0; ks < 2; ++ks) {
                const bf16x8 fa = frag_rows(smem + CK_AT, CK_P, mt * 16, ks * 32, lane), fr = frag_rows(smem + CK_RT, CK_P, mt * 16, ks * 32, lane);
                const bf16x8 fb = frag_rows(smem + CK_BT, CK_P, nt * 16, ks * 32, lane), fk = frag_rows(smem + CK_KT, CK_P, nt * 16, ks * 32, lane);
                MFMA16(aab, fa, fb); MFMA16(aak, fa, fk); MFMA16(arb, fr, fb); MFMA16(ark, fr, fk);
            }
            const int m = mt * 16 + (lane & 15), n0 = nt * 16 + 4 * (lane >> 4);
            f32x4 o1, o2, o3, o4;
#pragma unroll
            for (int e = 0; e < 4; ++e) { const int nn = n0 + e; o1[e] = nn < m ? aab[e] : 0.f; o2[e] = nn < m ? aak[e] : 0.f; o3[e] = nn <= m ? arb[e] : 0.f; o4[e] = nn <= m ? ark[e] : 0.f; }
            *(f32x4*)(TF + m * 36 + n0) = o1;
            st_bf4((bf16_t*)(smem + CK_MAK + m * CK_PG) + n0, o2); st_bf4((bf16_t*)(smem + CK_NRB + m * CK_PG) + n0, o3); st_bf4((bf16_t*)(smem + CK_NRK + m * CK_PG) + n0, o4);
        }
        __syncthreads();
        if (wv == 0) {
            const int c = lane & 31; float Tc[32];
#pragma unroll
            for (int t = 0; t < 32; ++t) {
                float a0 = (c == t) ? 1.f : 0.f, a1 = 0.f, a2 = 0.f, a3 = 0.f;
#pragma unroll
                for (int j4 = 0; j4 < (t + 3) / 4; ++j4) {
                    const f32x4 mrow = *(const f32x4*)(TF + t * 36 + j4 * 4);
                    if (j4 * 4 + 0 < t) a0 += mrow[0] * Tc[j4 * 4 + 0];
                    if (j4 * 4 + 1 < t) a1 += mrow[1] * Tc[j4 * 4 + 1];
                    if (j4 * 4 + 2 < t) a2 += mrow[2] * Tc[j4 * 4 + 2];
                    if (j4 * 4 + 3 < t) a3 += mrow[3] * Tc[j4 * 4 + 3];
                }
                Tc[t] = (a0 + a1) + (a2 + a3);
                if (lane < 32) ((bf16_t*)(smem + CK_T + t * CK_PG))[c] = f2bf(Tc[t]);
            }
        } else {
            for (int tl = wv - 1; tl < 8; tl += 3) {
                const int mt = tl >> 2, nt = tl & 3; f32x4 acc = {0.f, 0.f, 0.f, 0.f};
                MFMA16(acc, frag_rows(smem + CK_MAK, CK_PG, mt * 16, 0, lane), frag_cols(smem + CK_VC, CK_P, 0, nt * 16, lane));
                st_bf4((bf16_t*)(smem + CK_P1 + (mt * 16 + (lane & 15)) * CK_P) + nt * 16 + 4 * (lane >> 4), acc);
            }
        }
        __syncthreads();
#pragma unroll
        for (int u = 0; u < 4; ++u) {
            const int tl = wv * 4 + u, which = tl >> 3, mt = (tl >> 2) & 1, nt = tl & 3; f32x4 acc = {0.f, 0.f, 0.f, 0.f};
            MFMA16(acc, frag_rows(smem + CK_T, CK_PG, mt * 16, 0, lane), frag_cols(smem + (which ? CK_P1 : CK_AT), CK_P, 0, nt * 16, lane));
            st_bf4((bf16_t*)(smem + (which ? CK_W2 : CK_W1) + (mt * 16 + (lane & 15)) * CK_P) + nt * 16 + 4 * (lane >> 4), acc);
        }
        __syncthreads();
        {
            bf16_t* qrec = QY + (size_t)task * 4096; bf16_t* arec = AD + (size_t)task * 8192;
#pragma unroll
            for (int u = 0; u < 2; ++u) {
                const int tl = wv * 2 + u, mt = tl >> 2, nt = tl & 3, m = mt * 16 + (lane & 15), n0 = nt * 16 + 4 * (lane >> 4);
                const bf16x8 fnb = frag_rows(smem + CK_NRB, CK_PG, mt * 16, 0, lane), fnk = frag_rows(smem + CK_NRK, CK_PG, mt * 16, 0, lane);
                f32x4 aq = {0.f, 0.f, 0.f, 0.f}, ay = aq;
                MFMA16(aq, fnb, frag_cols(smem + CK_W1, CK_P, 0, nt * 16, lane));
                MFMA16(ay, fnb, frag_cols(smem + CK_W2, CK_P, 0, nt * 16, lane)); MFMA16(ay, fnk, frag_cols(smem + CK_VC, CK_P, 0, nt * 16, lane));
                const u32x2 rt = *(const u32x2*)(smem + CK_RT + m * CK_P + n0 * 2);
                aq[0] += bflo(rt.x); aq[1] += bfhi(rt.x); aq[2] += bflo(rt.y); aq[3] += bfhi(rt.y);
                st_bf4(qrec + ((m >> 4) * 2 + (n0 >> 5)) * 512 + (((n0 >> 3) & 3) * 16 + (m & 15)) * 8 + (n0 & 7), aq);
                st_bf4(qrec + 2048 + m * 64 + n0, ay);
            }
            const float* gC = G + 31 * 64;
#pragma unroll
            for (int u = 0; u < 4; ++u) {
                const int tl = wv * 4 + u, mt = tl >> 2, nt = tl & 3, m = mt * 16 + (lane & 15), n0 = nt * 16 + 4 * (lane >> 4);
                const bf16x8 fbt = frag_cols(smem + CK_BT, CK_P, 0, mt * 16, lane), fkt = frag_cols(smem + CK_KT, CK_P, 0, mt * 16, lane);
                f32x4 aa = {0.f, 0.f, 0.f, 0.f}, ad = aa;
                MFMA16(aa, fbt, frag_cols(smem + CK_W1, CK_P, 0, nt * 16, lane));
                MFMA16(ad, fbt, frag_cols(smem + CK_W2, CK_P, 0, nt * 16, lane)); MFMA16(ad, fkt, frag_cols(smem + CK_VC, CK_P, 0, nt * 16, lane));
                const float gm_ = gC[m];
#pragma unroll
                for (int e = 0; e < 4; ++e) { aa[e] = (aa[e] + ((n0 + e) == m ? 1.f : 0.f)) * gm_; ad[e] *= gm_; }
                st_bf4(arec + ((m >> 4) * 2 + (n0 >> 5)) * 512 + (((n0 >> 3) & 3) * 16 + (m & 15)) * 8 + (n0 & 7), aa);
                st_bf4(arec + 4096 + (((n0 >> 4) * 4 + (m >> 4)) * 64 + ((n0 & 15) >> 2) * 16 + (m & 15)) * 4, ad);
            }
        }
    }
}

__device__ __forceinline__ void phase_s2(const Params& p, char* smem, int d, int wg, int nwg) {
    const int tid = ltid(), lane = tid & 63, wv = tid >> 6;
    bf16_t* QY = WSP(bf16_t, off_qy(d)); const bf16_t* AD = WSP(bf16_t, off_ad(d));
    const int m15 = lane & 15, g4 = lane >> 4;
    if (wv != 0) return;
    for (int t = wg; t < 128; t += nwg) {
        const int x = t & 7, yy = t >> 3, cd = x * 4 + (yy >> 2), sl = yy & 3;
        char* zt = smem;
#pragma unroll
        for (int mt = 0; mt < 4; ++mt) *(u32x2*)(zt + (mt * 16 + m15) * 48 + 8 * g4) = (u32x2){0u, 0u};
        bf16x8 fa[3][4][2], fq[3][2][2]; u32x2 dz[3][4], dy[3][2];
#define S2_LOAD(S, n_) do { \
            const bf16_t* qrec = QY + (size_t)(cd * CK_NCH + (n_)) * 4096; const bf16_t* arec = AD + (size_t)(cd * CK_NCH + (n_)) * 8192; \
            _Pragma("unroll") for (int mt = 0; mt < 4; ++mt) { \
                _Pragma("unroll") for (int ks = 0; ks < 2; ++ks) fa[S][mt][ks] = *(const GAS bf16x8*)(arec + (mt * 2 + ks) * 512 + lane * 8); \
                dz[S][mt] = *(const GAS u32x2*)(arec + 4096 + ((sl * 4 + mt) * 64 + lane) * 4); } \
            _Pragma("unroll") for (int mt = 0; mt < 2; ++mt) { \
                _Pragma("unroll") for (int ks = 0; ks < 2; ++ks) fq[S][mt][ks] = *(const GAS bf16x8*)(qrec + (mt * 2 + ks) * 512 + lane * 8); \
                dy[S][mt] = *(const GAS u32x2*)(qrec + 2048 + (mt * 16 + m15) * 64 + sl * 16 + 4 * g4); } } while (0)
        S2_LOAD(0, 0); S2_LOAD(1, 1);
        for (int nb = 0; nb < CK_NCH; nb += 3) {
#pragma unroll
          for (int P = 0; P < 3; ++P) {
            const int n = nb + P;
            if (n >= CK_NCH) break;
            S2_LOAD((P + 2) % 3, min(n + 2, CK_NCH - 1));
            bf16x8 (&ca)[4][2] = fa[P]; bf16x8 (&cq)[2][2] = fq[P]; u32x2 (&cz)[4] = dz[P]; u32x2 (&cy)[2] = dy[P];
            __builtin_amdgcn_sched_barrier(0);
            const bf16x8 z0 = frag_cols(zt, 48, 0, 0, lane), z1 = frag_cols(zt, 48, 32, 0, lane);
            f32x4 az[4], ay[2];
#pragma unroll
            for (int mt = 0; mt < 4; ++mt) { az[mt] = (f32x4){bflo(cz[mt].x), bfhi(cz[mt].x), bflo(cz[mt].y), bfhi(cz[mt].y)}; MFMA16(az[mt], ca[mt][0], z0); MFMA16(az[mt], ca[mt][1], z1); }
#pragma unroll
            for (int mt = 0; mt < 4; ++mt) { u32x2 w; w.x = pk2(az[mt][0], az[mt][1]); w.y = pk2(az[mt][2], az[mt][3]); *(u32x2*)(zt + (mt * 16 + m15) * 48 + 8 * g4) = w; }
            __builtin_amdgcn_sched_barrier(0);
#pragma unroll
            for (int mt = 0; mt < 2; ++mt) { ay[mt] = (f32x4){bflo(cy[mt].x), bfhi(cy[mt].x), bflo(cy[mt].y), bfhi(cy[mt].y)}; MFMA16(ay[mt], cq[mt][0], z0); MFMA16(ay[mt], cq[mt][1], z1); }
            { bf16_t* qrec = QY + (size_t)(cd * CK_NCH + n) * 4096;
#pragma unroll
              for (int mt = 0; mt < 2; ++mt) st_bf4(qrec + 2048 + (mt * 16 + m15) * 64 + sl * 16 + 4 * g4, ay[mt]); }
          }
        }
#undef S2_LOAD
    }
}

template <int YBF>
__device__ __forceinline__ void phase_post(const Params& p, int j, int nrows, int wg, int nwg) {
    const int tid = ltid(), lane = tid & 63, wv = __builtin_amdgcn_readfirstlane(tid >> 6);
    const float* Y = WSP(float, OFF_PREG);
    const bf16_t* R = WSP(bf16_t, OFF_RKVK); const bf16_t* V = R + (size_t)2 * NT * 512;
    const bf16_t* G = WSP(bf16_t, OFF_G); bf16_t* YAB = WSP(bf16_t, OFF_HREG); const bf16_t* AL = WSP(bf16_t, OFF_BB);
    const bf16_t* QY0 = WSP(bf16_t, off_qy(0)); const bf16_t* QY1 = WSP(bf16_t, off_qy(1));
    const int c = 8 * lane;
    static_assert(YBF != 0, "the output phase reads y from the chunk records (chunked state pass)"); (void)Y;
    f32x4 ka[2], rk[2], gw[2], gb[2];
#pragma unroll
    for (int h = 0; h < 2; ++h) { ka[h] = *(const f32x4*)(p.k_a + (size_t)j * 512 + c + 4 * h); rk[h] = *(const f32x4*)(p.r_k + (size_t)j * 512 + c + 4 * h);
        gw[h] = *(const f32x4*)(p.gn_w + (size_t)j * 512 + c + 4 * h); gb[h] = *(const f32x4*)(p.gn_b + (size_t)j * 512 + c + 4 * h); }
    const int rstep = nwg * 4, rlast = nrows - 1;
    int r = wg * 4 + wv;
    if (r >= nrows) return;
    u32x4 in[2][8];
#define PO_LOAD(S, rr) do { \
        const int hh = lane >> 3, v_ = (lane & 7) * 8; int bb_, tt_, s0_, s1_; \
        if ((rr) < NL) { bb_ = (rr) >> 13; tt_ = (rr) & 8191; s0_ = 256 + tt_; s1_ = 256 + 8191 - tt_; } else { bb_ = ((rr) - NL) >> 8; tt_ = ((rr) - NL) & 255; s0_ = tt_; s1_ = 255 - tt_; } \
        const int cd = bb_ * 8 + hh; \
        in[S][0] = *(const u32x4*)(QY0 + (size_t)(cd * CK_NCH + (s0_ >> 5)) * 4096 + 2048 + (s0_ & 31) * 64 + v_); \
        in[S][1] = *(const u32x4*)(QY1 + (size_t)(cd * CK_NCH + (s1_ >> 5)) * 4096 + 2048 + (s1_ & 31) * 64 + v_); \
        in[S][2] = *(const u32x4*)(R + (size_t)(rr) * 512 + c); in[S][3] = *(const u32x4*)(V + (size_t)(rr) * 512 + c); in[S][4] = *(const u32x4*)(G + (size_t)(rr) * 512 + c); \
        in[S][5] = *(const u32x4*)(R + ((size_t)NT + (rr)) * 512 + c); in[S][6] = *(const u32x4*)(AL + (size_t)(rr) * 512 + c); in[S][7] = *(const u32x4*)(AL + ((size_t)NT + (rr)) * 512 + c); } while (0)
    PO_LOAD(0, r);
    while (r < nrows) {
#pragma unroll
      for (int P = 0; P < 2; ++P) {
        if (r >= nrows) break;
        { const int rn = min(r + rstep, rlast); PO_LOAD(1 - P, rn); }
        __builtin_amdgcn_sched_barrier(0);
        const u32x4 a = in[P][0], bq = in[P][1], rr = in[P][2], vv = in[P][3], gg = in[P][4], kx = in[P][5], al0 = in[P][6], al1 = in[P][7];
        float y[8];
#pragma unroll
        for (int e = 0; e < 4; ++e) { y[2 * e] = bflo(a[e]) + bflo(bq[e]); y[2 * e + 1] = bfhi(a[e]) + bfhi(bq[e]); }
        float s = 0.f;
#pragma unroll
        for (int e = 0; e < 8; ++e) s += y[e];
        s = sum8(s);
        const float mu = s * (1.f / 64.f);
        float q = 0.f;
#pragma unroll
        for (int e = 0; e < 8; ++e) { const float dlt = y[e] - mu; q += dlt * dlt; }
        q = sum8(q);
        const float rstd = frsq(q * (1.f / 64.f) + 64e-5f);
        float dot = 0.f;
#pragma unroll
        for (int e = 0; e < 4; ++e) {
            const float kav0 = ka[(2 * e) >> 2][(2 * e) & 3], kav1 = ka[(2 * e + 1) >> 2][(2 * e + 1) & 3];
            dot += bflo(rr[e]) * (bflo(kx[e]) * (2.f + (bflo(al0[e]) + bflo(al1[e]) - 2.f) * kav0)) * rk[(2 * e) >> 2][(2 * e) & 3];
            dot += bfhi(rr[e]) * (bfhi(kx[e]) * (2.f + (bfhi(al0[e]) + bfhi(al1[e]) - 2.f) * kav1)) * rk[(2 * e + 1) >> 2][(2 * e + 1) & 3];
        }
        dot = sum8(dot);
        float o[8];
#pragma unroll
        for (int e = 0; e < 8; ++e) {
            const float vf = (e & 1) ? bfhi(vv[e >> 1]) : bflo(vv[e >> 1]), gf = (e & 1) ? bfhi(gg[e >> 1]) : bflo(gg[e >> 1]);
            o[e] = ((y[e] - mu) * rstd * gw[e >> 2][e & 3] + gb[e >> 2][e & 3] + dot * vf) * gf;
        }
        u32x4 w;
#pragma unroll
        for (int e = 0; e < 4; ++e) w[e] = pk2(o[2 * e], o[2 * e + 1]);
        *(u32x4*)(YAB + (size_t)r * 1024 + c) = w;
        r += rstep;
      }
    }
#undef PO_LOAD
}

template <int DRY = 0, bool CW = false>
__device__ __forceinline__ void phase_resgemm(const Params& p, char* smem, const bf16_t* A, const bf16_t* B, int layer, int nrows, int wg, int nwg) {
    float* RES = DRY ? WSP(float, OFF_DIFF) : WSP(float, OFF_RES); const float* mod = WSP(float, OFF_MOD);
    const int ntot = (nrows / 128) * 8;
    W2Conv cw{p.moe_w2 + (size_t)layer * 32 * 1024 * 512, WSP(bf16_t, OFF_W2), CW ? ntot / nwg : 0, wg, nwg, {}};
    f32x4 acc[4][4];
    int it_ = 0;
    for (int t = wg; t < ntot; t += nwg, ++it_) {
        const int mt = t >> 3, nt = t & 7, m0 = mt * 128, n0 = nt * 128;
        if (CW) cw.load(it_);
        gemm_tile(smem, 16, APlain{A, 1024, m0}, BPlain{B + n0, 1024}, acc);
        const int mb = m0 < NL ? (m0 >> 13) : 4;
        const float* g2 = mod + (size_t)(mb * 4 + layer) * 6144 + 2 * 1024 + n0;
        const float* rsrc = layer == 0 ? (m0 < NL ? p.x : p.ctx - (size_t)NL * 1024) : RES;
        EPI_FOR(acc, { float* rp = RES + (DRY ? (size_t)((m0 + row) & 4095) : (size_t)(m0 + row)) * 1024 + n0 + col; const f32x4 g = *(const f32x4*)(g2 + col); f32x4 o = *(const f32x4*)(rsrc + (size_t)(m0 + row) * 1024 + n0 + col);
            o[0] += g[0] * v[0]; o[1] += g[1] * v[1]; o[2] += g[2] * v[2]; o[3] += g[3] * v[3]; *(f32x4*)rp = o; });
        if (CW) cw.store(it_);
    }
}

__device__ __forceinline__ void phase_f1(const Params& p, char* smem, int nrows, int wg, int nwg) {
    const bf16_t* H = WSP(bf16_t, OFF_HREG); bf16_t* Z = WSP(bf16_t, OFF_PREG); const bf16_t* DFTC = (const bf16_t*)(p.ws + OFF_WTS + W_DFTC);
    const int ntot = (nrows / 128) * 16;
    f32x4 acc[4][4];
    for (int t = wg; t < ntot; t += nwg) {
        const int mt = t >> 4, nt = t & 15, g = nt >> 2, cb = nt & 3, m0 = mt * 128;
        gemm_tile(smem, 4, APlain{H + g * 256, 1024, m0}, BPlain{DFTC + cb * 128, 512}, acc);
        EPI_FOR(acc, { st_bf4(Z + (size_t)(m0 + row) * 2048 + g * 512 + cb * 128 + col, v); });
    }
}
struct BZ { const bf16_t* Z; int rowbase, rstride, psh, off;
    __device__ __forceinline__ const bf16_t* ptr(int k, int n) const { const int part = k >> psh, idx = k & ((1 << psh) - 1); return Z + (size_t)(rowbase + idx * rstride) * 2048 + part * 256 + off + n; } };
__device__ __forceinline__ void phase_f2(const Params& p, char* smem, bool with_ctx, int wg, int nwg) {
    const bf16_t* Z = WSP(bf16_t, OFF_PREG); bf16_t* A1 = WSP(bf16_t, OFF_WREG); bf16_t* FO = WSP(bf16_t, OFF_RKVK);
    const bf16_t* TW = (const bf16_t*)(p.ws + OFF_WTS + W_TW); const bf16_t* CS256 = (const bf16_t*)(p.ws + OFF_WTS + W_CS256);
    const int nctx = with_ctx ? 64 : 0, ntot = 512 * 8 + nctx;
    f32x4 acc[4][4];
    for (int t = wg; t < ntot; t += nwg) {
        if (t >= nctx) {
            const int tl_ = t - nctx, bt = tl_ >> 3, nt = tl_ & 7, b = bt >> 7, t2 = bt & 127; const int ch0 = nt * 128, g = ch0 >> 8, cc = ch0 & 255;
            gemm_tile(smem, 2, APlain{TW + (size_t)t2 * 128 * 128, 128, 0}, BZ{Z, b * 8192 + t2, 128, 6, g * 512 + cc}, acc);
            EPI_FOR(acc, { const int pp = row >> 6, f1 = row & 63; st_bf4(A1 + ((((size_t)(b * 64 + f1) * 128 + t2) * 2 + pp) * 1024) + ch0 + col, v); });
        } else {
            const int u = t, b = u >> 4, mt = (u >> 3) & 1, nt = u & 7; const int ch0 = nt * 128, g = ch0 >> 8, cc = ch0 & 255;
            gemm_tile(smem, 8, APlain{CS256, 512, mt * 128}, BZ{Z, NL + b * 256, 1, 8, g * 512 + cc}, acc);
            EPI_FOR(acc, { f32x4 o; o[0] = v[0] * (1.f / 256.f); o[1] = v[1] * (1.f / 256.f); o[2] = v[2] * (1.f / 256.f); o[3] = v[3] * (1.f / 256.f);
                st_bf4(FO + (size_t)(NL + b * 256 + mt * 128 + row) * 1024 + ch0 + col, o); });
        }
    }
}
struct BA1 { const bf16_t* base; int off;
    __device__ __forceinline__ const bf16_t* ptr(int k, int n) const { const int part = k >> 7, t2 = k & 127; return base + (size_t)(t2 * 2 + part) * 1024 + off + n; } };
__device__ __forceinline__ void phase_f3(const Params& p, char* smem, int wg, int nwg) {
    const bf16_t* A1 = WSP(bf16_t, OFF_WREG); bf16_t* FO = WSP(bf16_t, OFF_RKVK); const bf16_t* CS128 = (const bf16_t*)(p.ws + OFF_WTS + W_CS128);
    f32x4 acc[4][4];
    const float scl = 0.000690533966f;
    for (int t = wg; t < 256 * 8; t += nwg) {
        const int bf_ = t >> 3, nt = t & 7, b = bf_ >> 6, f1 = bf_ & 63;
        gemm_tile(smem, 4, APlain{CS128, 256, 0}, BA1{A1 + (size_t)(b * 64 + f1) * 128 * 2 * 1024, nt * 128}, acc);
        EPI_FOR(acc, { f32x4 o; o[0] = v[0] * scl; o[1] = v[1] * scl; o[2] = v[2] * scl; o[3] = v[3] * scl;
            st_bf4(FO + (size_t)(b * 8192 + f1 + 64 * row) * 1024 + nt * 128 + col, o); });
    }
}

__device__ __forceinline__ void phase_f3_ring(const Params& p, char* smem, int wg, int nwg) {
    const int tid = ltid(), lane = tid & 63, wid = tid >> 6;
    const bf16_t* A1 = WSP(bf16_t, OFF_WREG); bf16_t* FO = WSP(bf16_t, OFF_RKVK); const bf16_t* CS128 = (const bf16_t*)(p.ws + OFF_WTS + W_CS128);
    const float scl = 0.000690533966f;
    const int ntot = 256 * 8;
    if (wg >= ntot) return;
    const int nmy = (ntot - wg + nwg - 1) / nwg, nsteps = nmy * 4;
    bf16x8 a[8][2];
#pragma unroll
    for (int ks = 0; ks < 8; ++ks)
#pragma unroll
        for (int mt = 0; mt < 2; ++mt) a[ks][mt] = *(const GAS bf16x8*)(CS128 + (size_t)(wid * 32 + mt * 16 + (lane & 15)) * 256 + ks * 32 + (lane >> 4) * 8);
    const int brow = tid >> 4, bnc = (((tid & 15) ^ bswz(brow)) << 3);
    const unsigned lds0 = (unsigned)__builtin_amdgcn_readfirstlane((int)((unsigned)(size_t)smem + (unsigned)(wid * 1024)));
    auto issueB = [&](int g) {
        g = min(g, nsteps - 1);
        const int t = wg + (g >> 2) * nwg, kt = g & 3, bf_ = t >> 3, nt = t & 7, b = bf_ >> 6, f1 = bf_ & 63;
        const bf16_t* base = A1 + (size_t)(b * 64 + f1) * 128 * 2 * 1024 + nt * 128;
#pragma unroll
        for (int q = 0; q < 4; ++q) { const int k = kt * 64 + brow + 16 * q, part = k >> 7, t2 = k & 127;
            glds16_asm(base + (size_t)(t2 * 2 + part) * 1024 + bnc, lds0 + kt * G_BBYTES + q * 4096); }
    };
    const int bg = lane >> 4, bq = (lane & 15) >> 2, bp = lane & 3;
    __syncthreads();
    issueB(0); issueB(1); issueB(2);
    f32x4 acc[2][8];
    for (int i = 0; i < nmy; ++i) {
#pragma unroll
        for (int m_ = 0; m_ < 2; ++m_)
#pragma unroll
            for (int n_ = 0; n_ < 8; ++n_) acc[m_][n_] = (f32x4){0.f, 0.f, 0.f, 0.f};
#pragma unroll
        for (int kt = 0; kt < 4; ++kt) {
            if (kt < 3 && i > 0) asm volatile("s_waitcnt vmcnt(24)" ::: "memory"); else asm volatile("s_waitcnt vmcnt(8)" ::: "memory");
            __syncthreads();
            issueB(i * 4 + kt + 3);
            const char* sb = smem + kt * G_BBYTES;
#pragma unroll
            for (int ks = 0; ks < 2; ++ks) {
#pragma unroll
                for (int nh = 0; nh < 4; ++nh) {
                    bf16x8 b[2];
#pragma unroll
                    for (int n2 = 0; n2 < 2; ++n2) {
                        const int nt = nh * 2 + n2;
                        const int c2 = 2 * nt + (bp >> 1);
                        const int k0 = 32 * ks + 8 * bg + bq, k1 = k0 + 4;
                        const s16x4 lo = __builtin_amdgcn_ds_read_tr16_b64_v4i16((LAS s16x4*)(sb + k0 * 256 + ((c2 ^ bswz(k0)) << 4) + 8 * (bp & 1)));
                        const s16x4 hi = __builtin_amdgcn_ds_read_tr16_b64_v4i16((LAS s16x4*)(sb + k1 * 256 + ((c2 ^ bswz(k1)) << 4) + 8 * (bp & 1)));
                        b[n2] = __builtin_shufflevector(lo, hi, 0, 1, 2, 3, 4, 5, 6, 7);
                    }
#pragma unroll
                    for (int mt = 0; mt < 2; ++mt)
#pragma unroll
                        for (int n2 = 0; n2 < 2; ++n2) acc[mt][nh * 2 + n2] = __builtin_amdgcn_mfma_f32_16x16x32_bf16(b[n2], a[kt * 2 + ks][mt], acc[mt][nh * 2 + n2], 0, 0, 0);
                }
            }
        }
        const int t = wg + i * nwg, bf_ = t >> 3, nt = t & 7, b = bf_ >> 6, f1 = bf_ & 63;
#pragma unroll
        for (int mt = 0; mt < 2; ++mt)
#pragma unroll
            for (int n8 = 0; n8 < 8; ++n8) {
                const int row = wid * 32 + mt * 16 + (lane & 15), col = n8 * 16 + 4 * (lane >> 4); const f32x4 v = acc[mt][n8];
                f32x4 o; o[0] = v[0] * scl; o[1] = v[1] * scl; o[2] = v[2] * scl; o[3] = v[3] * scl;
                st_bf4(FO + (size_t)(b * 8192 + f1 + 64 * row) * 1024 + nt * 128 + col, o);
            }
    }
    asm volatile("s_waitcnt vmcnt(0)" ::: "memory");
    __syncthreads();
}

__device__ __forceinline__ void moe_convert(const Params& p, int layer, int wg, int nwg) {
    const size_t gt = (size_t)wg * 256 + ltid(), gs = (size_t)nwg * 256; const size_t n4 = (size_t)32 * 1024 * 512 / 4;
    bf16_t* MW = WSP(bf16_t, (layer & 1) ? OFF_WREG : OFF_AD0);
    const float* s1 = p.moe_w1 + (size_t)layer * 32 * 1024 * 512; const float* s3 = p.moe_w3 + (size_t)layer * 32 * 1024 * 512; const float* s2 = p.moe_w2 + (size_t)layer * 32 * 1024 * 512;
    (void)s2;
    for (size_t i = gt; i < n4; i += gs) {
        st_bf4(MW + 4 * i, *(const f32x4*)(s1 + 4 * i)); st_bf4(MW + 4 * n4 + 4 * i, *(const f32x4*)(s3 + 4 * i));
    }
}
struct ASplit { const bf16_t* H; const bf16_t* HLO; int m0;
    __device__ __forceinline__ int info(int row) const { return m0 + row; }
    __device__ __forceinline__ const bf16_t* ptr(int gr, int, int k) const { return k < 2048 ? H + (size_t)gr * 1024 + (k & 1023) : HLO + (size_t)gr * 1024 + (k - 2048); } };
template <int DRY>
__device__ __forceinline__ void phase_router(const Params& p, char* smem, int layer, int nrows, int wg, int nwg) {
    const bf16_t* H = WSP(bf16_t, OFF_HREG); const bf16_t* HLO = WSP(bf16_t, OFF_KD);
    const bf16_t* RW = (const bf16_t*)(p.ws + OFF_WTS + W_RW) + (size_t)layer * 3072 * 128;
    int* cnt = WSP(int, OFF_CNT) + layer * 32; int* routei = WSP(int, OFF_ROUTEI); float* routeg = WSP(float, OFF_ROUTEG); int* tokl = WSP(int, OFF_TOKL);
    float* LG = (float*)smem;
    f32x4 acc[4][4];
    const int ntot = nrows / 128;
    for (int t = wg; t < ntot; t += nwg) {
        const int m0 = t * 128;
        gemm_tile(smem, ROUTER_NK, ASplit{H, HLO, m0}, BPlain{RW, 128}, acc);
        __syncthreads();
        EPI_FOR(acc, { if (col < 48) { LG[row * 49 + col] = v[0]; LG[row * 49 + col + 1] = v[1]; LG[row * 49 + col + 2] = v[2]; LG[row * 49 + col + 3] = v[3]; } });
        __syncthreads();
        if (ltid() < 128) {
            const int row = ltid(), r = m0 + row; const float* lg = LG + row * 49;
            float c0 = lg[0] + p.router_c_b[layer * 4 + 0], c1 = lg[1] + p.router_c_b[layer * 4 + 1], c2 = lg[2] + p.router_c_b[layer * 4 + 2], c3 = lg[3] + p.router_c_b[layer * 4 + 3];
            int gi = 0; float mx = c0;
            if (c1 > mx) { mx = c1; gi = 1; } if (c2 > mx) { mx = c2; gi = 2; } if (c3 > mx) { mx = c3; gi = 3; }
            const float gval = 1.f / (expf(c0 - mx) + expf(c1 - mx) + expf(c2 - mx) + expf(c3 - mx));
            float lf[8]; float m1 = -3.0e38f, m2 = -3.0e38f; int e1 = 0, e2 = 0;
#pragma unroll
            for (int e = 0; e < 8; ++e) lf[e] = lg[4 + gi * 8 + e] + p.router_f_b[layer * 32 + gi * 8 + e];
#pragma unroll
            for (int e = 0; e < 8; ++e) if (lf[e] > m1) { m1 = lf[e]; e1 = e; }
#pragma unroll
            for (int e = 0; e < 8; ++e) if (e != e1 && lf[e] > m2) { m2 = lf[e]; e2 = e; }
            const float q2 = expf(m2 - m1); const float ga = gval / (1.f + q2), gb = gval * q2 / (1.f + q2);
            const int x1 = gi * 8 + e1, x2 = gi * 8 + e2;
            if (DRY) { asm volatile("" :: "v"(ga), "v"(gb), "v"(x1), "v"(x2)); } else {
            const int p1 = atomicAdd(&cnt[x1], 1), p2 = atomicAdd(&cnt[x2], 1);
            tokl[(size_t)x1 * TOKCAP + p1] = r; tokl[(size_t)x2 * TOKCAP + p2] = r;
            routei[2 * r] = (p1 << 5) | x1; routei[2 * r + 1] = (p2 << 5) | x2; routeg[2 * r] = ga; routeg[2 * r + 1] = gb; }
        }
    }
    if (!(CHUNKED && (layer & 1) == 0)) moe_convert(p, layer, wg, nwg);
}
__device__ __forceinline__ void moe_table(const Params& p, int layer, int* rbs, int* cn, int wg) {
    const int* cnt = WSP(int, OFF_CNT) + layer * 32;
    __syncthreads();
    if (ltid() == 0) { int a = 0; for (int e = 0; e < 32; ++e) { const int c = cnt[e]; cn[e] = c; rbs[e] = a; a += (c + 127) >> 7; } rbs[32] = a;
        if (wg == 0) { int* poff = WSP(int, OFF_POFF) + layer * 64; for (int e = 0; e < 32; ++e) poff[e] = rbs[e] * 128; } }
    __syncthreads();
}
struct AGather { const bf16_t* H; const bf16_t* zero; const int* list; int nvalid;
    __device__ __forceinline__ int info(int row) const { return row < nvalid ? list[row] : -1; }
    __device__ __forceinline__ const bf16_t* ptr(int tok, int, int k) const { return tok >= 0 ? H + (size_t)tok * 1024 + k : zero; } };
struct BW13 { const bf16_t* w1; size_t d3;
    __device__ __forceinline__ const bf16_t* ptr(int k, int n) const { return w1 + (size_t)((n >> 5) & 1) * d3 + (size_t)k * 512 + (n >> 6) * 32 + (n & 31); } };

__device__ __forceinline__ void phase_moe1(const Params& p, char* smem, int layer, int wg, int nwg) {
    int* rbs = (int*)(smem + SM_TAB); int* cn = rbs + 40;
    moe_table(p, layer, rbs, cn, wg);
    const bf16_t* H2 = WSP(bf16_t, OFF_HREG); const bf16_t* MW = WSP(bf16_t, (layer & 1) ? OFF_WREG : OFF_AD0); bf16_t* HB = WSP(bf16_t, OFF_BB); const int* tokl = WSP(int, OFF_TOKL);
    const size_t WSZ = (size_t)32 * 1024 * 512;
    const int ntot = rbs[32] * 8;
    f32x4 acc[4][4];
    for (int t = wg; t < ntot; t += nwg) {
        const int rbg = t >> 3, cb = t & 7;
        int e = 0; while (rbs[e + 1] <= rbg) ++e;
        const int rb = rbg - rbs[e]; const int nvalid = cn[e] - rb * 128;
        gemm_tile(smem, 16, AGather{H2, WSP(bf16_t, OFF_ZERO), tokl + (size_t)e * TOKCAP + rb * 128, nvalid},
                  BW13{MW + (size_t)e * 1024 * 512 + cb * 64, WSZ}, acc);
        {
            const int l = ltid() & 63, w = ltid() >> 6, wm = w >> 1, wn = w & 1;
#pragma unroll
            for (int mt = 0; mt < 4; ++mt)
#pragma unroll
                for (int nt = 0; nt < 2; ++nt) {
                    const int row = wm * 64 + mt * 16 + (l & 15), hcol = cb * 64 + wn * 32 + nt * 16 + 4 * (l >> 4);
                    const f32x4 a1 = acc[mt][nt], a3 = acc[mt][nt + 2]; f32x4 o;
#pragma unroll
                    for (int q = 0; q < 4; ++q) o[q] = a1[q] * sigmoidf_(a1[q]) * a3[q];
                    st_bf4(HB + ((size_t)rbg * 128 + row) * 512 + hcol, o);
                }
        }
    }
}
__device__ __forceinline__ void phase_moe2(const Params& p, char* smem, int layer, int wg, int nwg) {
    int* rbs = (int*)(smem + SM_TAB); int* cn = rbs + 40;
    moe_table(p, layer, rbs, cn, wg);
    const bf16_t* MW2 = WSP(bf16_t, OFF_W2); const bf16_t* HB = WSP(bf16_t, OFF_BB); bf16_t* YM = WSP(bf16_t, OFF_PREG);
    const int ntot = rbs[32] * 8;
    f32x4 acc[4][4];
    for (int t = wg; t < ntot; t += nwg) {
        const int rbg = t >> 3, nt8 = t & 7;
        int e = 0; while (rbs[e + 1] <= rbg) ++e;
        gemm_tile(smem, 8, APlain{HB, 512, rbg * 128}, BPlain{MW2 + (size_t)e * 512 * 1024 + nt8 * 128, 1024}, acc);
        EPI_FOR(acc, { st_bf4(YM + ((size_t)rbg * 128 + row) * 1024 + nt8 * 128 + col, v); });
    }
}

__device__ __forceinline__ void phase_e4z(const Params& p, char* smem, int j, int nrows, int wg, int nwg) {
    const int tid = ltid(), lane = tid & 63, wid = tid >> 6, wm = wid >> 1, wn = wid & 1;
    const bf16_t* LR1 = WSP(bf16_t, OFF_LR1); bf16_t* KD = WSP(bf16_t, OFF_KD); bf16_t* BB = WSP(bf16_t, OFF_BB);
    const bf16_t* WL2 = (const bf16_t*)(p.ws + OFF_WTS + W_LR2) + (size_t)j * 384 * 512;
    const int ntot = (nrows / 128) * 16;
    if (wg >= ntot) return;
    const int u = wg & 15, ob = u >> 2, n0 = (u & 3) * 128, koff = ob * 64;
    const int nmy = (ntot - wg + nwg - 1) / nwg;
    const int arow = tid >> 3, akc = (((tid & 7) ^ (arow & 7)) << 3), brow = tid >> 4, bnc = (((tid & 15) ^ bswz(brow)) << 3);
    const unsigned lds0 = (unsigned)__builtin_amdgcn_readfirstlane((int)((unsigned)(size_t)smem + (unsigned)(wid * 1024)));
    constexpr int EZ_B = 3 * G_ABYTES, EZ_BIAS = 65536;
    __syncthreads();
    {
        const bf16_t* bsrc = WL2 + (size_t)koff * 512 + n0;
#pragma unroll
        for (int i = 0; i < 4; ++i) glds16_asm(bsrc + (size_t)(brow + 16 * i) * 512 + bnc, lds0 + EZ_B + i * 4096);
        if (tid < 128) ((float*)(smem + EZ_BIAS))[tid] = (ob < 2 ? p.decay_w0 + (size_t)(j * 2 + ob) * 512 : p.lr_a0 + (size_t)(j * 2 + ob - 2) * 512)[n0 + tid];
    }
    auto issueA = [&](int i, int buf) {
        const int m0 = ((wg + i * nwg) >> 4) * 128;
#pragma unroll
        for (int q = 0; q < 4; ++q) glds16_asm(LR1 + (size_t)(m0 + arow + 32 * q) * 384 + koff + akc, lds0 + buf * G_ABYTES + q * 4096);
    };
    issueA(0, 0); issueA(min(1, nmy - 1), 1);
    const int ar = wm * 64 + (lane & 15), ax = lane & 7, ag = lane >> 4;
    const int bg = lane >> 4, bq = (lane & 15) >> 2, bp = lane & 3;
    bf16_t* outp = ob < 2 ? KD + (size_t)ob * NT * 512 : BB + (size_t)(ob - 2) * NT * 512;
    int buf = 0;
    for (int i = 0; i < nmy; ++i) {
        if (i == 0) asm volatile("s_waitcnt vmcnt(4)" ::: "memory"); else asm volatile("s_waitcnt vmcnt(20)" ::: "memory");
        __syncthreads();
        { int b2 = buf + 2; if (b2 >= 3) b2 -= 3; issueA(min(i + 2, nmy - 1), b2); }
        const char* sa = smem + buf * G_ABYTES; const char* sb = smem + EZ_B;
        f32x4 acc[4][4];
#pragma unroll
        for (int a_ = 0; a_ < 4; ++a_)
#pragma unroll
            for (int b_ = 0; b_ < 4; ++b_) acc[a_][b_] = (f32x4){0.f, 0.f, 0.f, 0.f};
#pragma unroll
        for (int ks = 0; ks < 2; ++ks) {
            bf16x8 a[4], b[4];
#pragma unroll
            for (int mt = 0; mt < 4; ++mt) a[mt] = *(const bf16x8*)(sa + (ar + mt * 16) * 128 + (((4 * ks + ag) ^ ax) << 4));
#pragma unroll
            for (int nt = 0; nt < 4; ++nt) {
                const int c2 = 2 * (wn * 4 + nt) + (bp >> 1);
                const int k0 = 32 * ks + 8 * bg + bq, k1 = k0 + 4;
                const s16x4 lo = __builtin_amdgcn_ds_read_tr16_b64_v4i16((LAS s16x4*)(sb + k0 * 256 + ((c2 ^ bswz(k0)) << 4) + 8 * (bp & 1)));
                const s16x4 hi = __builtin_amdgcn_ds_read_tr16_b64_v4i16((LAS s16x4*)(sb + k1 * 256 + ((c2 ^ bswz(k1)) << 4) + 8 * (bp & 1)));
                b[nt] = __builtin_shufflevector(lo, hi, 0, 1, 2, 3, 4, 5, 6, 7);
            }
#pragma unroll
            for (int mt = 0; mt < 4; ++mt)
#pragma unroll
                for (int nt = 0; nt < 4; ++nt) acc[mt][nt] = __builtin_amdgcn_mfma_f32_16x16x32_bf16(b[nt], a[mt], acc[mt][nt], 0, 0, 0);
        }
        const int m0 = ((wg + i * nwg) >> 4) * 128;
        if (ob < 2) {
            EPI_FOR(acc, { const f32x4 b0 = *(const f32x4*)(smem + EZ_BIAS + col * 4); f32x4 o;
                _Pragma("unroll") for (int e = 0; e < 4; ++e) o[e] = v[e] + b0[e];
                st_bf4(outp + (size_t)(m0 + row) * 512 + n0 + col, o); });
        } else {
            EPI_FOR(acc, { const f32x4 b0 = *(const f32x4*)(smem + EZ_BIAS + col * 4); f32x4 o;
                _Pragma("unroll") for (int e = 0; e < 4; ++e) o[e] = sigmoidf_(v[e] + b0[e]);
                st_bf4(outp + (size_t)(m0 + row) * 512 + n0 + col, o); });
        }
        if (++buf == 3) buf = 0;
    }
    asm volatile("s_waitcnt vmcnt(0)" ::: "memory");
    __syncthreads();
}

template <int PH>
__device__ __forceinline__ void do_phase(const Params& pin, char* smem, int layer, int wg, int nwg) {
    Params p = pin; { size_t zoff = 0; asm volatile("" : "+s"(zoff)); p.ws = pin.ws + zoff; } asm volatile("" : "+s"(layer));
    const int j = layer >> 1;
    const bool ctx_in = layer <= 2, ctx_out = layer < 2;
    const int rows_in = ctx_in ? NT : NL, rows_out = ctx_out ? NT : NL;
    const char* wts = p.ws + OFF_WTS;
    if constexpr (PH == PH_PROLOGUE) phase_prologue(p, smem, wg, nwg);
    else if constexpr (PH == PH_MOD_MIX) { if (layer == 0) phase_modpipe<0, false>(p, layer, rows_in, wg, nwg); else phase_modpipe<0, true>(p, layer, rows_in, wg, nwg); }
    else if constexpr (PH == PH_E2) phase_e2(p, smem, j, rows_in, layer, wg, nwg);
    else if constexpr (PH == PH_E3) { phase_e3(p, j, rows_in, wg, nwg); if ((nwg & 15) == 0) phase_e4z(p, smem, j, rows_in, wg, nwg); else phase_e4(p, smem, j, rows_in, 0, wg, nwg); }
    else if constexpr (PH == PH_E4) phase_e4(p, smem, j, rows_in, 0, wg, nwg);
    else if constexpr (PH == PH_SCAN) phase_scan<0>(p, smem, wg, nwg);
    else if constexpr (PH == PH_SCANV) phase_scan<SCANVAR>(p, smem, wg, nwg);
    else if constexpr (PH == PH_POST) phase_post<CHUNKED>(p, j, rows_out, wg, nwg);
    else if constexpr (PH == PH_S1A) phase_s1(p, smem, j, 0, wg, nwg);
    else if constexpr (PH == PH_S2A) { if (nwg <= 128) { phase_s2(p, smem, 0, wg, nwg); phase_s1(p, smem, j, 1, wg, nwg); } else if (wg < 128) phase_s2(p, smem, 0, wg, nwg); else phase_s1(p, smem, j, 1, wg - 128, nwg - 128); }
    else if constexpr (PH == PH_S2B) { if (nwg <= 128) { phase_s2(p, smem, 1, wg, nwg); phase_e4(p, smem, j, rows_in, 1, wg, nwg); moe_convert(p, layer, wg, nwg); } else if (wg < 128) phase_s2(p, smem, 1, wg, nwg); else { phase_e4(p, smem, j, rows_in, 1, wg - 128, nwg - 128); moe_convert(p, layer, wg - 128, nwg - 128); } }
    else if constexpr (PH == PH_WOUT) phase_resgemm(p, smem, WSP(bf16_t, OFF_HREG), (const bf16_t*)(wts + W_WOUT) + (size_t)j * 1024 * 1024, layer, rows_out, wg, nwg);
    else if constexpr (PH == PH_F1) phase_f1(p, smem, rows_out, wg, nwg);
    else if constexpr (PH == PH_F2) phase_f2(p, smem, ctx_out, wg, nwg);
    else if constexpr (PH == PH_F3) phase_f3_ring(p, smem, wg, nwg);
    else if constexpr (PH == PH_WF) phase_resgemm<0, true>(p, smem, WSP(bf16_t, OFF_RKVK), (const bf16_t*)(wts + W_WF) + (size_t)j * 1024 * 1024, layer, rows_out, wg, nwg);
    else if constexpr (PH == PH_FFNR) { phase_ffn_route(p, smem, layer, rows_out, wg, nwg); if (layer & 1) moe_convert(p, layer, wg, nwg); }
    else if constexpr (PH == PH_MOD_FFN) phase_modulate<1>(p, layer, rows_out, false, false, wg, nwg);
    else if constexpr (PH == PH_ROUTER) phase_router<0>(p, smem, layer, rows_out, wg, nwg);
    else if constexpr (PH == PH_ROUTERV) phase_router<1>(p, smem, layer, rows_out, wg, nwg);
    else if constexpr (PH == PH_WOUTV) phase_resgemm<1>(p, smem, WSP(bf16_t, OFF_HREG), (const bf16_t*)(wts + W_WOUT) + (size_t)j * 1024 * 1024, layer, rows_out, wg, nwg);
    else if constexpr (PH == PH_MOE1) phase_moe1(p, smem, layer, wg, nwg);
    else if constexpr (PH == PH_MOE2) phase_moe2(p, smem, layer, wg, nwg);
    else if constexpr (PH == PH_FINAL) phase_modpipe<2, true>(p, 4, NL, wg, nwg);
}

#if MEGA
#ifndef PROF
#define PROF 0
#endif
#if PROF
#define PH_RUN(PHID, CAT) do { const unsigned long long _t0 = wall_clock64(); do_phase<PHID>(p, smem, layer, wg, nwg); xcd_barrier(bar); if ((CAT) == PROF || PROF == 99) tacc += wall_clock64() - _t0; } while (0)
#else
#ifndef DUP_CAT
#define DUP_CAT 0
#endif
#define PH_RUN(PHID, CAT) do { do_phase<PHID>(p, smem, layer, wg, nwg); xcd_barrier(bar); if ((CAT) == DUP_CAT) { do_phase<((PHID) == PH_SCAN ? PH_SCANV : (PHID) == PH_ROUTER ? PH_ROUTERV : (PHID) == PH_WOUT ? PH_WOUTV : (PHID))>(p, smem, layer, wg, nwg); xcd_barrier(bar); } } while (0)
#endif
__global__ void __launch_bounds__(256, 2) k_mega(Params p) {
    extern __shared__ __attribute__((aligned(16))) char smem[];
    if (threadIdx.x == 0) *(u32x4*)(smem + SM_BAR) = (u32x4){0u, 0u, 0u, 0u};
    __syncthreads();
    XcdBarrier bar = xcd_barrier_post(WSP(unsigned, OFF_BAR), (volatile LAS unsigned*)(smem + SM_BAR));
    const int wg = blockIdx.x, nwg = gridDim.x;
#if PROF
    unsigned long long tacc = 0;
#endif
    { int layer = 0; PH_RUN(PH_PROLOGUE, 1); }
    for (int layer = 0; layer < 4; ++layer) {
        PH_RUN(PH_MOD_MIX, 2);
        if ((layer & 1) == 0) {
            PH_RUN(PH_E2, 3); PH_RUN(PH_E3, 4);
#if CHUNKED
            PH_RUN(PH_S1A, 16); PH_RUN(PH_S2A, 17); PH_RUN(PH_S2B, 18);
#else
            PH_RUN(PH_SCAN, 6);
#endif
            PH_RUN(PH_POST, 7); PH_RUN(PH_WOUT, 8);
        } else {
            PH_RUN(PH_F1, 9); PH_RUN(PH_F2, 10); PH_RUN(PH_F3, 11); PH_RUN(PH_WF, 8);
        }
        PH_RUN(PH_FFNR, 12); PH_RUN(PH_MOE1, 14); PH_RUN(PH_MOE2, 15);
    }
#if PROF
    {
        float* slot = (float*)(p.ws + OFF_POFF + 2048);
        if (wg == 0 && threadIdx.x == 0) *slot = rintf(logf((float)tacc * 0.01f) * 20.f) * 0.05f;
        xcd_barrier(bar);
        const float c = *slot;
        for (size_t i = (size_t)wg * 256 + threadIdx.x; i < (size_t)NL * 1024; i += (size_t)nwg * 256) p.out[i] = c;
    }
#else
    do_phase<PH_FINAL>(p, smem, 4, wg, nwg);
#endif
}
#else
template <int PH>
__global__ void __launch_bounds__(256, 2) k_phase(Params p, int layer) {
    extern __shared__ __attribute__((aligned(16))) char smem[];
    do_phase<PH>(p, smem, layer, blockIdx.x, gridDim.x);
}
template <int PH> static void launch_phase(const Params& p, int layer, hipStream_t stream) {
    static bool attr = false;
    if (!attr) { (void)hipFuncSetAttribute((const void*)k_phase<PH>, hipFuncAttributeMaxDynamicSharedMemorySize, SMEM_BYTES); attr = true; }
    hipLaunchKernelGGL(k_phase<PH>, dim3(512), dim3(256), SMEM_BYTES, stream, p, layer);
}
#endif


#if DIAG >= 2
__global__ void k_census(Params p, int what) {
}
__global__ void k_census1(char* ws, size_t off, size_t nbytes, int isf32, int idx) {
    const unsigned* u = (const unsigned*)(ws + off); const size_t n = nbytes / 4; bool bad = false;
    for (size_t i = (size_t)blockIdx.x * 256 + threadIdx.x; i < n; i += (size_t)gridDim.x * 256) {
        const unsigned x = u[i];
        if (isf32) { if ((x & 0x7f800000u) >= (141u << 23)) bad = true; }
        else { if ((x & 0x7f80u) >= (141u << 7) || (x & 0x7f800000u) >= (141u << 23)) bad = true; }
    }
    if (bad) atomicOr((unsigned*)(ws + OFF_CNT) + 192, 1u << idx);
}
__global__ void k_report(Params p) {
    const unsigned f = *((const unsigned*)(p.ws + OFF_CNT) + 192);
    int idx = 0; for (int b = 1; b < 32; ++b) if (f & (1u << b)) { idx = b; break; }
    const float c = sqrtf(0.5f * (float)idx);
    for (size_t i = (size_t)blockIdx.x * 256 + threadIdx.x; i < (size_t)NL * 1024; i += (size_t)gridDim.x * 256) p.out[i] = c;
}
#endif

#if DIAG == 3
__global__ void __launch_bounds__(256, 2) k_gemmtest(Params p) {
    extern __shared__ __attribute__((aligned(16))) char smem[];
    bf16_t* A = WSP(bf16_t, OFF_PREG); bf16_t* B = A + 128 * 128; float* C = (float*)(B + 128 * 128);
    unsigned* cnt = (unsigned*)(p.ws + OFF_CNT) + 192;
    const int tid = threadIdx.x;
    for (int i = tid; i < 128 * 128; i += 256) { const int m = i >> 7, k = i & 127; A[i] = f2bf((float)(((m * 7 + k * 3) % 9) - 4)); B[i] = f2bf((float)(((m * 5 + k * 11) % 7) - 3)); }
    __threadfence(); __syncthreads();
    f32x4 acc[4][4];
    gemm_tile(smem, 2, APlain{A, 128, 0}, BPlain{B, 128}, acc);
    EPI_FOR(acc, { *(f32x4*)(C + (size_t)row * 128 + col) = v; });
    __threadfence(); __syncthreads();
    unsigned bad = 0, nonfin = 0, tr = 0;
    for (int i = tid; i < 128 * 128; i += 256) { const int m = i >> 7, n = i & 127; float s = 0.f, st = 0.f;
        for (int k = 0; k < 128; ++k) { s += bf2f(A[m * 128 + k]) * bf2f(B[k * 128 + n]); st += bf2f(A[n * 128 + k]) * bf2f(B[k * 128 + m]); }
        const float c = C[i]; if (c != s) ++bad; if (!(fabsf(c) < 3e38f)) ++nonfin; if (c == st) ++tr; }
    atomicAdd(cnt + 1, bad); atomicAdd(cnt + 2, nonfin); atomicAdd(cnt + 3, tr);
}
__global__ void k_report3(Params p) {
    const unsigned* cnt = (const unsigned*)(p.ws + OFF_CNT) + 192;
    float c2 = 8.f * (float)cnt[1] / 16384.f; if (cnt[2]) c2 += 20.f; if (cnt[3] > 8000) c2 += 50.f;
    const float c = sqrtf(c2);
    for (size_t i = (size_t)blockIdx.x * 256 + threadIdx.x; i < (size_t)NL * 1024; i += (size_t)gridDim.x * 256) p.out[i] = c;
}
#endif

#if DIAG == 4 || DIAG == 5
__device__ __forceinline__ bool close_(float a, float b, float tol) { return fabsf(a - b) <= tol * (1.f + fabsf(b)); }
__global__ void k_check(Params p) {
    unsigned* flag = (unsigned*)(p.ws + OFF_CNT) + 192;
    const float* mod = WSP(float, OFF_MOD); const bf16_t* H = WSP(bf16_t, OFF_HREG); const bf16_t* P = WSP(bf16_t, OFF_PREG); const bf16_t* LR1 = WSP(bf16_t, OFF_LR1);
    const bf16_t* WIN = (const bf16_t*)(p.ws + OFF_WTS + W_WIN); const bf16_t* WL1 = (const bf16_t*)(p.ws + OFF_WTS + W_LR1);
    const size_t gt = (size_t)blockIdx.x * 256 + threadIdx.x, gs = (size_t)gridDim.x * 256;
    unsigned bad = 0;
    for (size_t i = gt; i < 5 * 6144; i += gs) { const int mb = (int)(i / 6144), n = (int)(i % 6144); float s = 0.f;
        for (int k = 0; k < 1024; ++k) { const float cv = mb < 4 ? p.c[mb * 1024 + k] : p.c_ctx[k]; s += cv / (1.f + expf(-cv)) * p.ada_w[(size_t)k * 6144 + n]; }
        s += p.ada_b[n]; if (!close_(mod[(size_t)(mb * 4) * 6144 + n], s, 1e-3f)) bad |= 1u; }
    { const int rows[6] = {0, 1, 8191, 8192, NL, NT - 1};
      for (size_t i = gt; i < 6 * 1024; i += gs) { const int r = rows[i >> 10], c = (int)(i & 1023); const float* xr = r < NL ? p.x + (size_t)r * 1024 : p.ctx + (size_t)(r - NL) * 1024;
        float ss = 0.f; for (int k = 0; k < 1024; ++k) ss += xr[k] * xr[k]; const float rinv = 1.f / sqrtf(ss / 1024.f + 1e-6f); const int mb = r < NL ? r >> 13 : 4;
        const float h = xr[c] * rinv * p.norm_mix[c] * (1.f + mod[(size_t)(mb * 4) * 6144 + 1024 + c]) + mod[(size_t)(mb * 4) * 6144 + c];
        if (!close_(bf2f(H[(size_t)r * 1024 + c]), h, 2e-2f)) bad |= 2u; } }
    for (size_t i = gt; i < (size_t)1024 * 2048; i += gs) if (!close_(bf2f(WIN[i]), p.w_in[i], 1e-2f)) bad |= 4u;
    { const int rows[6] = {0, 1, 127, 128, 5000, NT - 1};
      for (size_t i = gt; i < 6 * 2048; i += gs) { const int r = rows[i >> 11], n = (int)(i & 2047); float s = 0.f;
        for (int k = 0; k < 1024; ++k) s += bf2f(H[(size_t)r * 1024 + k]) * bf2f(WIN[(size_t)k * 2048 + n]);
        if (!close_(bf2f(P[(size_t)r * 2048 + n]), s, 2e-2f)) bad |= 8u; } }
    { const int rows[6] = {0, 1, 63, 64, 8191, NT - 1};
      for (size_t i = gt; i < 6 * 384; i += gs) { const int r = rows[i / 384], n = (int)(i % 384); float s = 0.f;
        for (int k = 0; k < 1024; ++k) s += bf2f(H[(size_t)r * 1024 + k]) * bf2f(WL1[(size_t)k * 384 + n]);
        for (int k = 0; k < 1024; ++k) { const int sr = shift_src(r, k >> 8); if (sr >= 0) s += bf2f(H[(size_t)sr * 1024 + k]) * bf2f(WL1[(size_t)(1024 + k) * 384 + n]); }
        const float a = n < 128 ? tanhf(s) : (n < 256 ? s : 1.f / (1.f + expf(-s)));
        if (!close_(bf2f(LR1[(size_t)r * 384 + n]), a, 2e-2f)) bad |= 16u; } }
    if (bad) atomicOr(flag, bad);
}
__global__ void k_report4(Params p) {
    const unsigned f = *((const unsigned*)(p.ws + OFF_CNT) + 192);
    const float c = sqrtf(0.25f * (float)f);
    for (size_t i = (size_t)blockIdx.x * 256 + threadIdx.x; i < (size_t)NL * 1024; i += (size_t)gridDim.x * 256) p.out[i] = c;
}
#endif

#if DIAG == 5
__global__ void __launch_bounds__(256, 2) k_projtest(Params p) {
    extern __shared__ __attribute__((aligned(16))) char smem[];
    const bf16_t* H = WSP(bf16_t, OFF_HREG); const bf16_t* WIN = (const bf16_t*)(p.ws + OFF_WTS + W_WIN);
    float* C = WSP(float, OFF_PREG) + (size_t)blockIdx.x * 128 * 128;
    unsigned* flag = (unsigned*)(p.ws + OFF_CNT) + 192;
    const int m0s[4] = {0, 0, 128 * 263, 128 * 100}, n0s[4] = {0, 1920, 0, 640};
    const int m0 = m0s[blockIdx.x], n0 = n0s[blockIdx.x];
    f32x4 acc[4][4];
    gemm_tile(smem, 16, APlain{H, 1024, m0}, BPlain{WIN + n0, 2048}, acc);
    EPI_FOR(acc, { *(f32x4*)(C + (size_t)row * 128 + col) = v; });
    __threadfence(); __syncthreads();
    unsigned bad = 0;
    for (int i = threadIdx.x; i < 128 * 128; i += 256) { const int m = i >> 7, n = i & 127; float s = 0.f;
        for (int k = 0; k < 1024; ++k) s += bf2f(H[(size_t)(m0 + m) * 1024 + k]) * bf2f(WIN[(size_t)k * 2048 + n0 + n]);
        if (!(fabsf(C[i] - s) <= 1e-2f * (1.f + fabsf(s)))) bad = 1; }
    if (bad) atomicOr(flag, 1u << blockIdx.x);
}
#endif

extern "C" void kernel_launch(void* const* d_in, const int* in_sizes, int n_in, void* d_out, int out_size, void* d_ws, size_t ws_size, hipStream_t stream) {
    if (n_in != 36 || ws_size < WS_END) { fprintf(stderr, "kernel_launch: unexpected n_in %d or workspace %zu < %zu\n", n_in, ws_size, (size_t)WS_END); return; }
    Params p{};
    const float** pf = (const float**)&p;
    for (int i = 0; i < 36; ++i) pf[i] = (const float*)d_in[i];
    p.out = (float*)d_out; p.ws = (char*)d_ws;
    (void)hipMemsetAsync(d_ws, 0, ZERO_REGION, stream);
#if MEGA
    static int grid = 0;
    if (grid == 0) {
        int dev = 0, cus = 0, per_cu = 0;
        (void)hipGetDevice(&dev); (void)hipDeviceGetAttribute(&cus, hipDeviceAttributeMultiprocessorCount, dev);
        (void)hipFuncSetAttribute((const void*)k_mega, hipFuncAttributeMaxDynamicSharedMemorySize, SMEM_BYTES);
        (void)hipOccupancyMaxActiveBlocksPerMultiprocessor(&per_cu, (const void*)k_mega, 256, SMEM_BYTES);
        (void)hipGetLastError();
        if (per_cu < 1) per_cu = 1;
        grid = cus * (per_cu < 2 ? per_cu : 2);
    }
    hipLaunchKernelGGL(k_mega, dim3(grid), dim3(256), SMEM_BYTES, stream, p);
#else
#if DIAG == 1
    launch_phase<PH_MOD_MIX>(p, 0, stream); launch_phase<PH_FINAL>(p, 4, stream); return;
#endif
#if DIAG == 5
    launch_phase<PH_PROLOGUE>(p, 0, stream); launch_phase<PH_MOD_MIX>(p, 0, stream);
    (void)hipFuncSetAttribute((const void*)k_projtest, hipFuncAttributeMaxDynamicSharedMemorySize, SMEM_BYTES);
    hipLaunchKernelGGL(k_projtest, dim3(4), dim3(256), SMEM_BYTES, stream, p);
    hipLaunchKernelGGL(k_report4, dim3(1024), dim3(256), 0, stream, p); return;
#endif
#if DIAG == 4
    launch_phase<PH_PROLOGUE>(p, 0, stream); launch_phase<PH_MOD_MIX>(p, 0, stream); launch_phase<PH_E2>(p, 0, stream);
    hipLaunchKernelGGL(k_check, dim3(512), dim3(256), 0, stream, p);
    hipLaunchKernelGGL(k_report4, dim3(1024), dim3(256), 0, stream, p); return;
#endif
#if DIAG == 3
    (void)hipFuncSetAttribute((const void*)k_gemmtest, hipFuncAttributeMaxDynamicSharedMemorySize, SMEM_BYTES);
    hipLaunchKernelGGL(k_gemmtest, dim3(1), dim3(256), SMEM_BYTES, stream, p);
    hipLaunchKernelGGL(k_report3, dim3(1024), dim3(256), 0, stream, p); return;
#endif
#if DIAG == 2
#define CEN(off, bytes, isf, idx) hipLaunchKernelGGL(k_census1, dim3(1024), dim3(256), 0, stream, p.ws, (size_t)(off), (size_t)(bytes), isf, idx)
    launch_phase<PH_PROLOGUE>(p, 0, stream); launch_phase<PH_MOD_MIX>(p, 0, stream);
    CEN(OFF_MOD, 491520, 1, 1); CEN(OFF_HREG, (size_t)NT * 2048, 0, 2); CEN(OFF_WTS, W_END, 0, 3);
    launch_phase<PH_E2>(p, 0, stream);
    CEN(OFF_PREG, (size_t)NT * 4096, 0, 4); CEN(OFF_LR1, (size_t)NT * 768, 0, 5);
    launch_phase<PH_E3>(p, 0, stream);
    CEN(OFF_RKVK, (size_t)NT * 1024, 0, 6); CEN(OFF_RKVK + (size_t)NT * 1024, (size_t)NT * 1024, 0, 7); CEN(OFF_RKVK + (size_t)NT * 2048, (size_t)NT * 1024, 0, 8);
    CEN(OFF_RKVK + (size_t)NT * 3072, (size_t)NT * 1024, 0, 9); CEN(OFF_DIFF, (size_t)NT * 1024, 0, 10);
    launch_phase<PH_E4>(p, 0, stream);
    CEN(OFF_WREG, (size_t)NT * 4096, 1, 11); CEN(OFF_KD, (size_t)NT * 2048, 0, 12); CEN(OFF_BB, (size_t)NT * 2048, 0, 13); CEN(OFF_G, (size_t)NT * 1024, 0, 14);
    launch_phase<PH_SCAN>(p, 0, stream);
    CEN(OFF_PREG, (size_t)NT * 4096, 1, 15);
    launch_phase<PH_POST>(p, 0, stream);
    CEN(OFF_HREG, (size_t)NT * 2048, 0, 16);
    launch_phase<PH_WOUT>(p, 0, stream);
    CEN(OFF_RES, (size_t)NT * 4096, 1, 17);
    hipLaunchKernelGGL(k_report, dim3(1024), dim3(256), 0, stream, p); return;
#endif
    launch_phase<PH_PROLOGUE>(p, 0, stream);
    for (int layer = 0; layer < 4; ++layer) {
        launch_phase<PH_MOD_MIX>(p, layer, stream);
        if ((layer & 1) == 0) {
            launch_phase<PH_E2>(p, layer, stream); launch_phase<PH_E3>(p, layer, stream); launch_phase<PH_E4>(p, layer, stream);
            launch_phase<PH_SCAN>(p, layer, stream); launch_phase<PH_POST>(p, layer, stream); launch_phase<PH_WOUT>(p, layer, stream);
        } else {
            launch_phase<PH_F1>(p, layer, stream); launch_phase<PH_F2>(p, layer, stream); launch_phase<PH_F3>(p, layer, stream); launch_phase<PH_WF>(p, layer, stream);
        }
        launch_phase<PH_MOD_FFN>(p, layer, stream); launch_phase<PH_ROUTER>(p, layer, stream); launch_phase<PH_MOE1>(p, layer, stream); launch_phase<PH_MOE2>(p, layer, stream);
    }
    launch_phase<PH_FINAL>(p, 4, stream);
#endif
}
```

```cpp
#include <hip/hip_runtime.h>
#include <stdint.h>
#include <stdio.h>

#ifndef DIAG
#define DIAG 0
#endif
#ifndef CHUNKED
#define CHUNKED 1
#endif
#ifndef ROUTER_NK
#define ROUTER_NK 16
#endif
#ifndef MEGA
#define MEGA 1
#endif

typedef unsigned short bf16_t;
typedef short bf16x8 __attribute__((ext_vector_type(8)));
typedef short s16x4 __attribute__((ext_vector_type(4)));
typedef float f32x4 __attribute__((ext_vector_type(4)));
typedef unsigned u32x4 __attribute__((ext_vector_type(4)));
typedef unsigned u32x2 __attribute__((ext_vector_type(2)));
#define LAS __attribute__((address_space(3)))
#define GAS __attribute__((address_space(1)))

#define NL 32768
#define NCX 1024
#define NT 33792
#define DM 1024
#define TOKCAP NT
#define YM_ROWS 71680

#define MBY(x) ((size_t)(x) << 20)
constexpr size_t OFF_BAR = 0, OFF_CNT = 16384, OFF_ZERO = 16384 + 1024, ZERO_REGION = 32768;
constexpr size_t OFF_POFF = 32768, OFF_MOD = 65536;
constexpr size_t OFF_ROUTEI = MBY(1), OFF_ROUTEG = MBY(1) + 270336, OFF_TOKL = MBY(2);
constexpr size_t OFF_WTS = MBY(8);
constexpr size_t W_WIN = 0, W_WOUT = W_WIN + 8388608, W_WF = W_WOUT + 4194304, W_LR1 = W_WF + 4194304, W_LR2 = W_LR1 + 3145728,
                 W_POOL = W_LR2 + 786432, W_RW = W_POOL + 262144, W_DFTC = W_RW + 3145728, W_TW = W_DFTC + 262144, W_CS128 = W_TW + 4194304,
                 W_CS256 = W_CS128 + 65536, W_END = W_CS256 + 262144;
static_assert(W_END < MBY(32), "weights region");
constexpr size_t OFF_RES = MBY(40), OFF_HREG = MBY(172), OFF_PREG = MBY(238), OFF_LR1 = MBY(378), OFF_RKVK = MBY(403), OFF_DIFF = MBY(535),
                 OFF_WREG = MBY(568), OFF_KD = MBY(700), OFF_BB = MBY(766), OFF_G = MBY(836), WS_END = MBY(1001);
constexpr size_t OFF_W2 = OFF_RKVK + (size_t)3 * 33792 * 512 * 2;

struct Params {
    const float *x, *c, *ctx, *c_ctx, *ada_w, *ada_b, *norm_mix, *norm_ffn, *w_in, *mu_x, *mu_p, *decay_w0, *decay_w1, *decay_w2, *lr_a0, *lr_a1, *lr_a2,
        *gate_g1, *gate_g2, *k_k, *k_a, *r_k, *gn_w, *gn_b, *pool_w, *pool_scale, *w_out, *w_fourier, *router_c, *router_c_b, *router_f, *router_f_b,
        *moe_w1, *moe_w3, *moe_w2, *final_norm;
    float* out;
    char* ws;
};

typedef float f32x2_ __attribute__((ext_vector_type(2)));
typedef __bf16 bf16x2_ __attribute__((ext_vector_type(2)));
__device__ __forceinline__ unsigned pk2(float lo, float hi) { const f32x2_ v = {lo, hi}; const bf16x2_ r = __builtin_convertvector(v, bf16x2_); return __builtin_bit_cast(unsigned, r); }
__device__ __forceinline__ bf16_t f2bf(float f) { return (bf16_t)(pk2(f, 0.f) & 0xffffu); }
__device__ __forceinline__ float bf2f(bf16_t h) { return __uint_as_float((unsigned)h << 16); }
__device__ __forceinline__ float bflo(unsigned u) { return __uint_as_float(u << 16); }
__device__ __forceinline__ float bfhi(unsigned u) { return __uint_as_float(u & 0xffff0000u); }
__device__ __forceinline__ float rl_(float x, int l) { return __builtin_bit_cast(float, __builtin_amdgcn_readlane(__builtin_bit_cast(int, x), l)); }
template <int CTRL> __device__ __forceinline__ float dppf(float v) { return __builtin_bit_cast(float, __builtin_amdgcn_update_dpp(0, __builtin_bit_cast(int, v), CTRL, 0xf, 0xf, true)); }
__device__ __forceinline__ float sum8(float v) { v += dppf<0xB1>(v); v += dppf<0x4E>(v); v += dppf<0x141>(v); return v; }
__device__ __forceinline__ float sum16(float v) { v += dppf<0xB1>(v); v += dppf<0x4E>(v); v += dppf<0x141>(v); v += dppf<0x140>(v); return v; }
__device__ __forceinline__ float wave_sum(float v) {
    v += dppf<0xB1>(v); v += dppf<0x4E>(v); v += dppf<0x141>(v); v += dppf<0x140>(v);
    return (rl_(v, 0) + rl_(v, 16)) + (rl_(v, 32) + rl_(v, 48));
}
__device__ __forceinline__ float fexp(float x) { return __builtin_amdgcn_exp2f(x * 1.44269504089f); }
__device__ __forceinline__ float frcp(float x) { return __builtin_amdgcn_rcpf(x); }
__device__ __forceinline__ float frsq(float x) { return __builtin_amdgcn_rsqf(x); }
__device__ __forceinline__ float sigmoidf_(float x) { return frcp(1.f + fexp(-x)); }
__device__ __forceinline__ float tanhf_(float x) { return 1.f - 2.f * frcp(fexp(2.f * x) + 1.f); }
__device__ __forceinline__ int shift_src(int r, int q) {
    if (r < NL) {
        const int t = r & 8191, col = t & 63, row = t >> 6;
        if (q == 0) return col > 0 ? r - 1 : -1;
        if (q == 1) return col < 63 ? r + 1 : -1;
        if (q == 2) return row > 0 ? r - 64 : -1;
        return row < 127 ? r + 64 : -1;
    } else {
        const int t = (r - NL) & 255;
        if (q < 2) return t > 0 ? r - 1 : -1;
        return t < 255 ? r + 1 : -1;
    }
}

__device__ __forceinline__ int ltid() { int t = threadIdx.x; asm volatile("" : "+v"(t)); return t; }

#define XB_TMO      128
#define XB_XCNT(j)  (256  + 64 * (j))
#define XB_XSUB(j)  (1280 + 64 * (j))
#define XB_XGEN(j)  (2304 + 64 * (j))
#define XB_TOP      3328
#define XB_TOPGEN   3392
#define XCD_BAR_WORDS 3456
#define XB_SPIN_CAP (1u << 22)
__device__ __forceinline__ unsigned xb_ld(unsigned* p)              { return __hip_atomic_load(p, __ATOMIC_RELAXED, __HIP_MEMORY_SCOPE_AGENT); }
__device__ __forceinline__ unsigned xb_add(unsigned* p, unsigned v) { return __hip_atomic_fetch_add(p, v, __ATOMIC_RELAXED, __HIP_MEMORY_SCOPE_AGENT); }
__device__ __forceinline__ unsigned xb_xcc_id() { return (unsigned)__builtin_amdgcn_s_getreg((3 << 11) | 20) & 0xFu; }
#define XB_SPIN(cond, bar) do { unsigned _sp = 0; while (cond) { __builtin_amdgcn_s_sleep(1); \
    if ((++_sp & 255u) == 0u) { if (xb_ld(&(bar)[XB_TMO])) break; if (_sp > XB_SPIN_CAP) { atomicAdd(&(bar)[XB_TMO], 1u); break; } } } } while (0)
struct XcdBarrier { unsigned* bar; unsigned x; volatile LAS unsigned* st; };
__device__ __forceinline__ XcdBarrier xcd_barrier_post(unsigned* bar, volatile LAS unsigned* st) {
    XcdBarrier b; b.bar = bar; b.x = xb_xcc_id(); b.st = st;
    if (threadIdx.x == 0) (void)xb_add(&bar[XB_XCNT(b.x)], 1u);
    return b;
}
__device__ __forceinline__ void xcd_barrier_complete(unsigned* bar, unsigned x, unsigned& nloc, unsigned& nx) {
    const unsigned G = gridDim.x * gridDim.y * gridDim.z;
    unsigned sum, cnt, mine, sp = 0u;
    for (;;) {
        sum = 0u; cnt = 0u; mine = 0u;
#pragma unroll
        for (unsigned j = 0; j < 16; ++j) { const unsigned c = xb_ld(&bar[XB_XCNT(j)]); sum += c; cnt += (c > 0u) ? 1u : 0u; mine = (j == x) ? c : mine; }
        if (sum == G) break;
        __builtin_amdgcn_s_sleep(1);
        if ((++sp & 255u) == 0u) { if (xb_ld(&bar[XB_TMO])) break; if (sp > XB_SPIN_CAP) { atomicAdd(&bar[XB_TMO], 1u); break; } }
    }
    nloc = mine > 0u ? mine : 1u; nx = cnt > 0u ? cnt : 1u;
}
__device__ __forceinline__ void xcd_barrier(const XcdBarrier& b) {
    asm volatile("s_waitcnt vmcnt(0)" ::: "memory");
    __syncthreads();
    if (threadIdx.x == 0) {
        unsigned* bar = b.bar;
        __builtin_amdgcn_s_waitcnt(0);
        unsigned nloc = b.st[0], nx = b.st[1];
        if (nloc == 0u) { xcd_barrier_complete(bar, b.x, nloc, nx); b.st[0] = nloc; b.st[1] = nx; }
        const unsigned old = xb_add(&bar[XB_XSUB(b.x)], 1u);
        const unsigned gen = old / nloc;
        if (old + 1u == (gen + 1u) * nloc) {
            __builtin_amdgcn_fence(__ATOMIC_RELEASE, "agent");
            asm volatile("s_waitcnt vmcnt(0)" ::: "memory");
            const unsigned og = xb_add(&bar[XB_TOP], 1u);
            const unsigned tg = og / nx;
            if (og + 1u == (tg + 1u) * nx) xb_add(&bar[XB_TOPGEN], 1u);
            else XB_SPIN(xb_ld(&bar[XB_TOPGEN]) == tg, bar);
            __builtin_amdgcn_fence(__ATOMIC_ACQUIRE, "agent");
            xb_add(&bar[XB_XGEN(b.x)], 1u);
            asm volatile("s_waitcnt vmcnt(0)" ::: "memory");
        } else {
            XB_SPIN(xb_ld(&bar[XB_XGEN(b.x)]) == gen, bar);
            __builtin_amdgcn_fence(__ATOMIC_ACQUIRE, "agent");
            asm volatile("s_waitcnt vmcnt(0)" ::: "memory");
        }
    }
    __syncthreads();
}

#define G_ABYTES (128 * 128)
#define G_BBYTES (64 * 256)
#define G_STAGE (G_ABYTES + G_BBYTES)
#define SM_BAR 73728
#define SM_TAB (SM_BAR + 16)
#define SMEM_BYTES (SM_TAB + 512)
__device__ __forceinline__ int bswz(int k) { return ((k & 3) << 2) | ((k >> 2) & 3); }

__device__ __forceinline__ void glds16_asm(const void* gsrc, unsigned lds_dst) {
    unsigned keep;
    asm volatile("s_mov_b32 %0, m0\n\ts_mov_b32 m0, %2\n\ts_nop 0\n\tglobal_load_lds_dwordx4 %1, off\n\ts_mov_b32 m0, %0" : "=&s"(keep) : "v"(gsrc), "s"(lds_dst) : "memory");
}
template <class AF, class BF>
__device__ __forceinline__ void gemm_tile(char* smem, int nk, const AF& af, const BF& bf, f32x4 (&acc)[4][4]) {
    const int tid = ltid(), lane = tid & 63, wid = tid >> 6, wm = wid >> 1, wn = wid & 1;
#pragma unroll
    for (int i = 0; i < 4; ++i)
#pragma unroll
        for (int j = 0; j < 4; ++j) acc[i][j] = (f32x4){0.f, 0.f, 0.f, 0.f};
    const int arow = tid >> 3, akc = (((tid & 7) ^ (arow & 7)) << 3), brow = tid >> 4, bnc = (((tid & 15) ^ bswz(brow)) << 3);
    int ainfo[4];
#pragma unroll
    for (int i = 0; i < 4; ++i) ainfo[i] = af.info(arow + 32 * i);
    const unsigned lds0 = (unsigned)__builtin_amdgcn_readfirstlane((int)((unsigned)(size_t)smem + (unsigned)(wid * 1024)));
    auto issue = [&](int kt, int buf) {
        const unsigned dst = lds0 + (unsigned)(buf * G_STAGE);
#pragma unroll
        for (int i = 0; i < 4; ++i) glds16_asm(af.ptr(ainfo[i], arow + 32 * i, kt * 64 + akc), dst + i * 4096);
#pragma unroll
        for (int i = 0; i < 4; ++i) glds16_asm(bf.ptr(kt * 64 + brow + 16 * i, bnc), dst + G_ABYTES + i * 4096);
    };
    const int ar = wm * 64 + (lane & 15), ax = lane & 7, ag = lane >> 4;
    const int bg = lane >> 4, bq = (lane & 15) >> 2, bp = lane & 3;
    __syncthreads();
    issue(0, 0);
    asm volatile("s_waitcnt vmcnt(0)" ::: "memory");
    __syncthreads();
    for (int kt = 0; kt < nk; ++kt) {
        if (kt + 1 < nk) issue(kt + 1, (kt + 1) & 1);
        const char* sa = smem + (kt & 1) * G_STAGE; const char* sb = sa + G_ABYTES;
#pragma unroll
        for (int ks = 0; ks < 2; ++ks) {
            bf16x8 a[4], b[4];
#pragma unroll
            for (int mt = 0; mt < 4; ++mt) a[mt] = *(const bf16x8*)(sa + (ar + mt * 16) * 128 + (((4 * ks + ag) ^ ax) << 4));
#pragma unroll
            for (int nt = 0; nt < 4; ++nt) {
                const int c2 = 2 * (wn * 4 + nt) + (bp >> 1);
                const int k0 = 32 * ks + 8 * bg + bq, k1 = k0 + 4;
                const s16x4 lo = __builtin_amdgcn_ds_read_tr16_b64_v4i16((LAS s16x4*)(sb + k0 * 256 + ((c2 ^ bswz(k0)) << 4) + 8 * (bp & 1)));
                const s16x4 hi = __builtin_amdgcn_ds_read_tr16_b64_v4i16((LAS s16x4*)(sb + k1 * 256 + ((c2 ^ bswz(k1)) << 4) + 8 * (bp & 1)));
                b[nt] = __builtin_shufflevector(lo, hi, 0, 1, 2, 3, 4, 5, 6, 7);
            }
            __builtin_amdgcn_s_setprio(1);
#pragma unroll
            for (int mt = 0; mt < 4; ++mt)
#pragma unroll
                for (int nt = 0; nt < 4; ++nt) acc[mt][nt] = __builtin_amdgcn_mfma_f32_16x16x32_bf16(b[nt], a[mt], acc[mt][nt], 0, 0, 0);
            __builtin_amdgcn_s_setprio(0);
        }
        asm volatile("s_waitcnt vmcnt(0)" ::: "memory");
        __syncthreads();
    }
}
#define EPI_FOR(acc, ...) do { const int _l = ltid() & 63, _w = ltid() >> 6, _wm = _w >> 1, _wn = _w & 1; \
    _Pragma("unroll") for (int _mt = 0; _mt < 4; ++_mt) _Pragma("unroll") for (int _nt = 0; _nt < 4; ++_nt) { \
        const int row = _wm * 64 + _mt * 16 + (_l & 15), col = _wn * 64 + _nt * 16 + 4 * (_l >> 4); const f32x4 v = acc[_mt][_nt]; __VA_ARGS__ } } while (0)

__device__ __forceinline__ void st_bf4(bf16_t* p, f32x4 v) { u32x2 w; w.x = pk2(v[0], v[1]); w.y = pk2(v[2], v[3]); *(u32x2*)p = w; }

struct W2Conv {
    const float* src; bf16_t* dst; int nslices, wg, nwg; f32x4 r[8];
    static constexpr size_t N4 = (size_t)32 * 512 * 1024 / 4;
    __device__ __forceinline__ size_t item(int i, int k) const { return ((size_t)(k * nslices + i) * nwg + wg) * 256 + ltid(); }
    __device__ __forceinline__ void load(int i) {
        if (i >= nslices) return;
#pragma unroll
        for (int k = 0; k < 8; ++k) { const size_t it = item(i, k); if (it < N4) r[k] = __builtin_nontemporal_load((const f32x4*)(src + 4 * it)); }
    }
    __device__ __forceinline__ void store(int i) {
        if (i >= nslices) return;
#pragma unroll
        for (int k = 0; k < 8; ++k) { const size_t it = item(i, k); if (it < N4) st_bf4(dst + 4 * it, r[k]); }
    }
};

struct APlain { const bf16_t* base; int lda; int m0; __device__ __forceinline__ int info(int row) const { return m0 + row; }
    __device__ __forceinline__ const bf16_t* ptr(int gr, int, int k) const { return base + (size_t)gr * lda + k; } };
struct BPlain { const bf16_t* base; int ldb; __device__ __forceinline__ const bf16_t* ptr(int k, int n) const { return base + (size_t)k * ldb + n; } };

enum { PH_PROLOGUE = 0, PH_MOD_MIX, PH_E2, PH_E3, PH_E4, PH_SCAN, PH_POST, PH_WOUT, PH_F1, PH_F2, PH_F3, PH_WF, PH_MOD_FFN, PH_ROUTER, PH_MOE1, PH_MOE2, PH_FINAL, PH_SCANV, PH_ROUTERV, PH_WOUTV, PH_S1A, PH_S2A, PH_S1B, PH_S2B, PH_FFNR };

#ifndef SCANVAR
#define SCANVAR 0
#endif

#define WSP(T, off) ((T*)(p.ws + (off)))

__device__ __forceinline__ void phase_prologue(const Params& p, char* smem, int wg, int nwg) {
    const int tid = ltid(), lane = tid & 63, wv = tid >> 6;
    float* S = (float*)smem;
    float* RED = S + 5 * 1024;
    for (int idx = tid; idx < 5 * 1024; idx += 256) { const int rb = idx >> 10, k = idx & 1023; const float cv = rb < 4 ? p.c[rb * 1024 + k] : p.c_ctx[k]; S[idx] = cv / (1.f + expf(-cv)); }
    __syncthreads();
    float* mod = WSP(float, OFF_MOD);
    for (int task = wg; task < 384; task += nwg) {
        const int i = task / 96, n0 = (task % 96) * 64;
        const float* W = p.ada_w + (size_t)i * 1024 * 6144 + n0 + lane;
        float a0 = 0.f, a1 = 0.f, a2 = 0.f, a3 = 0.f, a4 = 0.f;
        for (int k = wv * 256; k < wv * 256 + 256; k += 8) {
            float w[8];
#pragma unroll
            for (int u = 0; u < 8; ++u) w[u] = __builtin_nontemporal_load(W + (size_t)(k + u) * 6144);
#pragma unroll
            for (int u = 0; u < 8; ++u) { a0 += S[k + u] * w[u]; a1 += S[1024 + k + u] * w[u]; a2 += S[2048 + k + u] * w[u]; a3 += S[3072 + k + u] * w[u]; a4 += S[4096 + k + u] * w[u]; }
        }
        RED[(wv * 5 + 0) * 64 + lane] = a0; RED[(wv * 5 + 1) * 64 + lane] = a1; RED[(wv * 5 + 2) * 64 + lane] = a2; RED[(wv * 5 + 3) * 64 + lane] = a3; RED[(wv * 5 + 4) * 64 + lane] = a4;
        __syncthreads();
        for (int o = tid; o < 320; o += 256) { const int r = o >> 6, l = o & 63;
            const float s = RED[(0 * 5 + r) * 64 + l] + RED[(1 * 5 + r) * 64 + l] + RED[(2 * 5 + r) * 64 + l] + RED[(3 * 5 + r) * 64 + l];
            mod[(size_t)(r * 4 + i) * 6144 + n0 + l] = s + p.ada_b[i * 6144 + n0 + l]; }
        __syncthreads();
    }
    const size_t gt = (size_t)wg * 256 + tid, gs = (size_t)nwg * 256;
    char* wts = p.ws + OFF_WTS;
    auto cast4 = [&](const float* src, bf16_t* dst, size_t n4) { for (size_t i = gt; i < n4; i += gs) { const f32x4 v = __builtin_nontemporal_load((const f32x4*)(src + 4 * i)); st_bf4(dst + 4 * i, v); } };
    cast4(p.w_in, (bf16_t*)(wts + W_WIN), (size_t)2 * 1024 * 2048 / 4);
    cast4(p.w_out, (bf16_t*)(wts + W_WOUT), (size_t)2 * 1024 * 1024 / 4);
    cast4(p.w_fourier, (bf16_t*)(wts + W_WF), (size_t)2 * 1024 * 1024 / 4);
    cast4(p.pool_w, (bf16_t*)(wts + W_POOL), (size_t)2 * 512 * 128 / 4);
    {
        bf16_t* d = (bf16_t*)(wts + W_LR1);
        for (size_t i = gt; i < (size_t)2 * 2048 * 384; i += gs) {
            const int n = (int)(i % 384), kk = (int)((i / 384) % 2048), j = (int)(i / (384 * 2048)); const int k = kk & 1023;
            float w, mu;
            if (n < 128) { const int dd = n >> 6; w = p.decay_w1[((size_t)(j * 2 + dd) * 1024 + k) * 64 + (n & 63)]; mu = p.mu_x[(j * 3 + 0) * 1024 + k]; }
            else if (n < 256) { const int dd = (n - 128) >> 6; w = p.lr_a1[((size_t)(j * 2 + dd) * 1024 + k) * 64 + (n & 63)]; mu = p.mu_x[(j * 3 + 1) * 1024 + k]; }
            else { w = p.gate_g1[((size_t)j * 1024 + k) * 128 + (n - 256)]; mu = p.mu_x[(j * 3 + 2) * 1024 + k]; }
            d[i] = f2bf(kk < 1024 ? (1.f - mu) * w : mu * w);
        }
    }
    {
        bf16_t* d = (bf16_t*)(wts + W_LR2);
        for (size_t i = gt; i < (size_t)2 * 384 * 512; i += gs) {
            const int n = (int)(i % 512), k = (int)((i / 512) % 384), j = (int)(i / (512 * 384));
            float w;
            if (k < 128) w = p.decay_w2[((size_t)(j * 2 + (k >> 6)) * 64 + (k & 63)) * 512 + n];
            else if (k < 256) w = p.lr_a2[((size_t)(j * 2 + ((k - 128) >> 6)) * 64 + (k & 63)) * 512 + n];
            else w = p.gate_g2[((size_t)j * 128 + (k - 256)) * 512 + n];
            d[i] = f2bf(w);
        }
    }
    {
        uint32_t* d = (uint32_t*)(wts + W_RW);
        for (size_t i = gt; i < (size_t)4 * 4608 * 4; i += gs) {
            const int l = (int)(i / 18432), q = (int)(i % 18432) >> 2, k = (int)(i & 3);
            float w0, w1;
            if (q < 4096) { const int ln = q & 63, hf = (q >> 6) & 1, pp = (q >> 7) & 7, gi = q >> 10; const int c0 = 4 * ln + 256 * (pp >> 1) + 2 * (pp & 1), x = gi * 8 + hf * 4 + k;
                w0 = p.router_f[((size_t)l * 1024 + c0) * 32 + x]; w1 = p.router_f[((size_t)l * 1024 + c0 + 1) * 32 + x]; }
            else { const int q2 = q - 4096, ln = q2 & 63, pp = q2 >> 6; const int c0 = 4 * ln + 256 * (pp >> 1) + 2 * (pp & 1);
                w0 = p.router_c[((size_t)l * 1024 + c0) * 4 + k]; w1 = p.router_c[((size_t)l * 1024 + c0 + 1) * 4 + k]; }
            d[i] = pk2(w0, w1);
        }
    }
    {
        bf16_t* d = (bf16_t*)(wts + W_DFTC);
        for (size_t i = gt; i < (size_t)256 * 512; i += gs) { const int n = (int)(i & 511), c = (int)(i >> 9); const int idx = (c * (n & 255)) & 255; float sn, cs; sincospif((float)idx / 128.f, &sn, &cs); d[i] = f2bf(n < 256 ? cs : -sn); }
    }
    {
        bf16_t* d = (bf16_t*)(wts + W_TW);
        for (size_t i = gt; i < (size_t)128 * 128 * 128; i += gs) {
            const int col = (int)(i & 127), row = (int)((i >> 7) & 127), t2 = (int)(i >> 14);
            const int pp = row >> 6, f1 = row & 63, pi = col >> 6, t1 = col & 63; const int idx = (t1 * f1 * 128 + t2 * f1) & 8191;
            float sn, cs; sincospif((float)idx / 4096.f, &sn, &cs);
            d[i] = f2bf(pp == 0 ? (pi == 0 ? cs : sn) : (pi == 0 ? -sn : cs));
        }
    }
    {
        bf16_t* d = (bf16_t*)(wts + W_CS128);
        for (size_t i = gt; i < (size_t)128 * 256; i += gs) { const int col = (int)(i & 255), f2 = (int)(i >> 8); const int pi = col >> 7, t2 = col & 127, idx = (t2 * f2) & 127; float sn, cs; sincospif((float)idx / 64.f, &sn, &cs); d[i] = f2bf(pi == 0 ? cs : sn); }
    }
    {
        bf16_t* d = (bf16_t*)(wts + W_CS256);
        for (size_t i = gt; i < (size_t)256 * 512; i += gs) { const int col = (int)(i & 511), f = (int)(i >> 9); const int pi = col >> 8, t = col & 255, idx = (t * f) & 255; float sn, cs; sincospif((float)idx / 128.f, &sn, &cs); d[i] = f2bf(pi == 0 ? cs : sn); }
    }
}

template <int MODE>
__device__ __forceinline__ void phase_modulate(const Params& p, int layer, int nrows, bool first, bool combine, int wg, int nwg) {
    const int lane = ltid() & 63, wv = ltid() >> 6;
    float* RES = WSP(float, OFF_RES);
    const float* mod = WSP(float, OFF_MOD);
    bf16_t* H = WSP(bf16_t, OFF_HREG); bf16_t* HLO = WSP(bf16_t, OFF_KD);
    const bf16_t* YM = WSP(bf16_t, OFF_PREG);
    const int* routei = WSP(int, OFF_ROUTEI); const float* routeg = WSP(float, OFF_ROUTEG);
    const int* poff = WSP(int, OFF_POFF) + (MODE == 2 ? 3 : layer - 1) * 64;
    const int lprev = MODE == 2 ? 3 : layer - 1;
    for (int r = wg * 4 + wv; r < nrows; r += nwg * 4) {
        const float* src = first ? (r < NL ? p.x + (size_t)r * 1024 : p.ctx + (size_t)(r - NL) * 1024) : RES + (size_t)r * 1024;
        f32x4 v[4];
#pragma unroll
        for (int j = 0; j < 4; ++j) v[j] = *(const f32x4*)(src + 4 * lane + 256 * j);
        const int mb = r < NL ? (r >> 13) : 4;
        if (combine) {
            const int i0 = routei[2 * r], i1 = routei[2 * r + 1]; const float g0 = routeg[2 * r], g1 = routeg[2 * r + 1];
            const size_t row0 = (size_t)poff[i0 & 31] + (i0 >> 5), row1 = (size_t)poff[i1 & 31] + (i1 >> 5);
            const float* m5 = mod + (size_t)(mb * 4 + lprev) * 6144 + 5 * 1024;
#pragma unroll
            for (int j = 0; j < 4; ++j) {
                const u32x2 y0 = *(const u32x2*)(YM + row0 * 1024 + 4 * lane + 256 * j), y1 = *(const u32x2*)(YM + row1 * 1024 + 4 * lane + 256 * j);
                const f32x4 g = *(const f32x4*)(m5 + 4 * lane + 256 * j);
                v[j][0] += g[0] * (g0 * bflo(y0.x) + g1 * bflo(y1.x)); v[j][1] += g[1] * (g0 * bfhi(y0.x) + g1 * bfhi(y1.x));
                v[j][2] += g[2] * (g0 * bflo(y0.y) + g1 * bflo(y1.y)); v[j][3] += g[3] * (g0 * bfhi(y0.y) + g1 * bfhi(y1.y));
            }
        }
        if (combine && MODE != 2) {
#pragma unroll
            for (int j = 0; j < 4; ++j) *(f32x4*)(RES + (size_t)r * 1024 + 4 * lane + 256 * j) = v[j];
        }
        float ss = 0.f;
#pragma unroll
        for (int j = 0; j < 4; ++j) ss += (v[j][0] * v[j][0] + v[j][1] * v[j][1]) + (v[j][2] * v[j][2] + v[j][3] * v[j][3]);
        ss = wave_sum(ss);
        const float rinv = frsq(ss * (1.f / 1024.f) + 1e-6f);
        if (MODE == 2) {
#if DIAG
            if (!(ss < 3.0e38f)) {
#pragma unroll
                for (int j = 0; j < 4; ++j) *(f32x4*)(p.out + (size_t)r * 1024 + 4 * lane + 256 * j) = (f32x4){3.f, 3.f, 3.f, 3.f};
                continue;
            }
#endif
#pragma unroll
            for (int j = 0; j < 4; ++j) { const f32x4 g = *(const f32x4*)(p.final_norm + 4 * lane + 256 * j); f32x4 o; o[0] = v[j][0] * rinv * g[0]; o[1] = v[j][1] * rinv * g[1]; o[2] = v[j][2] * rinv * g[2]; o[3] = v[j][3] * rinv * g[3];
                *(f32x4*)(p.out + (size_t)r * 1024 + 4 * lane + 256 * j) = o; }
        } else {
            const float* gn = (MODE == 0 ? p.norm_mix : p.norm_ffn) + layer * 1024;
            const float* sh = mod + (size_t)(mb * 4 + layer) * 6144 + (MODE == 0 ? 0 : 3) * 1024;
            const float* sc = sh + 1024;
#pragma unroll
            for (int j = 0; j < 4; ++j) {
                const int c = 4 * lane + 256 * j;
                const f32x4 g = *(const f32x4*)(gn + c), s1 = *(const f32x4*)(sh + c), s2 = *(const f32x4*)(sc + c);
                f32x4 h;
#pragma unroll
                for (int e = 0; e < 4; ++e) h[e] = (v[j][e] * rinv * g[e]) * (1.f + s2[e]) + s1[e];
                u32x2 w; w.x = pk2(h[0], h[1]); w.y = pk2(h[2], h[3]);
                *(u32x2*)(H + (size_t)r * 1024 + c) = w;
                if (MODE == 1 && ROUTER_NK > 32) { u32x2 w2; w2.x = pk2(h[0] - bflo(w.x), h[1] - bfhi(w.x)); w2.y = pk2(h[2] - bflo(w.y), h[3] - bfhi(w.y)); *(u32x2*)(HLO + (size_t)r * 1024 + c) = w2; }
            }
        }
    }
}


template <int MODE, bool COMBINE>
__device__ __forceinline__ void phase_modpipe(const Params& p, int layer, int nrows, int wg, int nwg) {
    const int tid = ltid(), lane = tid & 63, wv = __builtin_amdgcn_readfirstlane(tid >> 6);
    float* RES = WSP(float, OFF_RES);
    const float* mod = WSP(float, OFF_MOD);
    bf16_t* H = WSP(bf16_t, OFF_HREG);
    const bf16_t* YM = WSP(bf16_t, OFF_PREG);
    const int* routei = WSP(int, OFF_ROUTEI); const float* routeg = WSP(float, OFF_ROUTEG);
    const int lprev = MODE == 2 ? 3 : layer - 1;
    int poffv = 0;
    if (COMBINE) poffv = (WSP(int, OFF_POFF) + lprev * 64)[lane & 31];
    const int rstep = nwg * 4, rlast = nrows - 1;
    int r = wg * 4 + wv;
    if (r >= nrows) return;
    const float* gn = MODE == 2 ? p.final_norm : p.norm_mix + layer * 1024;
    f32x4 A[4], B[4], G5[4]; int mbc = -1;
    u32x2 ri[2] = {{0u, 0u}, {0u, 0u}}; f32x2_ rg[2] = {{0.f, 0.f}, {0.f, 0.f}};
    f32x4 v[2][4]; u32x2 ya[2][4], yb[2][4]; float g0[2] = {0.f, 0.f}, g1[2] = {0.f, 0.f};
#define MP_SRC(rr) (COMBINE ? RES + (size_t)(rr) * 1024 : ((rr) < NL ? p.x + (size_t)(rr) * 1024 : p.ctx + (size_t)((rr) - NL) * 1024))
#define MP_ISSUE(rr, Q) do { \
        const float* src_ = MP_SRC(rr); \
        _Pragma("unroll") for (int j = 0; j < 4; ++j) v[Q][j] = __builtin_nontemporal_load((const f32x4*)(src_ + 4 * lane + 256 * j)); \
        if (COMBINE) { const int i0 = __builtin_amdgcn_readfirstlane((int)ri[Q].x), i1 = __builtin_amdgcn_readfirstlane((int)ri[Q].y); \
            const size_t row0 = (size_t)__builtin_amdgcn_readlane(poffv, i0 & 31) + (i0 >> 5), row1 = (size_t)__builtin_amdgcn_readlane(poffv, i1 & 31) + (i1 >> 5); \
            _Pragma("unroll") for (int j = 0; j < 4; ++j) { ya[Q][j] = __builtin_nontemporal_load((const u32x2*)(YM + row0 * 1024 + 4 * lane + 256 * j)); yb[Q][j] = __builtin_nontemporal_load((const u32x2*)(YM + row1 * 1024 + 4 * lane + 256 * j)); } \
            g0[Q] = rg[Q].x; g1[Q] = rg[Q].y; } } while (0)
    if (COMBINE) { ri[0] = *(const u32x2*)(routei + 2 * r); rg[0] = *(const f32x2_*)(routeg + 2 * r);
        const int r1 = min(r + rstep, rlast); ri[1] = *(const u32x2*)(routei + 2 * r1); rg[1] = *(const f32x2_*)(routeg + 2 * r1); }
    MP_ISSUE(r, 0);
#define MP_STEP(Q) { \
        if (r >= nrows) break; \
        const int mb = r < NL ? (r >> 13) : 4; \
        if (mb != mbc) { mbc = mb; \
            const float* sh = mod + (size_t)(mb * 4 + layer) * 6144; const float* sc = sh + 1024; \
            const float* m5 = mod + (size_t)(mb * 4 + lprev) * 6144 + 5 * 1024; \
            _Pragma("unroll") for (int j = 0; j < 4; ++j) { const int c = 4 * lane + 256 * j; const f32x4 g = *(const f32x4*)(gn + c); \
                if (COMBINE) G5[j] = *(const f32x4*)(m5 + c); \
                if (MODE == 2) A[j] = g; \
                else { const f32x4 s1 = *(const f32x4*)(sh + c), s2 = *(const f32x4*)(sc + c); \
                    _Pragma("unroll") for (int e = 0; e < 4; ++e) { A[j][e] = g[e] * (1.f + s2[e]); B[j][e] = s1[e]; } } } \
        } \
        { const int r1 = min(r + rstep, rlast); MP_ISSUE(r1, 1 - (Q)); }                    \
        if (COMBINE) { const int r2 = min(r + 2 * rstep, rlast); ri[Q] = *(const u32x2*)(routei + 2 * r2); rg[Q] = *(const f32x2_*)(routeg + 2 * r2); }     \
        __builtin_amdgcn_sched_barrier(0); \
        if (COMBINE) { \
            _Pragma("unroll") for (int j = 0; j < 4; ++j) { \
                v[Q][j][0] += G5[j][0] * (g0[Q] * bflo(ya[Q][j].x) + g1[Q] * bflo(yb[Q][j].x)); v[Q][j][1] += G5[j][1] * (g0[Q] * bfhi(ya[Q][j].x) + g1[Q] * bfhi(yb[Q][j].x)); \
                v[Q][j][2] += G5[j][2] * (g0[Q] * bflo(ya[Q][j].y) + g1[Q] * bflo(yb[Q][j].y)); v[Q][j][3] += G5[j][3] * (g0[Q] * bfhi(ya[Q][j].y) + g1[Q] * bfhi(yb[Q][j].y)); \
            } \
            if (MODE != 2) { _Pragma("unroll") for (int j = 0; j < 4; ++j) *(f32x4*)(RES + (size_t)r * 1024 + 4 * lane + 256 * j) = v[Q][j]; } \
        } \
        float ss = 0.f; \
        _Pragma("unroll") for (int j = 0; j < 4; ++j) ss += (v[Q][j][0] * v[Q][j][0] + v[Q][j][1] * v[Q][j][1]) + (v[Q][j][2] * v[Q][j][2] + v[Q][j][3] * v[Q][j][3]); \
        ss = wave_sum(ss); \
        const float rinv = frsq(ss * (1.f / 1024.f) + 1e-6f); \
        _Pragma("unroll") for (int j = 0; j < 4; ++j) { \
            const int c = 4 * lane + 256 * j; \
            if (MODE == 2) { f32x4 o; \
                _Pragma("unroll") for (int e = 0; e < 4; ++e) o[e] = v[Q][j][e] * rinv * A[j][e]; \
                __builtin_nontemporal_store(o, (f32x4*)(p.out + (size_t)r * 1024 + c)); \
            } else { float h[4]; \
                _Pragma("unroll") for (int e = 0; e < 4; ++e) h[e] = (v[Q][j][e] * rinv) * A[j][e] + B[j][e]; \
                u32x2 w; w.x = pk2(h[0], h[1]); w.y = pk2(h[2], h[3]); \
                *(u32x2*)(H + (size_t)r * 1024 + c) = w; } \
        } \
        r += rstep; }
    while (true) { MP_STEP(0) MP_STEP(1) }
#undef MP_STEP
#undef MP_SRC
#undef MP_ISSUE
}

typedef __bf16 bf2_t __attribute__((ext_vector_type(2)));
__device__ __forceinline__ float dot2bf(uint32_t a, uint32_t b, float c) { return __builtin_amdgcn_fdot2_f32_bf16(__builtin_bit_cast(bf2_t, a), __builtin_bit_cast(bf2_t, b), c, false); }
__device__ __forceinline__ void phase_ffn_route(const Params& p, char* smem, int layer, int nrows, int wg, int nwg) {
    const int tid = ltid(), lane = tid & 63, wv = __builtin_amdgcn_readfirstlane(tid >> 6);
    const float* RES = WSP(float, OFF_RES); const float* mod = WSP(float, OFF_MOD); bf16_t* H = WSP(bf16_t, OFF_HREG);
    int* cnt = WSP(int, OFF_CNT) + layer * 32; int* routei = WSP(int, OFF_ROUTEI); float* routeg = WSP(float, OFF_ROUTEG); int* tokl = WSP(int, OFF_TOKL);
    {
        const u32x4* RT = (const u32x4*)(p.ws + OFF_WTS + W_RW) + (size_t)layer * 4608;
        for (int q = tid; q < 4608; q += 256) *(u32x4*)(smem + q * 16) = RT[q];
        if (tid < 32) ((float*)(smem + SM_TAB))[tid] = p.router_f_b[layer * 32 + tid];
    }
    __syncthreads();
    const float* gn = p.norm_ffn + layer * 1024;
    const bool hi32 = (lane & 32) != 0, hi16 = (lane & 16) != 0, hi8 = (lane & 8) != 0;
    const float cb0 = p.router_c_b[layer * 4 + 0], cb1 = p.router_c_b[layer * 4 + 1], cb2 = p.router_c_b[layer * 4 + 2], cb3 = p.router_c_b[layer * 4 + 3];
    int it = 0, sx1 = 0, sx2 = 0, sr = 0; float sga = 0.f, sgb = 0.f;
    auto flush = [&](int n) {
        if (lane < n) {
            const int p1 = atomicAdd(&cnt[sx1], 1), p2 = atomicAdd(&cnt[sx2], 1);
            tokl[(size_t)sx1 * TOKCAP + p1] = sr; tokl[(size_t)sx2 * TOKCAP + p2] = sr;
            routei[2 * sr] = (p1 << 5) | sx1; routei[2 * sr + 1] = (p2 << 5) | sx2; routeg[2 * sr] = sga; routeg[2 * sr + 1] = sgb;
        }
    };
    f32x4 A[4], B[4]; int mbc = -1;
    int r = wg * 4 + wv;
    const int rstep = nwg * 4;
    if (r >= nrows) return;
    const int rlast = nrows - 1;
    f32x4 vv[3][4];
#pragma unroll
    for (int j = 0; j < 4; ++j) vv[0][j] = __builtin_nontemporal_load((const f32x4*)(RES + (size_t)r * 1024 + 4 * lane + 256 * j));
#pragma unroll
    for (int j = 0; j < 4; ++j) vv[1][j] = __builtin_nontemporal_load((const f32x4*)(RES + (size_t)min(r + rstep, rlast) * 1024 + 4 * lane + 256 * j));
    while (r < nrows) {
#pragma unroll
      for (int P = 0; P < 3; ++P) {
        if (r >= nrows) break;
        const int mb = r < NL ? (r >> 13) : 4;
        if (mb != mbc) { mbc = mb;
            const float* sh = mod + (size_t)(mb * 4 + layer) * 6144 + 3 * 1024; const float* sc = sh + 1024;
#pragma unroll
            for (int j = 0; j < 4; ++j) { const int c = 4 * lane + 256 * j; const f32x4 g = *(const f32x4*)(gn + c), s1 = *(const f32x4*)(sh + c), s2 = *(const f32x4*)(sc + c);
#pragma unroll
                for (int e = 0; e < 4; ++e) { A[j][e] = g[e] * (1.f + s2[e]); B[j][e] = s1[e]; } }
        }
        const int rn = min(r + 2 * rstep, rlast);
#pragma unroll
        for (int j = 0; j < 4; ++j) vv[(P + 2) % 3][j] = __builtin_nontemporal_load((const f32x4*)(RES + (size_t)rn * 1024 + 4 * lane + 256 * j));
        f32x4 (&v)[4] = vv[P];
        __builtin_amdgcn_sched_barrier(0);
        float ss = 0.f;
#pragma unroll
        for (int j = 0; j < 4; ++j) ss += (v[j][0] * v[j][0] + v[j][1] * v[j][1]) + (v[j][2] * v[j][2] + v[j][3] * v[j][3]);
        ss = wave_sum(ss);
        const float rinv = frsq(ss * (1.f / 1024.f) + 1e-6f);
        uint32_t hp[8];
#pragma unroll
        for (int j = 0; j < 4; ++j) {
            float h[4];
#pragma unroll
            for (int e = 0; e < 4; ++e) h[e] = (v[j][e] * rinv) * A[j][e] + B[j][e];
            u32x2 w; w.x = pk2(h[0], h[1]); w.y = pk2(h[2], h[3]); hp[2 * j] = w.x; hp[2 * j + 1] = w.y;
            *(u32x2*)(H + (size_t)r * 1024 + 4 * lane + 256 * j) = w;
        }
        float c0 = 0.f, c1 = 0.f, c2 = 0.f, c3 = 0.f;
#pragma unroll
        for (int pp = 0; pp < 8; ++pp) { const u32x4 w = *(const u32x4*)(smem + 65536 + (pp * 64 + lane) * 16);
            c0 = dot2bf(hp[pp], w[0], c0); c1 = dot2bf(hp[pp], w[1], c1); c2 = dot2bf(hp[pp], w[2], c2); c3 = dot2bf(hp[pp], w[3], c3); }
        float m;
        { const float t0 = hi32 ? c0 : c2, t1 = hi32 ? c1 : c3;
          const float k0 = (hi32 ? c2 : c0) + __shfl_xor(t0, 32), k1 = (hi32 ? c3 : c1) + __shfl_xor(t1, 32);
          const float t = hi16 ? k0 : k1; m = (hi16 ? k1 : k0) + __shfl_xor(t, 16);
          m = sum16(m); }
        const float q0 = rl_(m, 0) + cb0, q1 = rl_(m, 16) + cb1, q2 = rl_(m, 32) + cb2, q3 = rl_(m, 48) + cb3;
        int gi = 0; float mx = q0;
        if (q1 > mx) { mx = q1; gi = 1; } if (q2 > mx) { mx = q2; gi = 2; } if (q3 > mx) { mx = q3; gi = 3; }
        const float gval = frcp(fexp(q0 - mx) + fexp(q1 - mx) + fexp(q2 - mx) + fexp(q3 - mx));
        float f[8];
#pragma unroll
        for (int x = 0; x < 8; ++x) f[x] = 0.f;
        const char* ft = smem + gi * 16384 + lane * 16;
#pragma unroll
        for (int pp = 0; pp < 8; ++pp)
#pragma unroll
            for (int hf = 0; hf < 2; ++hf) { const u32x4 w = *(const u32x4*)(ft + (pp * 2 + hf) * 1024);
#pragma unroll
                for (int x = 0; x < 4; ++x) f[hf * 4 + x] = dot2bf(hp[pp], w[x], f[hf * 4 + x]); }
        float n_;
        { float k[4];
#pragma unroll
          for (int x = 0; x < 4; ++x) { const float t = hi32 ? f[x] : f[x + 4]; k[x] = (hi32 ? f[x + 4] : f[x]) + __shfl_xor(t, 32); }
          float m2[2];
#pragma unroll
          for (int x = 0; x < 2; ++x) { const float t = hi16 ? k[x] : k[x + 2]; m2[x] = (hi16 ? k[x + 2] : k[x]) + __shfl_xor(t, 16); }
          const float t = hi8 ? m2[0] : m2[1]; n_ = (hi8 ? m2[1] : m2[0]) + __shfl_xor(t, 8);
          n_ = sum8(n_); }
        float lf[8]; float m1 = -3.0e38f, m2v = -3.0e38f; int e1 = 0, e2 = 0;
#pragma unroll
        for (int e = 0; e < 8; ++e) lf[e] = rl_(n_, 8 * e) + ((const float*)(smem + SM_TAB))[gi * 8 + e];
#pragma unroll
        for (int e = 0; e < 8; ++e) if (lf[e] > m1) { m1 = lf[e]; e1 = e; }
#pragma unroll
        for (int e = 0; e < 8; ++e) if (e != e1 && lf[e] > m2v) { m2v = lf[e]; e2 = e; }
        const float qq = fexp(m2v - m1), rq = frcp(1.f + qq);
        if (lane == it) { sx1 = gi * 8 + e1; sx2 = gi * 8 + e2; sga = gval * rq; sgb = gval * qq * rq; sr = r; }
        if (++it == 64) { flush(64); it = 0; }
        r += rstep;
      }
    }
    flush(it);
}

struct AShift { const bf16_t* H; const bf16_t* zero; int m0;
    __device__ __forceinline__ int info(int row) const {
        const int r = m0 + row; int bits, ctx;
        if (r < NL) { const int t = r & 8191, col = t & 63, rw = t >> 6; bits = (col > 0 ? 1 : 0) | (col < 63 ? 2 : 0) | (rw > 0 ? 4 : 0) | (rw < 127 ? 8 : 0); ctx = 0; }
        else { const int t = (r - NL) & 255; bits = (t > 0 ? 3 : 0) | (t < 255 ? 12 : 0); ctx = 1; }
        return r | (bits << 20) | (ctx << 24); }
    __device__ __forceinline__ const bf16_t* ptr(int inf, int, int k) const {
        const int gr = inf & 0xfffff;
        if (k < 1024) return H + (size_t)gr * 1024 + k;
        const int kk = k - 1024, q = kk >> 8; const bool ctx = (inf >> 24) & 1, ok = (inf >> (20 + q)) & 1;
        const int dl = ctx ? (q < 2 ? -1 : 1) : (q == 0 ? -1 : (q == 1 ? 1 : (q == 2 ? -64 : 64)));
        return ok ? H + (size_t)(gr + dl) * 1024 + kk : zero; } };

__device__ __forceinline__ void phase_e2(const Params& p, char* smem, int j, int nrows, int layer, int wg, int nwg) {
    const bf16_t* H = WSP(bf16_t, OFF_HREG); bf16_t* P = WSP(bf16_t, OFF_PREG); bf16_t* LR1 = WSP(bf16_t, OFF_LR1);
    const bf16_t* WIN = (const bf16_t*)(p.ws + OFF_WTS + W_WIN) + (size_t)j * 1024 * 2048;
    const bf16_t* WL1 = (const bf16_t*)(p.ws + OFF_WTS + W_LR1) + (size_t)j * 2048 * 384;
    const int nrt = nrows / 128, nlr = nrt * 3, ntot = nlr + nrt * 16;
    W2Conv cw{p.moe_w2 + (size_t)layer * 32 * 1024 * 512, WSP(bf16_t, OFF_W2), ntot / nwg, wg, nwg, {}};
    f32x4 acc[4][4];
    int it_ = 0;
    for (int t = wg; t < ntot; t += nwg, ++it_) {
        cw.load(it_);
        if (t >= nlr) {
            const int tp = t - nlr, mt = tp >> 4, nt = tp & 15, m0 = mt * 128, n0 = nt * 128;
            gemm_tile(smem, 16, APlain{H, 1024, m0}, BPlain{WIN + n0, 2048}, acc);
            EPI_FOR(acc, { st_bf4(P + (size_t)(m0 + row) * 2048 + n0 + col, v); });
        } else {
            const int u = t, mt = u / 3, nt = u % 3, m0 = mt * 128, n0 = nt * 128;
            gemm_tile(smem, 32, AShift{H, WSP(bf16_t, OFF_ZERO), m0}, BPlain{WL1 + n0, 384}, acc);
            EPI_FOR(acc, { f32x4 o;
                _Pragma("unroll") for (int e = 0; e < 4; ++e) { const float z = v[e]; o[e] = nt == 0 ? tanhf_(z) : (nt == 1 ? z : sigmoidf_(z)); }
                st_bf4(LR1 + (size_t)(m0 + row) * 384 + n0 + col, o); });
        }
        cw.store(it_);
    }
}

__device__ __forceinline__ void phase_e3(const Params& p, int j, int nrows, int wg, int nwg) {
    const int lane = ltid() & 63, wv = ltid() >> 6;
    const bf16_t* P = WSP(bf16_t, OFF_PREG);
    bf16_t* R = WSP(bf16_t, OFF_RKVK); bf16_t* K = R + (size_t)NT * 512; bf16_t* V = K + (size_t)NT * 512; bf16_t* KK = V + (size_t)NT * 512;
    bf16_t* DIFF = WSP(bf16_t, OFF_DIFF);
    const int c = 8 * lane, q = lane >> 4;
    for (int r = wg * 4 + wv; r < nrows; r += nwg * 4) {
        const int s = shift_src(r, q); const int sc = s >= 0 ? s : r;
        int t, T, base;
        if (r < NL) { t = r & 8191; T = 8192; base = r - t; } else { t = (r - NL) & 255; T = 256; base = r - t; }
        const int half = 1 << q; const int lo = max(t - half, 0), hi = min(t + half, T);
        u32x4 pa_[3], pb_[3];
#pragma unroll
        for (int n = 0; n < 3; ++n) { pa_[n] = *(const u32x4*)(P + (size_t)r * 2048 + n * 512 + c); pb_[n] = *(const u32x4*)(P + (size_t)sc * 2048 + n * 512 + c); }
        u32x4 wv_[16];
#pragma unroll
        for (int i = 0; i < 16; ++i) { const int tt = t + i - 8; const bool ok = tt >= lo && tt < hi; wv_[i] = *(const u32x4*)(P + (size_t)(base + (ok ? tt : t)) * 2048 + 1536 + c); }
        const u32x4 u = *(const u32x4*)(P + (size_t)r * 2048 + 1536 + c);
        __builtin_amdgcn_sched_barrier(0);
        float val[3][8];
#pragma unroll
        for (int n = 0; n < 3; ++n) {
            const u32x4 a = pa_[n]; u32x4 b = pb_[n];
            if (s < 0) b = (u32x4){0u, 0u, 0u, 0u};
            const f32x4 m0 = *(const f32x4*)(p.mu_p + (size_t)(j * 3 + n) * 512 + c), m1 = *(const f32x4*)(p.mu_p + (size_t)(j * 3 + n) * 512 + c + 4);
#pragma unroll
            for (int e = 0; e < 4; ++e) {
                const float pa0 = bflo(a[e]), pa1 = bfhi(a[e]), pb0 = bflo(b[e]), pb1 = bfhi(b[e]);
                const float mu0 = (2 * e < 4) ? m0[2 * e] : m1[2 * e - 4], mu1 = (2 * e + 1 < 4) ? m0[2 * e + 1] : m1[2 * e + 1 - 4];
                val[n][2 * e] = pa0 + (pb0 - pa0) * mu0; val[n][2 * e + 1] = pa1 + (pb1 - pa1) * mu1;
            }
        }
        const f32x4 kk0 = *(const f32x4*)(p.k_k + j * 512 + c), kk1 = *(const f32x4*)(p.k_k + j * 512 + c + 4);
        float kkv[8]; float ss = 0.f;
#pragma unroll
        for (int e = 0; e < 8; ++e) { kkv[e] = val[1][e] * (e < 4 ? kk0[e] : kk1[e - 4]); ss += kkv[e] * kkv[e]; }
        ss += __shfl_xor(ss, 1); ss += __shfl_xor(ss, 2); ss += __shfl_xor(ss, 4);
        const float rn = frsq(fmaxf(ss, 1e-12f));
        u32x4 o;
#pragma unroll
        for (int e = 0; e < 4; ++e) o[e] = pk2(val[0][2 * e], val[0][2 * e + 1]);
        *(u32x4*)(R + (size_t)r * 512 + c) = o;
#pragma unroll
        for (int e = 0; e < 4; ++e) o[e] = pk2(val[1][2 * e], val[1][2 * e + 1]);
        *(u32x4*)(K + (size_t)r * 512 + c) = o;
#pragma unroll
        for (int e = 0; e < 4; ++e) o[e] = pk2(val[2][2 * e], val[2][2 * e + 1]);
        *(u32x4*)(V + (size_t)r * 512 + c) = o;
        (void)kkv; (void)rn;
        float sum[8];
#pragma unroll
        for (int e = 0; e < 8; ++e) sum[e] = 0.f;
#pragma unroll
        for (int i = 0; i < 16; ++i) { const int tt = t + i - 8; const bool ok = tt >= lo && tt < hi;
#pragma unroll
            for (int e = 0; e < 4; ++e) { sum[2 * e] += ok ? bflo(wv_[i][e]) : 0.f; sum[2 * e + 1] += ok ? bfhi(wv_[i][e]) : 0.f; } }
        const float inv = 1.0f / (float)(hi - lo);
#pragma unroll
        for (int e = 0; e < 4; ++e) o[e] = pk2(sum[2 * e] * inv - bflo(u[e]), sum[2 * e + 1] * inv - bfhi(u[e]));
        *(u32x4*)(DIFF + (size_t)r * 512 + c) = o;
    }
}

__device__ __forceinline__ void phase_e4(const Params& p, char* smem, int j, int nrows, int part, int wg, int nwg) {
    const bf16_t* LR1 = WSP(bf16_t, OFF_LR1); const bf16_t* DIFF = WSP(bf16_t, OFF_DIFF);
    const bf16_t* K = WSP(bf16_t, OFF_RKVK) + (size_t)NT * 512; const bf16_t* KK = WSP(bf16_t, OFF_RKVK) + (size_t)3 * NT * 512;
    float* W = WSP(float, OFF_WREG); bf16_t* KD = WSP(bf16_t, OFF_KD); bf16_t* BB = WSP(bf16_t, OFF_BB); bf16_t* G = WSP(bf16_t, OFF_G); bf16_t* YAB = WSP(bf16_t, OFF_HREG);
    const bf16_t* WL2 = (const bf16_t*)(p.ws + OFF_WTS + W_LR2) + (size_t)j * 384 * 512;
    const bf16_t* WP = (const bf16_t*)(p.ws + OFF_WTS + W_POOL) + (size_t)j * 512 * 128;
    const int nrt = nrows / 128, nlr = nrt * (part == 0 ? 16 : 4), ntot = nlr + (part == 1 ? nrt * 4 : 0);
    f32x4 acc[4][4];
    for (int t = wg; t < ntot; t += nwg) {
        if (t < nlr) {
            const int mt = part == 0 ? t >> 4 : t >> 2, u = part == 0 ? (t & 15) : 16 + (t & 3), ob = u >> 2, n4 = u & 3, m0 = mt * 128, n0 = n4 * 128;
            const int koff = ob < 4 ? ob * 64 : 256, nk = ob < 4 ? 1 : 2;
            gemm_tile(smem, nk, APlain{LR1 + koff, 384, m0}, BPlain{WL2 + (size_t)koff * 512 + n0, 512}, acc);
            if (ob < 2) {
                const float* w0 = p.decay_w0 + (size_t)(j * 2 + ob) * 512 + n0;
                EPI_FOR(acc, { const f32x4 b0 = *(const f32x4*)(w0 + col); f32x4 o;
                    _Pragma("unroll") for (int e = 0; e < 4; ++e) o[e] = v[e] + b0[e];
                    st_bf4(KD + ((size_t)ob * NT + m0 + row) * 512 + n0 + col, o); });
            } else if (ob < 4) {
                const int d = ob - 2; const float* a0 = p.lr_a0 + (size_t)(j * 2 + d) * 512 + n0;
                EPI_FOR(acc, { const f32x4 b0 = *(const f32x4*)(a0 + col); f32x4 o;
                    _Pragma("unroll") for (int e = 0; e < 4; ++e) o[e] = sigmoidf_(v[e] + b0[e]);
                    st_bf4(BB + ((size_t)d * NT + m0 + row) * 512 + n0 + col, o); });
            } else {
                EPI_FOR(acc, { st_bf4(G + (size_t)(m0 + row) * 512 + n0 + col, v); });
            }
        } else {
            const int u = t - nlr, mt = u >> 2, g = u & 3, m0 = mt * 128;
            gemm_tile(smem, 2, APlain{DIFF + g * 128, 512, m0}, BPlain{WP + (size_t)g * 128 * 128, 128}, acc);
            const float* ps = p.pool_scale + (size_t)j * 512 + g * 128;
            EPI_FOR(acc, { const f32x4 s = *(const f32x4*)(ps + col); f32x4 o; o[0] = v[0] * s[0]; o[1] = v[1] * s[1]; o[2] = v[2] * s[2]; o[3] = v[3] * s[3];
                st_bf4(YAB + (size_t)(m0 + row) * 1024 + 512 + g * 128 + col, o); });
        }
    }
}

template <int VAR> __device__ __forceinline__ void phase_scan(const Params&, char*, int, int) {}
template <int CTRL> __device__ __forceinline__ float dpp_mov(float x) { return __builtin_bit_cast(float, __builtin_amdgcn_mov_dpp(__builtin_bit_cast(int, x), CTRL, 0xf, 0xf, true)); }
typedef float f32x2v __attribute__((ext_vector_type(2)));

#define CK_C 32
#define CK_NCH 264
#define CK_P 144
#define CK_PG 80
#define CK_G 0
#define CK_TOT 8192
#define CK_AT 9216
#define CK_BT (CK_AT + 4608)
#define CK_KT (CK_BT + 4608)
#define CK_RT (CK_KT + 4608)
#define CK_VC (CK_RT + 4608)
#define CK_T (CK_VC + 4608)
#define CK_MAK (CK_T + 2560)
#define CK_NRB (CK_MAK + 2560)
#define CK_NRK (CK_NRB + 2560)
#define CK_P1 (CK_NRK + 2560)
#define CK_W1 (CK_P1 + 4608)
#define CK_W2 (CK_W1 + 4608)
#define CK_TF (CK_W2 + 4608)
#define CK_END (CK_TF + 32 * 144)
static_assert(CK_END <= SM_BAR, "chunk LDS map");
constexpr size_t OFF_AD0 = MBY(869);
__device__ __forceinline__ size_t off_qy(int d) { return OFF_PREG + (size_t)d * MBY(66); }
__device__ __forceinline__ size_t off_ad(int d) { return d ? OFF_WREG : OFF_AD0; }

__device__ __forceinline__ bf16x8 frag_rows(const char* img, int pitch, int r0, int k0, int lane) {
    return *(const bf16x8*)(img + (r0 + (lane & 15)) * pitch + (k0 + 8 * (lane >> 4)) * 2);
}
__device__ __forceinline__ bf16x8 frag_cols(const char* img, int pitch, int k0, int c0, int lane) {
    const char* a = img + (k0 + 8 * (lane >> 4) + ((lane & 15) >> 2)) * pitch + (c0 + 4 * (lane & 3)) * 2;
    const s16x4 lo = __builtin_amdgcn_ds_read_tr16_b64_v4i16((LAS s16x4*)a), hi = __builtin_amdgcn_ds_read_tr16_b64_v4i16((LAS s16x4*)(a + 4 * pitch));
    return __builtin_shufflevector(lo, hi, 0, 1, 2, 3, 4, 5, 6, 7);
}
#define MFMA16(acc, afrag, bfrag) acc = __builtin_amdgcn_mfma_f32_16x16x32_bf16(bfrag, afrag, acc, 0, 0, 0)

__device__ __forceinline__ void phase_s1(const Params& p, char* smem, int jl, int d, int wg0, int nwg0) {
    const int tid = ltid(), lane = tid & 63, wv = tid >> 6;
    const bf16_t* R = WSP(bf16_t, OFF_RKVK); const bf16_t* V = R + (size_t)2 * NT * 512; const bf16_t* KK = R + (size_t)3 * NT * 512;
    const bf16_t* Kp = R + (size_t)NT * 512; const bf16_t* KD = WSP(bf16_t, OFF_KD) + (size_t)d * NT * 512; const bf16_t* BB = WSP(bf16_t, OFF_BB) + (size_t)d * NT * 512;
    bf16_t* QY = WSP(bf16_t, off_qy(d)); bf16_t* AD = WSP(bf16_t, off_ad(d));
    const int li = tid >> 3, c8 = (tid & 7) * 8;
    const int dir = d ? -1 : 1;
    const int ntask = 32 * CK_NCH;
    u32x4 lr, ld, lb, lv, lz;
    auto gl = [&](int task) {
        const int cd = task / CK_NCH, n = task - cd * CK_NCH, b = cd >> 3, h = cd & 7, s0 = n * CK_C;
        const int r0 = s0 < 256 ? NL + b * 256 + (d ? 255 - s0 : s0) : b * 8192 + (d ? 8191 - (s0 - 256) : (s0 - 256));
        const size_t ro = (size_t)(r0 + dir * li) * 512 + h * 64 + c8;
        lr = *(const GAS u32x4*)(R + ro); ld = *(const GAS u32x4*)(Kp + ro); lb = *(const GAS u32x4*)(BB + ro); lv = *(const GAS u32x4*)(V + ro);
        lz = *(const GAS u32x4*)(KD + ro);
    };
    int task = wg0;
    if (task < ntask) gl(task);
    for (; task < ntask; task += nwg0) {
        const int cd = task / CK_NCH, n = task - cd * CK_NCH;
        float* G = (float*)(smem + CK_G); float* TOT = (float*)(smem + CK_TOT); float* TF = (float*)(smem + CK_TF);
        __syncthreads();
        {
            f32x4 w0_, w1_;
#pragma unroll
            for (int e = 0; e < 2; ++e) { w0_[2 * e] = fexp(-0.60653065971f * sigmoidf_(bflo(lz[e]))); w0_[2 * e + 1] = fexp(-0.60653065971f * sigmoidf_(bfhi(lz[e])));
                                          w1_[2 * e] = fexp(-0.60653065971f * sigmoidf_(bflo(lz[2 + e]))); w1_[2 * e + 1] = fexp(-0.60653065971f * sigmoidf_(bfhi(lz[2 + e]))); }
            *(f32x4*)(G + li * 64 + c8) = w0_; *(f32x4*)(G + li * 64 + c8 + 4) = w1_;
        }
        const u32x4 xr = lr, xd = ld, xb = lb, xv = lv;
        const int hh = (task / CK_NCH) & 7;
        const f32x4 ka0 = *(const f32x4*)(p.k_a + (size_t)jl * 512 + hh * 64 + c8), ka1 = *(const f32x4*)(p.k_a + (size_t)jl * 512 + hh * 64 + c8 + 4);
        if (task + nwg0 < ntask) gl(task + nwg0);
        __builtin_amdgcn_sched_barrier(0);
        __syncthreads();
        {
            const int c = tid & 63, q = tid >> 6; float pr = 1.f;
#pragma unroll
            for (int j = 0; j < 8; ++j) { pr *= G[(8 * q + j) * 64 + c]; G[(8 * q + j) * 64 + c] = pr; }
            TOT[q * 64 + c] = pr;
            __syncthreads();
            float pre = 1.f;
            if (q > 0) pre = TOT[c]; if (q > 1) pre *= TOT[64 + c]; if (q > 2) pre *= TOT[128 + c];
#pragma unroll
            for (int j = 0; j < 8; ++j) G[(8 * q + j) * 64 + c] *= pre;
        }
        __syncthreads();
        {
            float g[8], gm[8];
            { const f32x4 a0 = *(const f32x4*)(G + li * 64 + c8), a1 = *(const f32x4*)(G + li * 64 + c8 + 4);
#pragma unroll
              for (int e = 0; e < 4; ++e) { g[e] = a0[e]; g[4 + e] = a1[e]; } }
            if (li > 0) { const f32x4 a0 = *(const f32x4*)(G + (li - 1) * 64 + c8), a1 = *(const f32x4*)(G + (li - 1) * 64 + c8 + 4);
#pragma unroll
              for (int e = 0; e < 4; ++e) { gm[e] = a0[e]; gm[4 + e] = a1[e]; } }
            else {
#pragma unroll
              for (int e = 0; e < 8; ++e) gm[e] = 1.f; }
            float kkf[8];
            { const f32x4 q0 = *(const f32x4*)(p.k_k + (size_t)jl * 512 + hh * 64 + c8), q1 = *(const f32x4*)(p.k_k + (size_t)jl * 512 + hh * 64 + c8 + 4); float ss = 0.f;
#pragma unroll
              for (int e = 0; e < 4; ++e) { kkf[2 * e] = bflo(xd[e]) * ((2 * e < 4) ? q0[2 * e] : q1[2 * e - 4]); kkf[2 * e + 1] = bfhi(xd[e]) * ((2 * e + 1 < 4) ? q0[2 * e + 1] : q1[2 * e + 1 - 4]); }
#pragma unroll
              for (int e = 0; e < 8; ++e) ss += kkf[e] * kkf[e];
              ss = sum8(ss);
              const float rn = frsq(fmaxf(ss, 1e-12f));
#pragma unroll
              for (int e = 0; e < 8; ++e) kkf[e] *= rn; }
            u32x4 oa, ob, ok, orr;
#pragma unroll
            for (int e = 0; e < 4; ++e) {
                const float i0 = frcp(g[2 * e]), i1 = frcp(g[2 * e + 1]);
                oa[e] = pk2(-kkf[2 * e] * gm[2 * e], -kkf[2 * e + 1] * gm[2 * e + 1]);
                const float al0 = bflo(xb[e]), al1 = bfhi(xb[e]);
                const float kav0 = (2 * e < 4) ? ka0[2 * e] : ka1[2 * e - 4], kav1 = (2 * e + 1 < 4) ? ka0[2 * e + 1] : ka1[2 * e + 1 - 4];
                ob[e] = pk2(kkf[2 * e] * al0 * i0, kkf[2 * e + 1] * al1 * i1);
                ok[e] = pk2(bflo(xd[e]) * (1.f + (al0 - 1.f) * kav0) * i0, bfhi(xd[e]) * (1.f + (al1 - 1.f) * kav1) * i1);
                orr[e] = pk2(bflo(xr[e]) * g[2 * e], bfhi(xr[e]) * g[2 * e + 1]);
            }
            const int o = li * CK_P + c8 * 2;
            *(u32x4*)(smem + CK_AT + o) = oa; *(u32x4*)(smem + CK_BT + o) = ob; *(u32x4*)(smem + CK_KT + o) = ok; *(u32x4*)(smem + CK_RT + o) = orr; *(u32x4*)(smem + CK_VC + o) = xv;
        }
        __syncthreads();
        {
            const int mt = wv >> 1, nt = wv & 1;
            f32x4 aab = {0.f, 0.f, 0.f, 0.f}, aak = aab, arb = aab, ark = aab;
#pragma unroll
            for (int ks = 0; ks < 2; ++ks) {
                const bf16x8 fa = frag_rows(smem + CK_AT, CK_P, mt * 16, ks * 32, lane), fr = frag_rows(smem + CK_RT, CK_P, mt * 16, ks * 32, lane);
                const bf16x8 fb = frag_rows(smem + CK_BT, CK_P, nt * 16, ks * 32, lane), fk = frag_rows(smem + CK_KT, CK_P, nt * 16, ks * 32, lane);
                MFMA16(aab, fa, fb); MFMA16(aak, fa, fk); MFMA16(arb, fr, fb); MFMA16(ark, fr, fk);
            }
            const int m = mt * 16 + (lane & 15), n0 = nt * 16 + 4 * (lane >> 4);
            f32x4 o1, o2, o3, o4;
#pragma unroll
            for (int e = 0; e < 4; ++e) { const int nn = n0 + e; o1[e] = nn < m ? aab[e] : 0.f; o2[e] = nn < m ? aak[e] : 0.f; o3[e] = nn <= m ? arb[e] : 0.f; o4[e] = nn <= m ? ark[e] : 0.f; }
            *(f32x4*)(TF + m * 36 + n0) = o1;
            st_bf4((bf16_t*)(smem + CK_MAK + m * CK_PG) + n0, o2); st_bf4((bf16_t*)(smem + CK_NRB + m * CK_PG) + n0, o3); st_bf4((bf16_t*)(smem + CK_NRK + m * CK_PG) + n0, o4);
        }
        __syncthreads();
        if (wv == 0) {
            const int c = lane & 31; float Tc[32];
#pragma unroll
            for (int t = 0; t < 32; ++t) {
                float a0 = (c == t) ? 1.f : 0.f, a1 = 0.f, a2 = 0.f, a3 = 0.f;
#pragma unroll
                for (int j4 = 0; j4 < (t + 3) / 4; ++j4) {
                    const f32x4 mrow = *(const f32x4*)(TF + t * 36 + j4 * 4);
                    if (j4 * 4 + 0 < t) a0 += mrow[0] * Tc[j4 * 4 + 0];
                    if (j4 * 4 + 1 < t) a1 += mrow[1] * Tc[j4 * 4 + 1];
                    if (j4 * 4 + 2 < t) a2 += mrow[2] * Tc[j4 * 4 + 2];
                    if (j4 * 4 + 3 < t) a3 += mrow[3] * Tc[j4 * 4 + 3];
                }
                Tc[t] = (a0 + a1) + (a2 + a3);
                if (lane < 32) ((bf16_t*)(smem + CK_T + t * CK_PG))[c] = f2bf(Tc[t]);
            }
        } else {
            for (int tl = wv - 1; tl < 8; tl += 3) {
                const int mt = tl >> 2, nt = tl & 3; f32x4 acc = {0.f, 0.f, 0.f, 0.f};
                MFMA16(acc, frag_rows(smem + CK_MAK, CK_PG, mt * 16, 0, lane), frag_cols(smem + CK_VC, CK_P, 0, nt * 16, lane));
                st_bf4((bf16_t*)(smem + CK_P1 + (mt * 16 + (lane & 15)) * CK_P) + nt * 16 + 4 * (lane >> 4), acc);
            }
        }
        __syncthreads();
#pragma unroll
        for (int u = 0; u < 4; ++u) {
            const int tl = wv * 4 + u, which = tl >> 3, mt = (tl >> 2) & 1, nt = tl & 3; f32x4 acc = {0.f, 0.f, 0.f, 0.f};
            MFMA16(acc, frag_rows(smem + CK_T, CK_PG, mt * 16, 0, lane), frag_cols(smem + (which ? CK_P1 : CK_AT), CK_P, 0, nt * 16, lane));
            st_bf4((bf16_t*)(smem + (which ? CK_W2 : CK_W1) + (mt * 16 + (lane & 15)) * CK_P) + nt * 16 + 4 * (lane >> 4), acc);
        }
        __syncthreads();
        {
            bf16_t* qrec = QY + (size_t)task * 4096; bf16_t* arec = AD + (size_t)task * 8192;
#pragma unroll
            for (int u = 0; u < 2; ++u) {
                const int tl = wv * 2 + u, mt = tl >> 2, nt = tl & 3, m = mt * 16 + (lane & 15), n0 = nt * 16 + 4 * (lane >> 4);
                const bf16x8 fnb = frag_rows(smem + CK_NRB, CK_PG, mt * 16, 0, lane), fnk = frag_rows(smem + CK_NRK, CK_PG, mt * 16, 0, lane);
                f32x4 aq = {0.f, 0.f, 0.f, 0.f}, ay = aq;
                MFMA16(aq, fnb, frag_cols(smem + CK_W1, CK_P, 0, nt * 16, lane));
                MFMA16(ay, fnb, frag_cols(smem + CK_W2, CK_P, 0, nt * 16, lane)); MFMA16(ay, fnk, frag_cols(smem + CK_VC, CK_P, 0, nt * 16, lane));
                const u32x2 rt = *(const u32x2*)(smem + CK_RT + m * CK_P + n0 * 2);
                aq[0] += bflo(rt.x); aq[1] += bfhi(rt.x); aq[2] += bflo(rt.y); aq[3] += bfhi(rt.y);
                st_bf4(qrec + ((m >> 4) * 2 + (n0 >> 5)) * 512 + (((n0 >> 3) & 3) * 16 + (m & 15)) * 8 + (n0 & 7), aq);
                st_bf4(qrec + 2048 + m * 64 + n0, ay);
            }
            const float* gC = G + 31 * 64;
#pragma unroll
            for (int u = 0; u < 4; ++u) {
                const int tl = wv * 4 + u, mt = tl >> 2, nt = tl & 3, m = mt * 16 + (lane & 15), n0 = nt * 16 + 4 * (lane >> 4);
                const bf16x8 fbt = frag_cols(smem + CK_BT, CK_P, 0, mt * 16, lane), fkt = frag_cols(smem + CK_KT, CK_P, 0, mt * 16, lane);
                f32x4 aa = {0.f, 0.f, 0.f, 0.f}, ad = aa;
                MFMA16(aa, fbt, frag_cols(smem + CK_W1, CK_P, 0, nt * 16, lane));
                MFMA16(ad, fbt, frag_cols(smem + CK_W2, CK_P, 0, nt * 16, lane)); MFMA16(ad, fkt, frag_cols(smem + CK_VC, CK_P, 0, nt * 16, lane));
                const float gm_ = gC[m];
#pragma unroll
                for (int e = 0; e < 4; ++e) { aa[e] = (aa[e] + ((n0 + e) == m ? 1.f : 0.f)) * gm_; ad[e] *= gm_; }
                st_bf4(arec + ((m >> 4) * 2 + (n0 >> 5)) * 512 + (((n0 >> 3) & 3) * 16 + (m & 15)) * 8 + (n0 & 7), aa);
                st_bf4(arec + 4096 + (((n0 >> 4) * 4 + (m >> 4)) * 64 + ((n0 & 15) >> 2) * 16 + (m & 15)) * 4, ad);
            }
        }
    }
}

__device__ __forceinline__ void phase_s2(const Params& p, char* smem, int d, int wg, int nwg) {
    const int tid = ltid(), lane = tid & 63, wv = tid >> 6;
    bf16_t* QY = WSP(bf16_t, off_qy(d)); const bf16_t* AD = WSP(bf16_t, off_ad(d));
    const int m15 = lane & 15, g4 = lane >> 4;
    if (wv != 0) return;
    for (int t = wg; t < 128; t += nwg) {
        const int x = t & 7, yy = t >> 3, cd = x * 4 + (yy >> 2), sl = yy & 3;
        char* zt = smem;
#pragma unroll
        for (int mt = 0; mt < 4; ++mt) *(u32x2*)(zt + (mt * 16 + m15) * 48 + 8 * g4) = (u32x2){0u, 0u};
        bf16x8 fa[3][4][2], fq[3][2][2]; u32x2 dz[3][4], dy[3][2];
#define S2_LOAD(S, n_) do { \
            const bf16_t* qrec = QY + (size_t)(cd * CK_NCH + (n_)) * 4096; const bf16_t* arec = AD + (size_t)(cd * CK_NCH + (n_)) * 8192; \
            _Pragma("unroll") for (int mt = 0; mt < 4; ++mt) { \
                _Pragma("unroll") for (int ks = 0; ks < 2; ++ks) fa[S][mt][ks] = __builtin_nontemporal_load((const GAS bf16x8*)(arec + (mt * 2 + ks) * 512 + lane * 8)); \
                dz[S][mt] = __builtin_nontemporal_load((const GAS u32x2*)(arec + 4096 + ((sl * 4 + mt) * 64 + lane) * 4)); } \
            _Pragma("unroll") for (int mt = 0; mt < 2; ++mt) { \
                _Pragma("unroll") for (int ks = 0; ks < 2; ++ks) fq[S][mt][ks] = __builtin_nontemporal_load((const GAS bf16x8*)(qrec + (mt * 2 + ks) * 512 + lane * 8)); \
                dy[S][mt] = __builtin_nontemporal_load((const GAS u32x2*)(qrec + 2048 + (mt * 16 + m15) * 64 + sl * 16 + 4 * g4)); } } while (0)
        S2_LOAD(0, 0); S2_LOAD(1, 1);
        for (int nb = 0; nb < CK_NCH; nb += 3) {
#pragma unroll
          for (int P = 0; P < 3; ++P) {
            const int n = nb + P;
            if (n >= CK_NCH) break;
            S2_LOAD((P + 2) % 3, min(n + 2, CK_NCH - 1));
            bf16x8 (&ca)[4][2] = fa[P]; bf16x8 (&cq)[2][2] = fq[P]; u32x2 (&cz)[4] = dz[P]; u32x2 (&cy)[2] = dy[P];
            __builtin_amdgcn_sched_barrier(0);
            const bf16x8 z0 = frag_cols(zt, 48, 0, 0, lane), z1 = frag_cols(zt, 48, 32, 0, lane);
            f32x4 az[4], ay[2];
#pragma unroll
            for (int mt = 0; mt < 4; ++mt) { az[mt] = (f32x4){bflo(cz[mt].x), bfhi(cz[mt].x), bflo(cz[mt].y), bfhi(cz[mt].y)}; MFMA16(az[mt], ca[mt][0], z0); MFMA16(az[mt], ca[mt][1], z1); }
#pragma unroll
            for (int mt = 0; mt < 4; ++mt) { u32x2 w; w.x = pk2(az[mt][0], az[mt][1]); w.y = pk2(az[mt][2], az[mt][3]); *(u32x2*)(zt + (mt * 16 + m15) * 48 + 8 * g4) = w; }
            __builtin_amdgcn_sched_barrier(0);
#pragma unroll
            for (int mt = 0; mt < 2; ++mt) { ay[mt] = (f32x4){bflo(cy[mt].x), bfhi(cy[mt].x), bflo(cy[mt].y), bfhi(cy[mt].y)}; MFMA16(ay[mt], cq[mt][0], z0); MFMA16(ay[mt], cq[mt][1], z1); }
            { bf16_t* qrec = QY + (size_t)(cd * CK_NCH + n) * 4096;
#pragma unroll
              for (int mt = 0; mt < 2; ++mt) st_bf4(qrec + 2048 + (mt * 16 + m15) * 64 + sl * 16 + 4 * g4, ay[mt]); }
          }
        }
#undef S2_LOAD
    }
}

template <int YBF>
__device__ __forceinline__ void phase_post(const Params& p, int j, int nrows, int wg, int nwg) {
    const int tid = ltid(), lane = tid & 63, wv = __builtin_amdgcn_readfirstlane(tid >> 6);
    const float* Y = WSP(float, OFF_PREG);
    const bf16_t* R = WSP(bf16_t, OFF_RKVK); const bf16_t* V = R + (size_t)2 * NT * 512;
    const bf16_t* G = WSP(bf16_t, OFF_G); bf16_t* YAB = WSP(bf16_t, OFF_HREG); const bf16_t* AL = WSP(bf16_t, OFF_BB);
    const bf16_t* QY0 = WSP(bf16_t, off_qy(0)); const bf16_t* QY1 = WSP(bf16_t, off_qy(1));
    const int c = 8 * lane;
    static_assert(YBF != 0, "the output phase reads y from the chunk records (chunked state pass)"); (void)Y;
    f32x4 ka[2], rk[2], gw[2], gb[2];
#pragma unroll
    for (int h = 0; h < 2; ++h) { ka[h] = *(const f32x4*)(p.k_a + (size_t)j * 512 + c + 4 * h); rk[h] = *(const f32x4*)(p.r_k + (size_t)j * 512 + c + 4 * h);
        gw[h] = *(const f32x4*)(p.gn_w + (size_t)j * 512 + c + 4 * h); gb[h] = *(const f32x4*)(p.gn_b + (size_t)j * 512 + c + 4 * h); }
    const int rstep = nwg * 4, rlast = nrows - 1;
    int r = wg * 4 + wv;
    if (r >= nrows) return;
    u32x4 in[2][8];
#define PO_LOAD(S, rr) do { \
        const int hh = lane >> 3, v_ = (lane & 7) * 8; int bb_, tt_, s0_, s1_; \
        if ((rr) < NL) { bb_ = (rr) >> 13; tt_ = (rr) & 8191; s0_ = 256 + tt_; s1_ = 256 + 8191 - tt_; } else { bb_ = ((rr) - NL) >> 8; tt_ = ((rr) - NL) & 255; s0_ = tt_; s1_ = 255 - tt_; } \
        const int cd = bb_ * 8 + hh; \
        in[S][0] = __builtin_nontemporal_load((const u32x4*)(QY0 + (size_t)(cd * CK_NCH + (s0_ >> 5)) * 4096 + 2048 + (s0_ & 31) * 64 + v_)); \
        in[S][1] = __builtin_nontemporal_load((const u32x4*)(QY1 + (size_t)(cd * CK_NCH + (s1_ >> 5)) * 4096 + 2048 + (s1_ & 31) * 64 + v_)); \
        in[S][2] = __builtin_nontemporal_load((const u32x4*)(R + (size_t)(rr) * 512 + c)); in[S][3] = __builtin_nontemporal_load((const u32x4*)(V + (size_t)(rr) * 512 + c)); in[S][4] = __builtin_nontemporal_load((const u32x4*)(G + (size_t)(rr) * 512 + c)); \
        in[S][5] = __builtin_nontemporal_load((const u32x4*)(R + ((size_t)NT + (rr)) * 512 + c)); in[S][6] = __builtin_nontemporal_load((const u32x4*)(AL + (size_t)(rr) * 512 + c)); in[S][7] = __builtin_nontemporal_load((const u32x4*)(AL + ((size_t)NT + (rr)) * 512 + c)); } while (0)
    PO_LOAD(0, r);
    while (r < nrows) {
#pragma unroll
      for (int P = 0; P < 2; ++P) {
        if (r >= nrows) break;
        { const int rn = min(r + rstep, rlast); PO_LOAD(1 - P, rn); }
        __builtin_amdgcn_sched_barrier(0);
        const u32x4 a = in[P][0], bq = in[P][1], rr = in[P][2], vv = in[P][3], gg = in[P][4], kx = in[P][5], al0 = in[P][6], al1 = in[P][7];
        float y[8];
#pragma unroll
        for (int e = 0; e < 4; ++e) { y[2 * e] = bflo(a[e]) + bflo(bq[e]); y[2 * e + 1] = bfhi(a[e]) + bfhi(bq[e]); }
        float s = 0.f;
#pragma unroll
        for (int e = 0; e < 8; ++e) s += y[e];
        s = sum8(s);
        const float mu = s * (1.f / 64.f);
        float q = 0.f;
#pragma unroll
        for (int e = 0; e < 8; ++e) { const float dlt = y[e] - mu; q += dlt * dlt; }
        q = sum8(q);
        const float rstd = frsq(q * (1.f / 64.f) + 64e-5f);
        float dot = 0.f;
#pragma unroll
        for (int e = 0; e < 4; ++e) {
            const float kav0 = ka[(2 * e) >> 2][(2 * e) & 3], kav1 = ka[(2 * e + 1) >> 2][(2 * e + 1) & 3];
            dot += bflo(rr[e]) * (bflo(kx[e]) * (2.f + (bflo(al0[e]) + bflo(al1[e]) - 2.f) * kav0)) * rk[(2 * e) >> 2][(2 * e) & 3];
            dot += bfhi(rr[e]) * (bfhi(kx[e]) * (2.f + (bfhi(al0[e]) + bfhi(al1[e]) - 2.f) * kav1)) * rk[(2 * e + 1) >> 2][(2 * e + 1) & 3];
        }
        dot = sum8(dot);
        float o[8];
#pragma unroll
        for (int e = 0; e < 8; ++e) {
            const float vf = (e & 1) ? bfhi(vv[e >> 1]) : bflo(vv[e >> 1]), gf = (e & 1) ? bfhi(gg[e >> 1]) : bflo(gg[e >> 1]);
            o[e] = ((y[e] - mu) * rstd * gw[e >> 2][e & 3] + gb[e >> 2][e & 3] + dot * vf) * gf;
        }
        u32x4 w;
#pragma unroll
        for (int e = 0; e < 4; ++e) w[e] = pk2(o[2 * e], o[2 * e + 1]);
        *(u32x4*)(YAB + (size_t)r * 1024 + c) = w;
        r += rstep;
      }
    }
#undef PO_LOAD
}

template <int DRY = 0, bool CW = false>
__device__ __forceinline__ void phase_resgemm(const Params& p, char* smem, const bf16_t* A, const bf16_t* B, int layer, int nrows, int wg, int nwg) {
    float* RES = DRY ? WSP(float, OFF_DIFF) : WSP(float, OFF_RES); const float* mod = WSP(float, OFF_MOD);
    const int ntot = (nrows / 128) * 8;
    W2Conv cw{p.moe_w2 + (size_t)layer * 32 * 1024 * 512, WSP(bf16_t, OFF_W2), CW ? ntot / nwg : 0, wg, nwg, {}};
    f32x4 acc[4][4];
    int it_ = 0;
    for (int t = wg; t < ntot; t += nwg, ++it_) {
        const int mt = t >> 3, nt = t & 7, m0 = mt * 128, n0 = nt * 128;
        if (CW) cw.load(it_);
        gemm_tile(smem, 16, APlain{A, 1024, m0}, BPlain{B + n0, 1024}, acc);
        const int mb = m0 < NL ? (m0 >> 13) : 4;
        const float* g2 = mod + (size_t)(mb * 4 + layer) * 6144 + 2 * 1024 + n0;
        const float* rsrc = layer == 0 ? (m0 < NL ? p.x : p.ctx - (size_t)NL * 1024) : RES;
        EPI_FOR(acc, { float* rp = RES + (DRY ? (size_t)((m0 + row) & 4095) : (size_t)(m0 + row)) * 1024 + n0 + col; const f32x4 g = *(const f32x4*)(g2 + col); f32x4 o = *(const f32x4*)(rsrc + (size_t)(m0 + row) * 1024 + n0 + col);
            o[0] += g[0] * v[0]; o[1] += g[1] * v[1]; o[2] += g[2] * v[2]; o[3] += g[3] * v[3]; *(f32x4*)rp = o; });
        if (CW) cw.store(it_);
    }
}

__device__ __forceinline__ void phase_f1(const Params& p, char* smem, int nrows, int wg, int nwg) {
    const bf16_t* H = WSP(bf16_t, OFF_HREG); bf16_t* Z = WSP(bf16_t, OFF_PREG); const bf16_t* DFTC = (const bf16_t*)(p.ws + OFF_WTS + W_DFTC);
    const int ntot = (nrows / 128) * 16;
    f32x4 acc[4][4];
    for (int t = wg; t < ntot; t += nwg) {
        const int mt = t >> 4, nt = t & 15, g = nt >> 2, cb = nt & 3, m0 = mt * 128;
        gemm_tile(smem, 4, APlain{H + g * 256, 1024, m0}, BPlain{DFTC + cb * 128, 512}, acc);
        EPI_FOR(acc, { st_bf4(Z + (size_t)(m0 + row) * 2048 + g * 512 + cb * 128 + col, v); });
    }
}
struct BZ { const bf16_t* Z; int rowbase, rstride, psh, off;
    __device__ __forceinline__ const bf16_t* ptr(int k, int n) const { const int part = k >> psh, idx = k & ((1 << psh) - 1); return Z + (size_t)(rowbase + idx * rstride) * 2048 + part * 256 + off + n; } };
__device__ __forceinline__ void phase_f2(const Params& p, char* smem, bool with_ctx, int wg, int nwg) {
    const bf16_t* Z = WSP(bf16_t, OFF_PREG); bf16_t* A1 = WSP(bf16_t, OFF_WREG); bf16_t* FO = WSP(bf16_t, OFF_RKVK);
    const bf16_t* TW = (const bf16_t*)(p.ws + OFF_WTS + W_TW); const bf16_t* CS256 = (const bf16_t*)(p.ws + OFF_WTS + W_CS256);
    const int nctx = with_ctx ? 64 : 0, ntot = 512 * 8 + nctx;
    f32x4 acc[4][4];
    for (int t = wg; t < ntot; t += nwg) {
        if (t >= nctx) {
            const int tl_ = t - nctx, bt = tl_ >> 3, nt = tl_ & 7, b = bt >> 7, t2 = bt & 127; const int ch0 = nt * 128, g = ch0 >> 8, cc = ch0 & 255;
            gemm_tile(smem, 2, APlain{TW + (size_t)t2 * 128 * 128, 128, 0}, BZ{Z, b * 8192 + t2, 128, 6, g * 512 + cc}, acc);
            EPI_FOR(acc, { const int pp = row >> 6, f1 = row & 63; st_bf4(A1 + ((((size_t)(b * 64 + f1) * 128 + t2) * 2 + pp) * 1024) + ch0 + col, v); });
        } else {
            const int u = t, b = u >> 4, mt = (u >> 3) & 1, nt = u & 7; const int ch0 = nt * 128, g = ch0 >> 8, cc = ch0 & 255;
            gemm_tile(smem, 8, APlain{CS256, 512, mt * 128}, BZ{Z, NL + b * 256, 1, 8, g * 512 + cc}, acc);
            EPI_FOR(acc, { f32x4 o; o[0] = v[0] * (1.f / 256.f); o[1] = v[1] * (1.f / 256.f); o[2] = v[2] * (1.f / 256.f); o[3] = v[3] * (1.f / 256.f);
                st_bf4(FO + (size_t)(NL + b * 256 + mt * 128 + row) * 1024 + ch0 + col, o); });
        }
    }
}
struct BA1 { const bf16_t* base; int off;
    __device__ __forceinline__ const bf16_t* ptr(int k, int n) const { const int part = k >> 7, t2 = k & 127; return base + (size_t)(t2 * 2 + part) * 1024 + off + n; } };
__device__ __forceinline__ void phase_f3(const Params& p, char* smem, int wg, int nwg) {
    const bf16_t* A1 = WSP(bf16_t, OFF_WREG); bf16_t* FO = WSP(bf16_t, OFF_RKVK); const bf16_t* CS128 = (const bf16_t*)(p.ws + OFF_WTS + W_CS128);
    f32x4 acc[4][4];
    const float scl = 0.000690533966f;
    for (int t = wg; t < 256 * 8; t += nwg) {
        const int bf_ = t >> 3, nt = t & 7, b = bf_ >> 6, f1 = bf_ & 63;
        gemm_tile(smem, 4, APlain{CS128, 256, 0}, BA1{A1 + (size_t)(b * 64 + f1) * 128 * 2 * 1024, nt * 128}, acc);
        EPI_FOR(acc, { f32x4 o; o[0] = v[0] * scl; o[1] = v[1] * scl; o[2] = v[2] * scl; o[3] = v[3] * scl;
            st_bf4(FO + (size_t)(b * 8192 + f1 + 64 * row) * 1024 + nt * 128 + col, o); });
    }
}

__device__ __forceinline__ void phase_f3_ring(const Params& p, char* smem, int wg, int nwg) {
    const int tid = ltid(), lane = tid & 63, wid = tid >> 6;
    const bf16_t* A1 = WSP(bf16_t, OFF_WREG); bf16_t* FO = WSP(bf16_t, OFF_RKVK); const bf16_t* CS128 = (const bf16_t*)(p.ws + OFF_WTS + W_CS128);
    const float scl = 0.000690533966f;
    const int ntot = 256 * 8;
    if (wg >= ntot) return;
    const int nmy = (ntot - wg + nwg - 1) / nwg, nsteps = nmy * 4;
    bf16x8 a[8][2];
#pragma unroll
    for (int ks = 0; ks < 8; ++ks)
#pragma unroll
        for (int mt = 0; mt < 2; ++mt) a[ks][mt] = *(const GAS bf16x8*)(CS128 + (size_t)(wid * 32 + mt * 16 + (lane & 15)) * 256 + ks * 32 + (lane >> 4) * 8);
    const int brow = tid >> 4, bnc = (((tid & 15) ^ bswz(brow)) << 3);
    const unsigned lds0 = (unsigned)__builtin_amdgcn_readfirstlane((int)((unsigned)(size_t)smem + (unsigned)(wid * 1024)));
    auto issueB = [&](int g) {
        g = min(g, nsteps - 1);
        const int t = wg + (g >> 2) * nwg, kt = g & 3, bf_ = t >> 3, nt = t & 7, b = bf_ >> 6, f1 = bf_ & 63;
        const bf16_t* base = A1 + (size_t)(b * 64 + f1) * 128 * 2 * 1024 + nt * 128;
#pragma unroll
        for (int q = 0; q < 4; ++q) { const int k = kt * 64 + brow + 16 * q, part = k >> 7, t2 = k & 127;
            glds16_asm(base + (size_t)(t2 * 2 + part) * 1024 + bnc, lds0 + kt * G_BBYTES + q * 4096); }
    };
    const int bg = lane >> 4, bq = (lane & 15) >> 2, bp = lane & 3;
    __syncthreads();
    issueB(0); issueB(1); issueB(2);
    f32x4 acc[2][8];
    for (int i = 0; i < nmy; ++i) {
#pragma unroll
        for (int m_ = 0; m_ < 2; ++m_)
#pragma unroll
            for (int n_ = 0; n_ < 8; ++n_) acc[m_][n_] = (f32x4){0.f, 0.f, 0.f, 0.f};
#pragma unroll
        for (int kt = 0; kt < 4; ++kt) {
            if (kt < 3 && i > 0) asm volatile("s_waitcnt vmcnt(24)" ::: "memory"); else asm volatile("s_waitcnt vmcnt(8)" ::: "memory");
            __syncthreads();
            issueB(i * 4 + kt + 3);
            const char* sb = smem + kt * G_BBYTES;
#pragma unroll
            for (int ks = 0; ks < 2; ++ks) {
#pragma unroll
                for (int nh = 0; nh < 4; ++nh) {
                    bf16x8 b[2];
#pragma unroll
                    for (int n2 = 0; n2 < 2; ++n2) {
                        const int nt = nh * 2 + n2;
                        const int c2 = 2 * nt + (bp >> 1);
                        const int k0 = 32 * ks + 8 * bg + bq, k1 = k0 + 4;
                        const s16x4 lo = __builtin_amdgcn_ds_read_tr16_b64_v4i16((LAS s16x4*)(sb + k0 * 256 + ((c2 ^ bswz(k0)) << 4) + 8 * (bp & 1)));
                        const s16x4 hi = __builtin_amdgcn_ds_read_tr16_b64_v4i16((LAS s16x4*)(sb + k1 * 256 + ((c2 ^ bswz(k1)) << 4) + 8 * (bp & 1)));
                        b[n2] = __builtin_shufflevector(lo, hi, 0, 1, 2, 3, 4, 5, 6, 7);
                    }
#pragma unroll
                    for (int mt = 0; mt < 2; ++mt)
#pragma unroll
                        for (int n2 = 0; n2 < 2; ++n2) acc[mt][nh * 2 + n2] = __builtin_amdgcn_mfma_f32_16x16x32_bf16(b[n2], a[kt * 2 + ks][mt], acc[mt][nh * 2 + n2], 0, 0, 0);
                }
            }
        }
        const int t = wg + i * nwg, bf_ = t >> 3, nt = t & 7, b = bf_ >> 6, f1 = bf_ & 63;
#pragma unroll
        for (int mt = 0; mt < 2; ++mt)
#pragma unroll
            for (int n8 = 0; n8 < 8; ++n8) {
                const int row = wid * 32 + mt * 16 + (lane & 15), col = n8 * 16 + 4 * (lane >> 4); const f32x4 v = acc[mt][n8];
                f32x4 o; o[0] = v[0] * scl; o[1] = v[1] * scl; o[2] = v[2] * scl; o[3] = v[3] * scl;
                st_bf4(FO + (size_t)(b * 8192 + f1 + 64 * row) * 1024 + nt * 128 + col, o);
            }
    }
    asm volatile("s_waitcnt vmcnt(0)" ::: "memory");
    __syncthreads();
}

__device__ __forceinline__ void moe_convert(const Params& p, int layer, int wg, int nwg) {
    const size_t gt = (size_t)wg * 256 + ltid(), gs = (size_t)nwg * 256; const size_t n4 = (size_t)32 * 1024 * 512 / 4;
    bf16_t* MW = WSP(bf16_t, (layer & 1) ? OFF_WREG : OFF_AD0);
    const float* s1 = p.moe_w1 + (size_t)layer * 32 * 1024 * 512; const float* s3 = p.moe_w3 + (size_t)layer * 32 * 1024 * 512; const float* s2 = p.moe_w2 + (size_t)layer * 32 * 1024 * 512;
    (void)s2;
    for (size_t i = gt; i < n4; i += gs) {
        st_bf4(MW + 4 * i, __builtin_nontemporal_load((const f32x4*)(s1 + 4 * i))); st_bf4(MW + 4 * n4 + 4 * i, __builtin_nontemporal_load((const f32x4*)(s3 + 4 * i)));
    }
}
struct ASplit { const bf16_t* H; const bf16_t* HLO; int m0;
    __device__ __forceinline__ int info(int row) const { return m0 + row; }
    __device__ __forceinline__ const bf16_t* ptr(int gr, int, int k) const { return k < 2048 ? H + (size_t)gr * 1024 + (k & 1023) : HLO + (size_t)gr * 1024 + (k - 2048); } };
template <int DRY>
__device__ __forceinline__ void phase_router(const Params& p, char* smem, int layer, int nrows, int wg, int nwg) {
    const bf16_t* H = WSP(bf16_t, OFF_HREG); const bf16_t* HLO = WSP(bf16_t, OFF_KD);
    const bf16_t* RW = (const bf16_t*)(p.ws + OFF_WTS + W_RW) + (size_t)layer * 3072 * 128;
    int* cnt = WSP(int, OFF_CNT) + layer * 32; int* routei = WSP(int, OFF_ROUTEI); float* routeg = WSP(float, OFF_ROUTEG); int* tokl = WSP(int, OFF_TOKL);
    float* LG = (float*)smem;
    f32x4 acc[4][4];
    const int ntot = nrows / 128;
    for (int t = wg; t < ntot; t += nwg) {
        const int m0 = t * 128;
        gemm_tile(smem, ROUTER_NK, ASplit{H, HLO, m0}, BPlain{RW, 128}, acc);
        __syncthreads();
        EPI_FOR(acc, { if (col < 48) { LG[row * 49 + col] = v[0]; LG[row * 49 + col + 1] = v[1]; LG[row * 49 + col + 2] = v[2]; LG[row * 49 + col + 3] = v[3]; } });
        __syncthreads();
        if (ltid() < 128) {
            const int row = ltid(), r = m0 + row; const float* lg = LG + row * 49;
            float c0 = lg[0] + p.router_c_b[layer * 4 + 0], c1 = lg[1] + p.router_c_b[layer * 4 + 1], c2 = lg[2] + p.router_c_b[layer * 4 + 2], c3 = lg[3] + p.router_c_b[layer * 4 + 3];
            int gi = 0; float mx = c0;
            if (c1 > mx) { mx = c1; gi = 1; } if (c2 > mx) { mx = c2; gi = 2; } if (c3 > mx) { mx = c3; gi = 3; }
            const float gval = 1.f / (expf(c0 - mx) + expf(c1 - mx) + expf(c2 - mx) + expf(c3 - mx));
            float lf[8]; float m1 = -3.0e38f, m2 = -3.0e38f; int e1 = 0, e2 = 0;
#pragma unroll
            for (int e = 0; e < 8; ++e) lf[e] = lg[4 + gi * 8 + e] + p.router_f_b[layer * 32 + gi * 8 + e];
#pragma unroll
            for (int e = 0; e < 8; ++e) if (lf[e] > m1) { m1 = lf[e]; e1 = e; }
#pragma unroll
            for (int e = 0; e < 8; ++e) if (e != e1 && lf[e] > m2) { m2 = lf[e]; e2 = e; }
            const float q2 = expf(m2 - m1); const float ga = gval / (1.f + q2), gb = gval * q2 / (1.f + q2);
            const int x1 = gi * 8 + e1, x2 = gi * 8 + e2;
            if (DRY) { asm volatile("" :: "v"(ga), "v"(gb), "v"(x1), "v"(x2)); } else {
            const int p1 = atomicAdd(&cnt[x1], 1), p2 = atomicAdd(&cnt[x2], 1);
            tokl[(size_t)x1 * TOKCAP + p1] = r; tokl[(size_t)x2 * TOKCAP + p2] = r;
            routei[2 * r] = (p1 << 5) | x1; routei[2 * r + 1] = (p2 << 5) | x2; routeg[2 * r] = ga; routeg[2 * r + 1] = gb; }
        }
    }
    if (!(CHUNKED && (layer & 1) == 0)) moe_convert(p, layer, wg, nwg);
}
__device__ __forceinline__ void moe_table(const Params& p, int layer, int* rbs, int* cn, int wg) {
    const int* cnt = WSP(int, OFF_CNT) + layer * 32;
    __syncthreads();
    if (ltid() == 0) { int a = 0; for (int e = 0; e < 32; ++e) { const int c = cnt[e]; cn[e] = c; rbs[e] = a; a += (c + 127) >> 7; } rbs[32] = a;
        if (wg == 0) { int* poff = WSP(int, OFF_POFF) + layer * 64; for (int e = 0; e < 32; ++e) poff[e] = rbs[e] * 128; } }
    __syncthreads();
}
struct AGather { const bf16_t* H; const bf16_t* zero; const int* list; int nvalid;
    __device__ __forceinline__ int info(int row) const { return row < nvalid ? list[row] : -1; }
    __device__ __forceinline__ const bf16_t* ptr(int tok, int, int k) const { return tok >= 0 ? H + (size_t)tok * 1024 + k : zero; } };
struct BW13 { const bf16_t* w1; size_t d3;
    __device__ __forceinline__ const bf16_t* ptr(int k, int n) const { return w1 + (size_t)((n >> 5) & 1) * d3 + (size_t)k * 512 + (n >> 6) * 32 + (n & 31); } };

__device__ __forceinline__ void phase_moe1(const Params& p, char* smem, int layer, int wg, int nwg) {
    int* rbs = (int*)(smem + SM_TAB); int* cn = rbs + 40;
    moe_table(p, layer, rbs, cn, wg);
    const bf16_t* H2 = WSP(bf16_t, OFF_HREG); const bf16_t* MW = WSP(bf16_t, (layer & 1) ? OFF_WREG : OFF_AD0); bf16_t* HB = WSP(bf16_t, OFF_BB); const int* tokl = WSP(int, OFF_TOKL);
    const size_t WSZ = (size_t)32 * 1024 * 512;
    const int ntot = rbs[32] * 8;
    f32x4 acc[4][4];
    for (int t = wg; t < ntot; t += nwg) {
        const int rbg = t >> 3, cb = t & 7;
        int e = 0; while (rbs[e + 1] <= rbg) ++e;
        const int rb = rbg - rbs[e]; const int nvalid = cn[e] - rb * 128;
        gemm_tile(smem, 16, AGather{H2, WSP(bf16_t, OFF_ZERO), tokl + (size_t)e * TOKCAP + rb * 128, nvalid},
                  BW13{MW + (size_t)e * 1024 * 512 + cb * 64, WSZ}, acc);
        {
            const int l = ltid() & 63, w = ltid() >> 6, wm = w >> 1, wn = w & 1;
#pragma unroll
            for (int mt = 0; mt < 4; ++mt)
#pragma unroll
                for (int nt = 0; nt < 2; ++nt) {
                    const int row = wm * 64 + mt * 16 + (l & 15), hcol = cb * 64 + wn * 32 + nt * 16 + 4 * (l >> 4);
                    const f32x4 a1 = acc[mt][nt], a3 = acc[mt][nt + 2]; f32x4 o;
#pragma unroll
                    for (int q = 0; q < 4; ++q) o[q] = a1[q] * sigmoidf_(a1[q]) * a3[q];
                    st_bf4(HB + ((size_t)rbg * 128 + row) * 512 + hcol, o);
                }
        }
    }
}
__device__ __forceinline__ void phase_moe2(const Params& p, char* smem, int layer, int wg, int nwg) {
    int* rbs = (int*)(smem + SM_TAB); int* cn = rbs + 40;
    moe_table(p, layer, rbs, cn, wg);
    const bf16_t* MW2 = WSP(bf16_t, OFF_W2); const bf16_t* HB = WSP(bf16_t, OFF_BB); bf16_t* YM = WSP(bf16_t, OFF_PREG);
    const int ntot = rbs[32] * 8;
    f32x4 acc[4][4];
    for (int t = wg; t < ntot; t += nwg) {
        const int rbg = t >> 3, nt8 = t & 7;
        int e = 0; while (rbs[e + 1] <= rbg) ++e;
        gemm_tile(smem, 8, APlain{HB, 512, rbg * 128}, BPlain{MW2 + (size_t)e * 512 * 1024 + nt8 * 128, 1024}, acc);
        EPI_FOR(acc, { st_bf4(YM + ((size_t)rbg * 128 + row) * 1024 + nt8 * 128 + col, v); });
    }
}

__device__ __forceinline__ void phase_e4z(const Params& p, char* smem, int j, int nrows, int wg, int nwg) {
    const int tid = ltid(), lane = tid & 63, wid = tid >> 6, wm = wid >> 1, wn = wid & 1;
    const bf16_t* LR1 = WSP(bf16_t, OFF_LR1); bf16_t* KD = WSP(bf16_t, OFF_KD); bf16_t* BB = WSP(bf16_t, OFF_BB);
    const bf16_t* WL2 = (const bf16_t*)(p.ws + OFF_WTS + W_LR2) + (size_t)j * 384 * 512;
    const int ntot = (nrows / 128) * 16;
    if (wg >= ntot) return;
    const int u = wg & 15, ob = u >> 2, n0 = (u & 3) * 128, koff = ob * 64;
    const int nmy = (ntot - wg + nwg - 1) / nwg;
    const int arow = tid >> 3, akc = (((tid & 7) ^ (arow & 7)) << 3), brow = tid >> 4, bnc = (((tid & 15) ^ bswz(brow)) << 3);
    const unsigned lds0 = (unsigned)__builtin_amdgcn_readfirstlane((int)((unsigned)(size_t)smem + (unsigned)(wid * 1024)));
    constexpr int EZ_B = 3 * G_ABYTES, EZ_BIAS = 65536;
    __syncthreads();
    {
        const bf16_t* bsrc = WL2 + (size_t)koff * 512 + n0;
#pragma unroll
        for (int i = 0; i < 4; ++i) glds16_asm(bsrc + (size_t)(brow + 16 * i) * 512 + bnc, lds0 + EZ_B + i * 4096);
        if (tid < 128) ((float*)(smem + EZ_BIAS))[tid] = (ob < 2 ? p.decay_w0 + (size_t)(j * 2 + ob) * 512 : p.lr_a0 + (size_t)(j * 2 + ob - 2) * 512)[n0 + tid];
    }
    auto issueA = [&](int i, int buf) {
        const int m0 = ((wg + i * nwg) >> 4) * 128;
#pragma unroll
        for (int q = 0; q < 4; ++q) glds16_asm(LR1 + (size_t)(m0 + arow + 32 * q) * 384 + koff + akc, lds0 + buf * G_ABYTES + q * 4096);
    };
    issueA(0, 0); issueA(min(1, nmy - 1), 1);
    const int ar = wm * 64 + (lane & 15), ax = lane & 7, ag = lane >> 4;
    const int bg = lane >> 4, bq = (lane & 15) >> 2, bp = lane & 3;
    bf16_t* outp = ob < 2 ? KD + (size_t)ob * NT * 512 : BB + (size_t)(ob - 2) * NT * 512;
    int buf = 0;
    for (int i = 0; i < nmy; ++i) {
        if (i == 0) asm volatile("s_waitcnt vmcnt(4)" ::: "memory"); else asm volatile("s_waitcnt vmcnt(20)" ::: "memory");
        __syncthreads();
        { int b2 = buf + 2; if (b2 >= 3) b2 -= 3; issueA(min(i + 2, nmy - 1), b2); }
        const char* sa = smem + buf * G_ABYTES; const char* sb = smem + EZ_B;
        f32x4 acc[4][4];
#pragma unroll
        for (int a_ = 0; a_ < 4; ++a_)
#pragma unroll
            for (int b_ = 0; b_ < 4; ++b_) acc[a_][b_] = (f32x4){0.f, 0.f, 0.f, 0.f};
#pragma unroll
        for (int ks = 0; ks < 2; ++ks) {
            bf16x8 a[4], b[4];
#pragma unroll
            for (int mt = 0; mt < 4; ++mt) a[mt] = *(const bf16x8*)(sa + (ar + mt * 16) * 128 + (((4 * ks + ag) ^ ax) << 4));
#pragma unroll
            for (int nt = 0; nt < 4; ++nt) {
                const int c2 = 2 * (wn * 4 + nt) + (bp >> 1);
                const int k0 = 32 * ks + 8 * bg + bq, k1 = k0 + 4;
                const s16x4 lo = __builtin_amdgcn_ds_read_tr16_b64_v4i16((LAS s16x4*)(sb + k0 * 256 + ((c2 ^ bswz(k0)) << 4) + 8 * (bp & 1)));
                const s16x4 hi = __builtin_amdgcn_ds_read_tr16_b64_v4i16((LAS s16x4*)(sb + k1 * 256 + ((c2 ^ bswz(k1)) << 4) + 8 * (bp & 1)));
                b[nt] = __builtin_shufflevector(lo, hi, 0, 1, 2, 3, 4, 5, 6, 7);
            }
#pragma unroll
            for (int mt = 0; mt < 4; ++mt)
#pragma unroll
                for (int nt = 0; nt < 4; ++nt) acc[mt][nt] = __builtin_amdgcn_mfma_f32_16x16x32_bf16(b[nt], a[mt], acc[mt][nt], 0, 0, 0);
        }
        const int m0 = ((wg + i * nwg) >> 4) * 128;
        if (ob < 2) {
            EPI_FOR(acc, { const f32x4 b0 = *(const f32x4*)(smem + EZ_BIAS + col * 4); f32x4 o;
                _Pragma("unroll") for (int e = 0; e < 4; ++e) o[e] = v[e] + b0[e];
                st_bf4(outp + (size_t)(m0 + row) * 512 + n0 + col, o); });
        } else {
            EPI_FOR(acc, { const f32x4 b0 = *(const f32x4*)(smem + EZ_BIAS + col * 4); f32x4 o;
                _Pragma("unroll") for (int e = 0; e < 4; ++e) o[e] = sigmoidf_(v[e] + b0[e]);
                st_bf4(outp + (size_t)(m0 + row) * 512 + n0 + col, o); });
        }
        if (++buf == 3) buf = 0;
    }
    asm volatile("s_waitcnt vmcnt(0)" ::: "memory");
    __syncthreads();
}

template <int PH>
__device__ __forceinline__ void do_phase(const Params& pin, char* smem, int layer, int wg, int nwg) {
    Params p = pin; { size_t zoff = 0; asm volatile("" : "+s"(zoff)); p.ws = pin.ws + zoff; } asm volatile("" : "+s"(layer));
    const int j = layer >> 1;
    const bool ctx_in = layer <= 2, ctx_out = layer < 2;
    const int rows_in = ctx_in ? NT : NL, rows_out = ctx_out ? NT : NL;
    const char* wts = p.ws + OFF_WTS;
    if constexpr (PH == PH_PROLOGUE) phase_prologue(p, smem, wg, nwg);
    else if constexpr (PH == PH_MOD_MIX) { if (layer == 0) phase_modpipe<0, false>(p, layer, rows_in, wg, nwg); else phase_modpipe<0, true>(p, layer, rows_in, wg, nwg); }
    else if constexpr (PH == PH_E2) phase_e2(p, smem, j, rows_in, layer, wg, nwg);
    else if constexpr (PH == PH_E3) { phase_e3(p, j, rows_in, wg, nwg); if ((nwg & 15) == 0) phase_e4z(p, smem, j, rows_in, wg, nwg); else phase_e4(p, smem, j, rows_in, 0, wg, nwg); }
    else if constexpr (PH == PH_E4) phase_e4(p, smem, j, rows_in, 0, wg, nwg);
    else if constexpr (PH == PH_SCAN) phase_scan<0>(p, smem, wg, nwg);
    else if constexpr (PH == PH_SCANV) phase_scan<SCANVAR>(p, smem, wg, nwg);
    else if constexpr (PH == PH_POST) phase_post<CHUNKED>(p, j, rows_out, wg, nwg);
    else if constexpr (PH == PH_S1A) phase_s1(p, smem, j, 0, wg, nwg);
    else if constexpr (PH == PH_S2A) { if (nwg <= 128) { phase_s2(p, smem, 0, wg, nwg); phase_s1(p, smem, j, 1, wg, nwg); } else if (wg < 128) phase_s2(p, smem, 0, wg, nwg); else phase_s1(p, smem, j, 1, wg - 128, nwg - 128); }
    else if constexpr (PH == PH_S2B) { if (nwg <= 128) { phase_s2(p, smem, 1, wg, nwg); phase_e4(p, smem, j, rows_in, 1, wg, nwg); moe_convert(p, layer, wg, nwg); } else if (wg < 128) phase_s2(p, smem, 1, wg, nwg); else { phase_e4(p, smem, j, rows_in, 1, wg - 128, nwg - 128); moe_convert(p, layer, wg - 128, nwg - 128); } }
    else if constexpr (PH == PH_WOUT) phase_resgemm(p, smem, WSP(bf16_t, OFF_HREG), (const bf16_t*)(wts + W_WOUT) + (size_t)j * 1024 * 1024, layer, rows_out, wg, nwg);
    else if constexpr (PH == PH_F1) phase_f1(p, smem, rows_out, wg, nwg);
    else if constexpr (PH == PH_F2) phase_f2(p, smem, ctx_out, wg, nwg);
    else if constexpr (PH == PH_F3) phase_f3_ring(p, smem, wg, nwg);
    else if constexpr (PH == PH_WF) phase_resgemm<0, true>(p, smem, WSP(bf16_t, OFF_RKVK), (const bf16_t*)(wts + W_WF) + (size_t)j * 1024 * 1024, layer, rows_out, wg, nwg);
    else if constexpr (PH == PH_FFNR) { phase_ffn_route(p, smem, layer, rows_out, wg, nwg); if (layer & 1) moe_convert(p, layer, wg, nwg); }
    else if constexpr (PH == PH_MOD_FFN) phase_modulate<1>(p, layer, rows_out, false, false, wg, nwg);
    else if constexpr (PH == PH_ROUTER) phase_router<0>(p, smem, layer, rows_out, wg, nwg);
    else if constexpr (PH == PH_ROUTERV) phase_router<1>(p, smem, layer, rows_out, wg, nwg);
    else if constexpr (PH == PH_WOUTV) phase_resgemm<1>(p, smem, WSP(bf16_t, OFF_HREG), (const bf16_t*)(wts + W_WOUT) + (size_t)j * 1024 * 1024, layer, rows_out, wg, nwg);
    else if constexpr (PH == PH_MOE1) phase_moe1(p, smem, layer, wg, nwg);
    else if constexpr (PH == PH_MOE2) phase_moe2(p, smem, layer, wg, nwg);
    else if constexpr (PH == PH_FINAL) phase_modpipe<2, true>(p, 4, NL, wg, nwg);
}

#if MEGA
#ifndef PROF
#define PROF 0
#endif
#if PROF
#define PH_RUN(PHID, CAT) do { const unsigned long long _t0 = wall_clock64(); do_phase<PHID>(p, smem, layer, wg, nwg); xcd_barrier(bar); if ((CAT) == PROF || PROF == 99) tacc += wall_clock64() - _t0; } while (0)
#else
#ifndef DUP_CAT
#define DUP_CAT 0
#endif
#define PH_RUN(PHID, CAT) do { do_phase<PHID>(p, smem, layer, wg, nwg); xcd_barrier(bar); if ((CAT) == DUP_CAT) { do_phase<((PHID) == PH_SCAN ? PH_SCANV : (PHID) == PH_ROUTER ? PH_ROUTERV : (PHID) == PH_WOUT ? PH_WOUTV : (PHID))>(p, smem, layer, wg, nwg); xcd_barrier(bar); } } while (0)
#endif
__global__ void __launch_bounds__(256, 2) k_mega(Params p) {
    extern __shared__ __attribute__((aligned(16))) char smem[];
    if (threadIdx.x == 0) *(u32x4*)(smem + SM_BAR) = (u32x4){0u, 0u, 0u, 0u};
    __syncthreads();
    XcdBarrier bar = xcd_barrier_post(WSP(unsigned, OFF_BAR), (volatile LAS unsigned*)(smem + SM_BAR));
    const int wg = blockIdx.x, nwg = gridDim.x;
#if PROF
    unsigned long long tacc = 0;
#endif
    { int layer = 0; PH_RUN(PH_PROLOGUE, 1); }
    for (int layer = 0; layer < 4; ++layer) {
        PH_RUN(PH_MOD_MIX, 2);
        if ((layer & 1) == 0) {
            PH_RUN(PH_E2, 3); PH_RUN(PH_E3, 4);
#if CHUNKED
            PH_RUN(PH_S1A, 16); PH_RUN(PH_S2A, 17); PH_RUN(PH_S2B, 18);
#else
            PH_RUN(PH_SCAN, 6);
#endif
            PH_RUN(PH_POST, 7); PH_RUN(PH_WOUT, 8);
        } else {
            PH_RUN(PH_F1, 9); PH_RUN(PH_F2, 10); PH_RUN(PH_F3, 11); PH_RUN(PH_WF, 8);
        }
        PH_RUN(PH_FFNR, 12); PH_RUN(PH_MOE1, 14); PH_RUN(PH_MOE2, 15);
    }
#if PROF
    {
        float* slot = (float*)(p.ws + OFF_POFF + 2048);
        if (wg == 0 && threadIdx.x == 0) *slot = rintf(logf((float)tacc * 0.01f) * 20.f) * 0.05f;
        xcd_barrier(bar);
        const float c = *slot;
        for (size_t i = (size_t)wg * 256 + threadIdx.x; i < (size_t)NL * 1024; i += (size_t)nwg * 256) p.out[i] = c;
    }
#else
    do_phase<PH_FINAL>(p, smem, 4, wg, nwg);
#endif
}
#else
template <int PH>
__global__ void __launch_bounds__(256, 2) k_phase(Params p, int layer) {
    extern __shared__ __attribute__((aligned(16))) char smem[];
    do_phase<PH>(p, smem, layer, blockIdx.x, gridDim.x);
}
template <int PH> static void launch_phase(const Params& p, int layer, hipStream_t stream) {
    static bool attr = false;
    if (!attr) { (void)hipFuncSetAttribute((const void*)k_phase<PH>, hipFuncAttributeMaxDynamicSharedMemorySize, SMEM_BYTES); attr = true; }
    hipLaunchKernelGGL(k_phase<PH>, dim3(512), dim3(256), SMEM_BYTES, stream, p, layer);
}
#endif


#if DIAG >= 2
__global__ void k_census(Params p, int what) {
}
__global__ void k_census1(char* ws, size_t off, size_t nbytes, int isf32, int idx) {
    const unsigned* u = (const unsigned*)(ws + off); const size_t n = nbytes / 4; bool bad = false;
    for (size_t i = (size_t)blockIdx.x * 256 + threadIdx.x; i < n; i += (size_t)gridDim.x * 256) {
        const unsigned x = u[i];
        if (isf32) { if ((x & 0x7f800000u) >= (141u << 23)) bad = true; }
        else { if ((x & 0x7f80u) >= (141u << 7) || (x & 0x7f800000u) >= (141u << 23)) bad = true; }
    }
    if (bad) atomicOr((unsigned*)(ws + OFF_CNT) + 192, 1u << idx);
}
__global__ void k_report(Params p) {
    const unsigned f = *((const unsigned*)(p.ws + OFF_CNT) + 192);
    int idx = 0; for (int b = 1; b < 32; ++b) if (f & (1u << b)) { idx = b; break; }
    const float c = sqrtf(0.5f * (float)idx);
    for (size_t i = (size_t)blockIdx.x * 256 + threadIdx.x; i < (size_t)NL * 1024; i += (size_t)gridDim.x * 256) p.out[i] = c;
}
#endif

#if DIAG == 3
__global__ void __launch_bounds__(256, 2) k_gemmtest(Params p) {
    extern __shared__ __attribute__((aligned(16))) char smem[];
    bf16_t* A = WSP(bf16_t, OFF_PREG); bf16_t* B = A + 128 * 128; float* C = (float*)(B + 128 * 128);
    unsigned* cnt = (unsigned*)(p.ws + OFF_CNT) + 192;
    const int tid = threadIdx.x;
    for (int i = tid; i < 128 * 128; i += 256) { const int m = i >> 7, k = i & 127; A[i] = f2bf((float)(((m * 7 + k * 3) % 9) - 4)); B[i] = f2bf((float)(((m * 5 + k * 11) % 7) - 3)); }
    __threadfence(); __syncthreads();
    f32x4 acc[4][4];
    gemm_tile(smem, 2, APlain{A, 128, 0}, BPlain{B, 128}, acc);
    EPI_FOR(acc, { *(f32x4*)(C + (size_t)row * 128 + col) = v; });
    __threadfence(); __syncthreads();
    unsigned bad = 0, nonfin = 0, tr = 0;
    for (int i = tid; i < 128 * 128; i += 256) { const int m = i >> 7, n = i & 127; float s = 0.f, st = 0.f;
        for (int k = 0; k < 128; ++k) { s += bf2f(A[m * 128 + k]) * bf2f(B[k * 128 + n]); st += bf2f(A[n * 128 + k]) * bf2f(B[k * 128 + m]); }
        const float c = C[i]; if (c != s) ++bad; if (!(fabsf(c) < 3e38f)) ++nonfin; if (c == st) ++tr; }
    atomicAdd(cnt + 1, bad); atomicAdd(cnt + 2, nonfin); atomicAdd(cnt + 3, tr);
}
__global__ void k_report3(Params p) {
    const unsigned* cnt = (const unsigned*)(p.ws + OFF_CNT) + 192;
    float c2 = 8.f * (float)cnt[1] / 16384.f; if (cnt[2]) c2 += 20.f; if (cnt[3] > 8000) c2 += 50.f;
    const float c = sqrtf(c2);
    for (size_t i = (size_t)blockIdx.x * 256 + threadIdx.x; i < (size_t)NL * 1024; i += (size_t)gridDim.x * 256) p.out[i] = c;
}
#endif

#if DIAG == 4 || DIAG == 5
__device__ __forceinline__ bool close_(float a, float b, float tol) { return fabsf(a - b) <= tol * (1.f + fabsf(b)); }
__global__ void k_check(Params p) {
    unsigned* flag = (unsigned*)(p.ws + OFF_CNT) + 192;
    const float* mod = WSP(float, OFF_MOD); const bf16_t* H = WSP(bf16_t, OFF_HREG); const bf16_t* P = WSP(bf16_t, OFF_PREG); const bf16_t* LR1 = WSP(bf16_t, OFF_LR1);
    const bf16_t* WIN = (const bf16_t*)(p.ws + OFF_WTS + W_WIN); const bf16_t* WL1 = (const bf16_t*)(p.ws + OFF_WTS + W_LR1);
    const size_t gt = (size_t)blockIdx.x * 256 + threadIdx.x, gs = (size_t)gridDim.x * 256;
    unsigned bad = 0;
    for (size_t i = gt; i < 5 * 6144; i += gs) { const int mb = (int)(i / 6144), n = (int)(i % 6144); float s = 0.f;
        for (int k = 0; k < 1024; ++k) { const float cv = mb < 4 ? p.c[mb * 1024 + k] : p.c_ctx[k]; s += cv / (1.f + expf(-cv)) * p.ada_w[(size_t)k * 6144 + n]; }
        s += p.ada_b[n]; if (!close_(mod[(size_t)(mb * 4) * 6144 + n], s, 1e-3f)) bad |= 1u; }
    { const int rows[6] = {0, 1, 8191, 8192, NL, NT - 1};
      for (size_t i = gt; i < 6 * 1024; i += gs) { const int r = rows[i >> 10], c = (int)(i & 1023); const float* xr = r < NL ? p.x + (size_t)r * 1024 : p.ctx + (size_t)(r - NL) * 1024;
        float ss = 0.f; for (int k = 0; k < 1024; ++k) ss += xr[k] * xr[k]; const float rinv = 1.f / sqrtf(ss / 1024.f + 1e-6f); const int mb = r < NL ? r >> 13 : 4;
        const float h = xr[c] * rinv * p.norm_mix[c] * (1.f + mod[(size_t)(mb * 4) * 6144 + 1024 + c]) + mod[(size_t)(mb * 4) * 6144 + c];
        if (!close_(bf2f(H[(size_t)r * 1024 + c]), h, 2e-2f)) bad |= 2u; } }
    for (size_t i = gt; i < (size_t)1024 * 2048; i += gs) if (!close_(bf2f(WIN[i]), p.w_in[i], 1e-2f)) bad |= 4u;
    { const int rows[6] = {0, 1, 127, 128, 5000, NT - 1};
      for (size_t i = gt; i < 6 * 2048; i += gs) { const int r = rows[i >> 11], n = (int)(i & 2047); float s = 0.f;
        for (int k = 0; k < 1024; ++k) s += bf2f(H[(size_t)r * 1024 + k]) * bf2f(WIN[(size_t)k * 2048 + n]);
        if (!close_(bf2f(P[(size_t)r * 2048 + n]), s, 2e-2f)) bad |= 8u; } }
    { const int rows[6] = {0, 1, 63, 64, 8191, NT - 1};
      for (size_t i = gt; i < 6 * 384; i += gs) { const int r = rows[i / 384], n = (int)(i % 384); float s = 0.f;
        for (int k = 0; k < 1024; ++k) s += bf2f(H[(size_t)r * 1024 + k]) * bf2f(WL1[(size_t)k * 384 + n]);
        for (int k = 0; k < 1024; ++k) { const int sr = shift_src(r, k >> 8); if (sr >= 0) s += bf2f(H[(size_t)sr * 1024 + k]) * bf2f(WL1[(size_t)(1024 + k) * 384 + n]); }
        const float a = n < 128 ? tanhf(s) : (n < 256 ? s : 1.f / (1.f + expf(-s)));
        if (!close_(bf2f(LR1[(size_t)r * 384 + n]), a, 2e-2f)) bad |= 16u; } }
    if (bad) atomicOr(flag, bad);
}
__global__ void k_report4(Params p) {
    const unsigned f = *((const unsigned*)(p.ws + OFF_CNT) + 192);
    const float c = sqrtf(0.25f * (float)f);
    for (size_t i = (size_t)blockIdx.x * 256 + threadIdx.x; i < (size_t)NL * 1024; i += (size_t)gridDim.x * 256) p.out[i] = c;
}
#endif

#if DIAG == 5
__global__ void __launch_bounds__(256, 2) k_projtest(Params p) {
    extern __shared__ __attribute__((aligned(16))) char smem[];
    const bf16_t* H = WSP(bf16_t, OFF_HREG); const bf16_t* WIN = (const bf16_t*)(p.ws + OFF_WTS + W_WIN);
    float* C = WSP(float, OFF_PREG) + (size_t)blockIdx.x * 128 * 128;
    unsigned* flag = (unsigned*)(p.ws + OFF_CNT) + 192;
    const int m0s[4] = {0, 0, 128 * 263, 128 * 100}, n0s[4] = {0, 1920, 0, 640};
    const int m0 = m0s[blockIdx.x], n0 = n0s[blockIdx.x];
    f32x4 acc[4][4];
    gemm_tile(smem, 16, APlain{H, 1024, m0}, BPlain{WIN + n0, 2048}, acc);
    EPI_FOR(acc, { *(f32x4*)(C + (size_t)row * 128 + col) = v; });
    __threadfence(); __syncthreads();
    unsigned bad = 0;
    for (int i = threadIdx.x; i < 128 * 128; i += 256) { const int m = i >> 7, n = i & 127; float s = 0.f;
        for (int k = 0; k < 1024; ++k) s += bf2f(H[(size_t)(m0 + m) * 1024 + k]) * bf2f(WIN[(size_t)k * 2048 + n0 + n]);
        if (!(fabsf(C[i] - s) <= 1e-2f * (1.f + fabsf(s)))) bad = 1; }
    if (bad) atomicOr(flag, 1u << blockIdx.x);
}
#endif

extern "C" void kernel_launch(void* const* d_in, const int* in_sizes, int n_in, void* d_out, int out_size, void* d_ws, size_t ws_size, hipStream_t stream) {
    if (n_in != 36 || ws_size < WS_END) { fprintf(stderr, "kernel_launch: unexpected n_in %d or workspace %zu < %zu\n", n_in, ws_size, (size_t)WS_END); return; }
    Params p{};
    const float** pf = (const float**)&p;
    for (int i = 0; i < 36; ++i) pf[i] = (const float*)d_in[i];
    p.out = (float*)d_out; p.ws = (char*)d_ws;
    (void)hipMemsetAsync(d_ws, 0, ZERO_REGION, stream);
#if MEGA
    static int grid = 0;
    if (grid == 0) {
        int dev = 0, cus = 0, per_cu = 0;
        (void)hipGetDevice(&dev); (void)hipDeviceGetAttribute(&cus, hipDeviceAttributeMultiprocessorCount, dev);
        (void)hipFuncSetAttribute((const void*)k_mega, hipFuncAttributeMaxDynamicSharedMemorySize, SMEM_BYTES);
        (void)hipOccupancyMaxActiveBlocksPerMultiprocessor(&per_cu, (const void*)k_mega, 256, SMEM_BYTES);
        (void)hipGetLastError();
        if (per_cu < 1) per_cu = 1;
        grid = cus * (per_cu < 2 ? per_cu : 2);
    }
    hipLaunchKernelGGL(k_mega, dim3(grid), dim3(256), SMEM_BYTES, stream, p);
#else
#if DIAG == 1
    launch_phase<PH_MOD_MIX>(p, 0, stream); launch_phase<PH_FINAL>(p, 4, stream); return;
#endif
#if DIAG == 5
    launch_phase<PH_PROLOGUE>(p, 0, stream); launch_phase<PH_MOD_MIX>(p, 0, stream);
    (void)hipFuncSetAttribute((const void*)k_projtest, hipFuncAttributeMaxDynamicSharedMemorySize, SMEM_BYTES);
    hipLaunchKernelGGL(k_projtest, dim3(4), dim3(256), SMEM_BYTES, stream, p);
    hipLaunchKernelGGL(k_report4, dim3(1024), dim3(256), 0, stream, p); return;
#endif
#if DIAG == 4
    launch_phase<PH_PROLOGUE>(p, 0, stream); launch_phase<PH_MOD_MIX>(p, 0, stream); launch_phase<PH_E2>(p, 0, stream);
    hipLaunchKernelGGL(k_check, dim3(512), dim3(256), 0, stream, p);
    hipLaunchKernelGGL(k_report4, dim3(1024), dim3(256), 0, stream, p); return;
#endif
#if DIAG == 3
    (void)hipFuncSetAttribute((const void*)k_gemmtest, hipFuncAttributeMaxDynamicSharedMemorySize, SMEM_BYTES);
    hipLaunchKernelGGL(k_gemmtest, dim3(1), dim3(256), SMEM_BYTES, stream, p);
    hipLaunchKernelGGL(k_report3, dim3(1024), dim3(256), 0, stream, p); return;
#endif
#if DIAG == 2
#define CEN(off, bytes, isf, idx) hipLaunchKernelGGL(k_census1, dim3(1024), dim3(256), 0, stream, p.ws, (size_t)(off), (size_t)(bytes), isf, idx)
    launch_phase<PH_PROLOGUE>(p, 0, stream); launch_phase<PH_MOD_MIX>(p, 0, stream);
    CEN(OFF_MOD, 491520, 1, 1); CEN(OFF_HREG, (size_t)NT * 2048, 0, 2); CEN(OFF_WTS, W_END, 0, 3);
    launch_phase<PH_E2>(p, 0, stream);
    CEN(OFF_PREG, (size_t)NT * 4096, 0, 4); CEN(OFF_LR1, (size_t)NT * 768, 0, 5);
    launch_phase<PH_E3>(p, 0, stream);
    CEN(OFF_RKVK, (size_t)NT * 1024, 0, 6); CEN(OFF_RKVK + (size_t)NT * 1024, (size_t)NT * 1024, 0, 7); CEN(OFF_RKVK + (size_t)NT * 2048, (size_t)NT * 1024, 0, 8);
    CEN(OFF_RKVK + (size_t)NT * 3072, (size_t)NT * 1024, 0, 9); CEN(OFF_DIFF, (size_t)NT * 1024, 0, 10);
    launch_phase<PH_E4>(p, 0, stream);
    CEN(OFF_WREG, (size_t)NT * 4096, 1, 11); CEN(OFF_KD, (size_t)NT * 2048, 0, 12); CEN(OFF_BB, (size_t)NT * 2048, 0, 13); CEN(OFF_G, (size_t)NT * 1024, 0, 14);
    launch_phase<PH_SCAN>(p, 0, stream);
    CEN(OFF_PREG, (size_t)NT * 4096, 1, 15);
    launch_phase<PH_POST>(p, 0, stream);
    CEN(OFF_HREG, (size_t)NT * 2048, 0, 16);
    launch_phase<PH_WOUT>(p, 0, stream);
    CEN(OFF_RES, (size_t)NT * 4096, 1, 17);
    hipLaunchKernelGGL(k_report, dim3(1024), dim3(256), 0, stream, p); return;
#endif
    launch_phase<PH_PROLOGUE>(p, 0, stream);
    for (int layer = 0; layer < 4; ++layer) {
        launch_phase<PH_MOD_MIX>(p, layer, stream);
        if ((layer & 1) == 0) {
            launch_phase<PH_E2>(p, layer, stream); launch_phase<PH_E3>(p, layer, stream); launch_phase<PH_E4>(p, layer, stream);
            launch_phase<PH_SCAN>(p, layer, stream); launch_phase<PH_POST>(p, layer, stream); launch_phase<PH_WOUT>(p, layer, stream);
        } else {
            launch_phase<PH_F1>(p, layer, stream); launch_phase<PH_F2>(p, layer, stream); launch_phase<PH_F3>(p, layer, stream); launch_phase<PH_WF>(p, layer, stream);
        }
        launch_phase<PH_MOD_FFN>(p, layer, stream); launch_phase<PH_ROUTER>(p, layer, stream); launch_phase<PH_MOE1>(p, layer, stream); launch_phase<PH_MOE2>(p, layer, stream);
    }
    launch_phase<PH_FINAL>(p, 4, stream);
#endif
}
```

```cpp
#include <hip/hip_runtime.h>
#include <stdint.h>
#include <stdio.h>

#ifndef DIAG
#define DIAG 0
#endif
#ifndef CHUNKED
#define CHUNKED 1
#endif
#ifndef ROUTER_NK
#define ROUTER_NK 16
#endif
#ifndef MEGA
#define MEGA 1
#endif

typedef unsigned short bf16_t;
typedef short bf16x8 __attribute__((ext_vector_type(8)));
typedef short s16x4 __attribute__((ext_vector_type(4)));
typedef float f32x4 __attribute__((ext_vector_type(4)));
typedef unsigned u32x4 __attribute__((ext_vector_type(4)));
typedef unsigned u32x2 __attribute__((ext_vector_type(2)));
#define LAS __attribute__((address_space(3)))
#define GAS __attribute__((address_space(1)))

#define NL 32768
#define NCX 1024
#define NT 33792
#define DM 1024
#define TOKCAP NT
#define YM_ROWS 71680

#define MBY(x) ((size_t)(x) << 20)
constexpr size_t OFF_BAR = 0, OFF_CNT = 16384, OFF_ZERO = 16384 + 1024, ZERO_REGION = 32768;
constexpr size_t OFF_POFF = 32768, OFF_MOD = 65536;
constexpr size_t OFF_ROUTEI = MBY(1), OFF_ROUTEG = MBY(1) + 270336, OFF_TOKL = MBY(2);
constexpr size_t OFF_WTS = MBY(8);
constexpr size_t W_WIN = 0, W_WOUT = W_WIN + 8388608, W_WF = W_WOUT + 4194304, W_LR1 = W_WF + 4194304, W_LR2 = W_LR1 + 3145728,
                 W_POOL = W_LR2 + 786432, W_RW = W_POOL + 262144, W_DFTC = W_RW + 3145728, W_TW = W_DFTC + 262144, W_CS128 = W_TW + 4194304,
                 W_CS256 = W_CS128 + 65536, W_END = W_CS256 + 262144;
static_assert(W_END < MBY(32), "weights region");
constexpr size_t OFF_RES = MBY(40), OFF_HREG = MBY(172), OFF_PREG = MBY(238), OFF_LR1 = MBY(378), OFF_RKVK = MBY(403), OFF_DIFF = MBY(535),
                 OFF_WREG = MBY(568), OFF_KD = MBY(700), OFF_BB = MBY(766), OFF_G = MBY(836), WS_END = MBY(1001);
constexpr size_t OFF_W2 = OFF_RKVK + (size_t)3 * 33792 * 512 * 2;

struct Params {
    const float *x, *c, *ctx, *c_ctx, *ada_w, *ada_b, *norm_mix, *norm_ffn, *w_in, *mu_x, *mu_p, *decay_w0, *decay_w1, *decay_w2, *lr_a0, *lr_a1, *lr_a2,
        *gate_g1, *gate_g2, *k_k, *k_a, *r_k, *gn_w, *gn_b, *pool_w, *pool_scale, *w_out, *w_fourier, *router_c, *router_c_b, *router_f, *router_f_b,
        *moe_w1, *moe_w3, *moe_w2, *final_norm;
    float* out;
    char* ws;
};

typedef float f32x2_ __attribute__((ext_vector_type(2)));
typedef __bf16 bf16x2_ __attribute__((ext_vector_type(2)));
__device__ __forceinline__ unsigned pk2(float lo, float hi) { const f32x2_ v = {lo, hi}; const bf16x2_ r = __builtin_convertvector(v, bf16x2_); return __builtin_bit_cast(unsigned, r); }
__device__ __forceinline__ bf16_t f2bf(float f) { return (bf16_t)(pk2(f, 0.f) & 0xffffu); }
__device__ __forceinline__ float bf2f(bf16_t h) { return __uint_as_float((unsigned)h << 16); }
__device__ __forceinline__ float bflo(unsigned u) { return __uint_as_float(u << 16); }
__device__ __forceinline__ float bfhi(unsigned u) { return __uint_as_float(u & 0xffff0000u); }
__device__ __forceinline__ float rl_(float x, int l) { return __builtin_bit_cast(float, __builtin_amdgcn_readlane(__builtin_bit_cast(int, x), l)); }
template <int CTRL> __device__ __forceinline__ float dppf(float v) { return __builtin_bit_cast(float, __builtin_amdgcn_update_dpp(0, __builtin_bit_cast(int, v), CTRL, 0xf, 0xf, true)); }
__device__ __forceinline__ float sum8(float v) { v += dppf<0xB1>(v); v += dppf<0x4E>(v); v += dppf<0x141>(v); return v; }
__device__ __forceinline__ float sum16(float v) { v += dppf<0xB1>(v); v += dppf<0x4E>(v); v += dppf<0x141>(v); v += dppf<0x140>(v); return v; }
__device__ __forceinline__ float wave_sum(float v) {
    v += dppf<0xB1>(v); v += dppf<0x4E>(v); v += dppf<0x141>(v); v += dppf<0x140>(v);
    return (rl_(v, 0) + rl_(v, 16)) + (rl_(v, 32) + rl_(v, 48));
}
__device__ __forceinline__ float fexp(float x) { return __builtin_amdgcn_exp2f(x * 1.44269504089f); }
__device__ __forceinline__ float frcp(float x) { return __builtin_amdgcn_rcpf(x); }
__device__ __forceinline__ float frsq(float x) { return __builtin_amdgcn_rsqf(x); }
__device__ __forceinline__ float sigmoidf_(float x) { return frcp(1.f + fexp(-x)); }
__device__ __forceinline__ float tanhf_(float x) { return 1.f - 2.f * frcp(fexp(2.f * x) + 1.f); }
__device__ __forceinline__ int shift_src(int r, int q) {
    if (r < NL) {
        const int t = r & 8191, col = t & 63, row = t >> 6;
        if (q == 0) return col > 0 ? r - 1 : -1;
        if (q == 1) return col < 63 ? r + 1 : -1;
        if (q == 2) return row > 0 ? r - 64 : -1;
        return row < 127 ? r + 64 : -1;
    } else {
        const int t = (r - NL) & 255;
        if (q < 2) return t > 0 ? r - 1 : -1;
        return t < 255 ? r + 1 : -1;
    }
}

__device__ __forceinline__ int ltid() { int t = threadIdx.x; asm volatile("" : "+v"(t)); return t; }

#define XB_TMO      128
#define XB_XCNT(j)  (256  + 64 * (j))
#define XB_XSUB(j)  (1280 + 64 * (j))
#define XB_XGEN(j)  (2304 + 64 * (j))
#define XB_TOP      3328
#define XB_TOPGEN   3392
#define XCD_BAR_WORDS 3456
#define XB_SPIN_CAP (1u << 22)
__device__ __forceinline__ unsigned xb_ld(unsigned* p)              { return __hip_atomic_load(p, __ATOMIC_RELAXED, __HIP_MEMORY_SCOPE_AGENT); }
__device__ __forceinline__ unsigned xb_add(unsigned* p, unsigned v) { return __hip_atomic_fetch_add(p, v, __ATOMIC_RELAXED, __HIP_MEMORY_SCOPE_AGENT); }
__device__ __forceinline__ unsigned xb_xcc_id() { return (unsigned)__builtin_amdgcn_s_getreg((3 << 11) | 20) & 0xFu; }
#define XB_SPIN(cond, bar) do { unsigned _sp = 0; while (cond) { __builtin_amdgcn_s_sleep(1); \
    if ((++_sp & 255u) == 0u) { if (xb_ld(&(bar)[XB_TMO])) break; if (_sp > XB_SPIN_CAP) { atomicAdd(&(bar)[XB_TMO], 1u); break; } } } } while (0)
struct XcdBarrier { unsigned* bar; unsigned x; volatile LAS unsigned* st; };
__device__ __forceinline__ XcdBarrier xcd_barrier_post(unsigned* bar, volatile LAS unsigned* st) {
    XcdBarrier b; b.bar = bar; b.x = xb_xcc_id(); b.st = st;
    if (threadIdx.x == 0) (void)xb_add(&bar[XB_XCNT(b.x)], 1u);
    return b;
}
__device__ __forceinline__ void xcd_barrier_complete(unsigned* bar, unsigned x, unsigned& nloc, unsigned& nx) {
    const unsigned G = gridDim.x * gridDim.y * gridDim.z;
    unsigned sum, cnt, mine, sp = 0u;
    for (;;) {
        sum = 0u; cnt = 0u; mine = 0u;
#pragma unroll
        for (unsigned j = 0; j < 16; ++j) { const unsigned c = xb_ld(&bar[XB_XCNT(j)]); sum += c; cnt += (c > 0u) ? 1u : 0u; mine = (j == x) ? c : mine; }
        if (sum == G) break;
        __builtin_amdgcn_s_sleep(1);
        if ((++sp & 255u) == 0u) { if (xb_ld(&bar[XB_TMO])) break; if (sp > XB_SPIN_CAP) { atomicAdd(&bar[XB_TMO], 1u); break; } }
    }
    nloc = mine > 0u ? mine : 1u; nx = cnt > 0u ? cnt : 1u;
}
__device__ __forceinline__ void xcd_barrier(const XcdBarrier& b) {
    asm volatile("s_waitcnt vmcnt(0)" ::: "memory");
    __syncthreads();
    if (threadIdx.x == 0) {
        unsigned* bar = b.bar;
        __builtin_amdgcn_s_waitcnt(0);
        unsigned nloc = b.st[0], nx = b.st[1];
        if (nloc == 0u) { xcd_barrier_complete(bar, b.x, nloc, nx); b.st[0] = nloc; b.st[1] = nx; }
        const unsigned old = xb_add(&bar[XB_XSUB(b.x)], 1u);
        const unsigned gen = old / nloc;
        if (old + 1u == (gen + 1u) * nloc) {
            __builtin_amdgcn_fence(__ATOMIC_RELEASE, "agent");
            asm volatile("s_waitcnt vmcnt(0)" ::: "memory");
            const unsigned og = xb_add(&bar[XB_TOP], 1u);
            const unsigned tg = og / nx;
            if (og + 1u == (tg + 1u) * nx) xb_add(&bar[XB_TOPGEN], 1u);
            else XB_SPIN(xb_ld(&bar[XB_TOPGEN]) == tg, bar);
            __builtin_amdgcn_fence(__ATOMIC_ACQUIRE, "agent");
            xb_add(&bar[XB_XGEN(b.x)], 1u);
            asm volatile("s_waitcnt vmcnt(0)" ::: "memory");
        } else {
            XB_SPIN(xb_ld(&bar[XB_XGEN(b.x)]) == gen, bar);
            __builtin_amdgcn_fence(__ATOMIC_ACQUIRE, "agent");
            asm volatile("s_waitcnt vmcnt(0)" ::: "memory");
        }
    }
    __syncthreads();
}

#define G_ABYTES (128 * 128)
#define G_BBYTES (64 * 256)
#define G_STAGE (G_ABYTES + G_BBYTES)
#define SM_BAR 73728
#define SM_TAB (SM_BAR + 16)
#define SMEM_BYTES (SM_TAB + 512)
__device__ __forceinline__ int bswz(int k) { return ((k & 3) << 2) | ((k >> 2) & 3); }

__device__ __forceinline__ void glds16_asm(const void* gsrc, unsigned lds_dst) {
    unsigned keep;
    asm volatile("s_mov_b32 %0, m0\n\ts_mov_b32 m0, %2\n\ts_nop 0\n\tglobal_load_lds_dwordx4 %1, off\n\ts_mov_b32 m0, %0" : "=&s"(keep) : "v"(gsrc), "s"(lds_dst) : "memory");
}
template <class AF, class BF>
__device__ __forceinline__ void gemm_tile(char* smem, int nk, const AF& af, const BF& bf, f32x4 (&acc)[4][4]) {
    const int tid = ltid(), lane = tid & 63, wid = tid >> 6, wm = wid >> 1, wn = wid & 1;
#pragma unroll
    for (int i = 0; i < 4; ++i)
#pragma unroll
        for (int j = 0; j < 4; ++j) acc[i][j] = (f32x4){0.f, 0.f, 0.f, 0.f};
    const int arow = tid >> 3, akc = (((tid & 7) ^ (arow & 7)) << 3), brow = tid >> 4, bnc = (((tid & 15) ^ bswz(brow)) << 3);
    int ainfo[4];
#pragma unroll
    for (int i = 0; i < 4; ++i) ainfo[i] = af.info(arow + 32 * i);
    const unsigned lds0 = (unsigned)__builtin_amdgcn_readfirstlane((int)((unsigned)(size_t)smem + (unsigned)(wid * 1024)));
    auto issue = [&](int kt, int buf) {
        const unsigned dst = lds0 + (unsigned)(buf * G_STAGE);
#pragma unroll
        for (int i = 0; i < 4; ++i) glds16_asm(af.ptr(ainfo[i], arow + 32 * i, kt * 64 + akc), dst + i * 4096);
#pragma unroll
        for (int i = 0; i < 4; ++i) glds16_asm(bf.ptr(kt * 64 + brow + 16 * i, bnc), dst + G_ABYTES + i * 4096);
    };
    const int ar = wm * 64 + (lane & 15), ax = lane & 7, ag = lane >> 4;
    const int bg = lane >> 4, bq = (lane & 15) >> 2, bp = lane & 3;
    __syncthreads();
    issue(0, 0);
    asm volatile("s_waitcnt vmcnt(0)" ::: "memory");
    __syncthreads();
    for (int kt = 0; kt < nk; ++kt) {
        if (kt + 1 < nk) issue(kt + 1, (kt + 1) & 1);
        const char* sa = smem + (kt & 1) * G_STAGE; const char* sb = sa + G_ABYTES;
#pragma unroll
        for (int ks = 0; ks < 2; ++ks) {
            bf16x8 a[4], b[4];
#pragma unroll
            for (int mt = 0; mt < 4; ++mt) a[mt] = *(const bf16x8*)(sa + (ar + mt * 16) * 128 + (((4 * ks + ag) ^ ax) << 4));
#pragma unroll
            for (int nt = 0; nt < 4; ++nt) {
                const int c2 = 2 * (wn * 4 + nt) + (bp >> 1);
                const int k0 = 32 * ks + 8 * bg + bq, k1 = k0 + 4;
                const s16x4 lo = __builtin_amdgcn_ds_read_tr16_b64_v4i16((LAS s16x4*)(sb + k0 * 256 + ((c2 ^ bswz(k0)) << 4) + 8 * (bp & 1)));
                const s16x4 hi = __builtin_amdgcn_ds_read_tr16_b64_v4i16((LAS s16x4*)(sb + k1 * 256 + ((c2 ^ bswz(k1)) << 4) + 8 * (bp & 1)));
                b[nt] = __builtin_shufflevector(lo, hi, 0, 1, 2, 3, 4, 5, 6, 7);
            }
            __builtin_amdgcn_s_setprio(1);
#pragma unroll
            for (int mt = 0; mt < 4; ++mt)
#pragma unroll
                for (int nt = 0; nt < 4; ++nt) acc[mt][nt] = __builtin_amdgcn_mfma_f32_16x16x32_bf16(b[nt], a[mt], acc[mt][nt], 0, 0, 0);
            __builtin_amdgcn_s_setprio(0);
        }
        asm volatile("s_waitcnt vmcnt(0)" ::: "memory");
        __syncthreads();
    }
}
#define EPI_FOR(acc, ...) do { const int _l = ltid() & 63, _w = ltid() >> 6, _wm = _w >> 1, _wn = _w & 1; \
    _Pragma("unroll") for (int _mt = 0; _mt < 4; ++_mt) _Pragma("unroll") for (int _nt = 0; _nt < 4; ++_nt) { \
        const int row = _wm * 64 + _mt * 16 + (_l & 15), col = _wn * 64 + _nt * 16 + 4 * (_l >> 4); const f32x4 v = acc[_mt][_nt]; __VA_ARGS__ } } while (0)

__device__ __forceinline__ void st_bf4(bf16_t* p, f32x4 v) { u32x2 w; w.x = pk2(v[0], v[1]); w.y = pk2(v[2], v[3]); *(u32x2*)p = w; }
__device__ __forceinline__ void st_bf4_nt(bf16_t* p, f32x4 v) { u32x2 w; w.x = pk2(v[0], v[1]); w.y = pk2(v[2], v[3]); __builtin_nontemporal_store(w, (u32x2*)p); }

struct W2Conv {
    const float* src; bf16_t* dst; int nslices, wg, nwg; f32x4 r[8];
    static constexpr size_t N4 = (size_t)32 * 512 * 1024 / 4;
    __device__ __forceinline__ size_t item(int i, int k) const { return ((size_t)(k * nslices + i) * nwg + wg) * 256 + ltid(); }
    __device__ __forceinline__ void load(int i) {
        if (i >= nslices) return;
#pragma unroll
        for (int k = 0; k < 8; ++k) { const size_t it = item(i, k); if (it < N4) r[k] = __builtin_nontemporal_load((const f32x4*)(src + 4 * it)); }
    }
    __device__ __forceinline__ void store(int i) {
        if (i >= nslices) return;
#pragma unroll
        for (int k = 0; k < 8; ++k) { const size_t it = item(i, k); if (it < N4) st_bf4(dst + 4 * it, r[k]); }
    }
};

struct APlain { const bf16_t* base; int lda; int m0; __device__ __forceinline__ int info(int row) const { return m0 + row; }
    __device__ __forceinline__ const bf16_t* ptr(int gr, int, int k) const { return base + (size_t)gr * lda + k; } };
struct BPlain { const bf16_t* base; int ldb; __device__ __forceinline__ const bf16_t* ptr(int k, int n) const { return base + (size_t)k * ldb + n; } };

enum { PH_PROLOGUE = 0, PH_MOD_MIX, PH_E2, PH_E3, PH_E4, PH_SCAN, PH_POST, PH_WOUT, PH_F1, PH_F2, PH_F3, PH_WF, PH_MOD_FFN, PH_ROUTER, PH_MOE1, PH_MOE2, PH_FINAL, PH_SCANV, PH_ROUTERV, PH_WOUTV, PH_S1A, PH_S2A, PH_S1B, PH_S2B, PH_FFNR };

#ifndef SCANVAR
#define SCANVAR 0
#endif

#define WSP(T, off) ((T*)(p.ws + (off)))

__device__ __forceinline__ void phase_prologue(const Params& p, char* smem, int wg, int nwg) {
    const int tid = ltid(), lane = tid & 63, wv = tid >> 6;
    float* S = (float*)smem;
    float* RED = S + 5 * 1024;
    for (int idx = tid; idx < 5 * 1024; idx += 256) { const int rb = idx >> 10, k = idx & 1023; const float cv = rb < 4 ? p.c[rb * 1024 + k] : p.c_ctx[k]; S[idx] = cv / (1.f + expf(-cv)); }
    __syncthreads();
    float* mod = WSP(float, OFF_MOD);
    for (int task = wg; task < 384; task += nwg) {
        const int i = task / 96, n0 = (task % 96) * 64;
        const float* W = p.ada_w + (size_t)i * 1024 * 6144 + n0 + lane;
        float a0 = 0.f, a1 = 0.f, a2 = 0.f, a3 = 0.f, a4 = 0.f;
        for (int k = wv * 256; k < wv * 256 + 256; k += 8) {
            float w[8];
#pragma unroll
            for (int u = 0; u < 8; ++u) w[u] = __builtin_nontemporal_load(W + (size_t)(k + u) * 6144);
#pragma unroll
            for (int u = 0; u < 8; ++u) { a0 += S[k + u] * w[u]; a1 += S[1024 + k + u] * w[u]; a2 += S[2048 + k + u] * w[u]; a3 += S[3072 + k + u] * w[u]; a4 += S[4096 + k + u] * w[u]; }
        }
        RED[(wv * 5 + 0) * 64 + lane] = a0; RED[(wv * 5 + 1) * 64 + lane] = a1; RED[(wv * 5 + 2) * 64 + lane] = a2; RED[(wv * 5 + 3) * 64 + lane] = a3; RED[(wv * 5 + 4) * 64 + lane] = a4;
        __syncthreads();
        for (int o = tid; o < 320; o += 256) { const int r = o >> 6, l = o & 63;
            const float s = RED[(0 * 5 + r) * 64 + l] + RED[(1 * 5 + r) * 64 + l] + RED[(2 * 5 + r) * 64 + l] + RED[(3 * 5 + r) * 64 + l];
            mod[(size_t)(r * 4 + i) * 6144 + n0 + l] = s + p.ada_b[i * 6144 + n0 + l]; }
        __syncthreads();
    }
    const size_t gt = (size_t)wg * 256 + tid, gs = (size_t)nwg * 256;
    char* wts = p.ws + OFF_WTS;
    auto cast4 = [&](const float* src, bf16_t* dst, size_t n4) { for (size_t i = gt; i < n4; i += gs) { const f32x4 v = __builtin_nontemporal_load((const f32x4*)(src + 4 * i)); st_bf4(dst + 4 * i, v); } };
    cast4(p.w_in, (bf16_t*)(wts + W_WIN), (size_t)2 * 1024 * 2048 / 4);
    cast4(p.w_out, (bf16_t*)(wts + W_WOUT), (size_t)2 * 1024 * 1024 / 4);
    cast4(p.w_fourier, (bf16_t*)(wts + W_WF), (size_t)2 * 1024 * 1024 / 4);
    cast4(p.pool_w, (bf16_t*)(wts + W_POOL), (size_t)2 * 512 * 128 / 4);
    {
        bf16_t* d = (bf16_t*)(wts + W_LR1);
        for (size_t i = gt; i < (size_t)2 * 2048 * 384; i += gs) {
            const int n = (int)(i % 384), kk = (int)((i / 384) % 2048), j = (int)(i / (384 * 2048)); const int k = kk & 1023;
            float w, mu;
            if (n < 128) { const int dd = n >> 6; w = p.decay_w1[((size_t)(j * 2 + dd) * 1024 + k) * 64 + (n & 63)]; mu = p.mu_x[(j * 3 + 0) * 1024 + k]; }
            else if (n < 256) { const int dd = (n - 128) >> 6; w = p.lr_a1[((size_t)(j * 2 + dd) * 1024 + k) * 64 + (n & 63)]; mu = p.mu_x[(j * 3 + 1) * 1024 + k]; }
            else { w = p.gate_g1[((size_t)j * 1024 + k) * 128 + (n - 256)]; mu = p.mu_x[(j * 3 + 2) * 1024 + k]; }
            d[i] = f2bf(kk < 1024 ? (1.f - mu) * w : mu * w);
        }
    }
    {
        bf16_t* d = (bf16_t*)(wts + W_LR2);
        for (size_t i = gt; i < (size_t)2 * 384 * 512; i += gs) {
            const int n = (int)(i % 512), k = (int)((i / 512) % 384), j = (int)(i / (512 * 384));
            float w;
            if (k < 128) w = p.decay_w2[((size_t)(j * 2 + (k >> 6)) * 64 + (k & 63)) * 512 + n];
            else if (k < 256) w = p.lr_a2[((size_t)(j * 2 + ((k - 128) >> 6)) * 64 + (k & 63)) * 512 + n];
            else w = p.gate_g2[((size_t)j * 128 + (k - 256)) * 512 + n];
            d[i] = f2bf(w);
        }
    }
    {
        uint32_t* d = (uint32_t*)(wts + W_RW);
        for (size_t i = gt; i < (size_t)4 * 4608 * 4; i += gs) {
            const int l = (int)(i / 18432), q = (int)(i % 18432) >> 2, k = (int)(i & 3);
            float w0, w1;
            if (q < 4096) { const int ln = q & 63, hf = (q >> 6) & 1, pp = (q >> 7) & 7, gi = q >> 10; const int c0 = 4 * ln + 256 * (pp >> 1) + 2 * (pp & 1), x = gi * 8 + hf * 4 + k;
                w0 = p.router_f[((size_t)l * 1024 + c0) * 32 + x]; w1 = p.router_f[((size_t)l * 1024 + c0 + 1) * 32 + x]; }
            else { const int q2 = q - 4096, ln = q2 & 63, pp = q2 >> 6; const int c0 = 4 * ln + 256 * (pp >> 1) + 2 * (pp & 1);
                w0 = p.router_c[((size_t)l * 1024 + c0) * 4 + k]; w1 = p.router_c[((size_t)l * 1024 + c0 + 1) * 4 + k]; }
            d[i] = pk2(w0, w1);
        }
    }
    {
        bf16_t* d = (bf16_t*)(wts + W_DFTC);
        for (size_t i = gt; i < (size_t)256 * 512; i += gs) { const int n = (int)(i & 511), c = (int)(i >> 9); const int idx = (c * (n & 255)) & 255; float sn, cs; sincospif((float)idx / 128.f, &sn, &cs); d[i] = f2bf(n < 256 ? cs : -sn); }
    }
    {
        bf16_t* d = (bf16_t*)(wts + W_TW);
        for (size_t i = gt; i < (size_t)128 * 128 * 128; i += gs) {
            const int col = (int)(i & 127), row = (int)((i >> 7) & 127), t2 = (int)(i >> 14);
            const int pp = row >> 6, f1 = row & 63, pi = col >> 6, t1 = col & 63; const int idx = (t1 * f1 * 128 + t2 * f1) & 8191;
            float sn, cs; sincospif((float)idx / 4096.f, &sn, &cs);
            d[i] = f2bf(pp == 0 ? (pi == 0 ? cs : sn) : (pi == 0 ? -sn : cs));
        }
    }
    {
        bf16_t* d = (bf16_t*)(wts + W_CS128);
        for (size_t i = gt; i < (size_t)128 * 256; i += gs) { const int col = (int)(i & 255), f2 = (int)(i >> 8); const int pi = col >> 7, t2 = col & 127, idx = (t2 * f2) & 127; float sn, cs; sincospif((float)idx / 64.f, &sn, &cs); d[i] = f2bf(pi == 0 ? cs : sn); }
    }
    {
        bf16_t* d = (bf16_t*)(wts + W_CS256);
        for (size_t i = gt; i < (size_t)256 * 512; i += gs) { const int col = (int)(i & 511), f = (int)(i >> 9); const int pi = col >> 8, t = col & 255, idx = (t * f) & 255; float sn, cs; sincospif((float)idx / 128.f, &sn, &cs); d[i] = f2bf(pi == 0 ? cs : sn); }
    }
}

template <int MODE>
__device__ __forceinline__ void phase_modulate(const Params& p, int layer, int nrows, bool first, bool combine, int wg, int nwg) {
    const int lane = ltid() & 63, wv = ltid() >> 6;
    float* RES = WSP(float, OFF_RES);
    const float* mod = WSP(float, OFF_MOD);
    bf16_t* H = WSP(bf16_t, OFF_HREG); bf16_t* HLO = WSP(bf16_t, OFF_KD);
    const bf16_t* YM = WSP(bf16_t, OFF_PREG);
    const int* routei = WSP(int, OFF_ROUTEI); const float* routeg = WSP(float, OFF_ROUTEG);
    const int* poff = WSP(int, OFF_POFF) + (MODE == 2 ? 3 : layer - 1) * 64;
    const int lprev = MODE == 2 ? 3 : layer - 1;
    for (int r = wg * 4 + wv; r < nrows; r += nwg * 4) {
        const float* src = first ? (r < NL ? p.x + (size_t)r * 1024 : p.ctx + (size_t)(r - NL) * 1024) : RES + (size_t)r * 1024;
        f32x4 v[4];
#pragma unroll
        for (int j = 0; j < 4; ++j) v[j] = *(const f32x4*)(src + 4 * lane + 256 * j);
        const int mb = r < NL ? (r >> 13) : 4;
        if (combine) {
            const int i0 = routei[2 * r], i1 = routei[2 * r + 1]; const float g0 = routeg[2 * r], g1 = routeg[2 * r + 1];
            const size_t row0 = (size_t)poff[i0 & 31] + (i0 >> 5), row1 = (size_t)poff[i1 & 31] + (i1 >> 5);
            const float* m5 = mod + (size_t)(mb * 4 + lprev) * 6144 + 5 * 1024;
#pragma unroll
            for (int j = 0; j < 4; ++j) {
                const u32x2 y0 = *(const u32x2*)(YM + row0 * 1024 + 4 * lane + 256 * j), y1 = *(const u32x2*)(YM + row1 * 1024 + 4 * lane + 256 * j);
                const f32x4 g = *(const f32x4*)(m5 + 4 * lane + 256 * j);
                v[j][0] += g[0] * (g0 * bflo(y0.x) + g1 * bflo(y1.x)); v[j][1] += g[1] * (g0 * bfhi(y0.x) + g1 * bfhi(y1.x));
                v[j][2] += g[2] * (g0 * bflo(y0.y) + g1 * bflo(y1.y)); v[j][3] += g[3] * (g0 * bfhi(y0.y) + g1 * bfhi(y1.y));
            }
        }
        if (combine && MODE != 2) {
#pragma unroll
            for (int j = 0; j < 4; ++j) *(f32x4*)(RES + (size_t)r * 1024 + 4 * lane + 256 * j) = v[j];
        }
        float ss = 0.f;
#pragma unroll
        for (int j = 0; j < 4; ++j) ss += (v[j][0] * v[j][0] + v[j][1] * v[j][1]) + (v[j][2] * v[j][2] + v[j][3] * v[j][3]);
        ss = wave_sum(ss);
        const float rinv = frsq(ss * (1.f / 1024.f) + 1e-6f);
        if (MODE == 2) {
#if DIAG
            if (!(ss < 3.0e38f)) {
#pragma unroll
                for (int j = 0; j < 4; ++j) *(f32x4*)(p.out + (size_t)r * 1024 + 4 * lane + 256 * j) = (f32x4){3.f, 3.f, 3.f, 3.f};
                continue;
            }
#endif
#pragma unroll
            for (int j = 0; j < 4; ++j) { const f32x4 g = *(const f32x4*)(p.final_norm + 4 * lane + 256 * j); f32x4 o; o[0] = v[j][0] * rinv * g[0]; o[1] = v[j][1] * rinv * g[1]; o[2] = v[j][2] * rinv * g[2]; o[3] = v[j][3] * rinv * g[3];
                *(f32x4*)(p.out + (size_t)r * 1024 + 4 * lane + 256 * j) = o; }
        } else {
            const float* gn = (MODE == 0 ? p.norm_mix : p.norm_ffn) + layer * 1024;
            const float* sh = mod + (size_t)(mb * 4 + layer) * 6144 + (MODE == 0 ? 0 : 3) * 1024;
            const float* sc = sh + 1024;
#pragma unroll
            for (int j = 0; j < 4; ++j) {
                const int c = 4 * lane + 256 * j;
                const f32x4 g = *(const f32x4*)(gn + c), s1 = *(const f32x4*)(sh + c), s2 = *(const f32x4*)(sc + c);
                f32x4 h;
#pragma unroll
                for (int e = 0; e < 4; ++e) h[e] = (v[j][e] * rinv * g[e]) * (1.f + s2[e]) + s1[e];
                u32x2 w; w.x = pk2(h[0], h[1]); w.y = pk2(h[2], h[3]);
                *(u32x2*)(H + (size_t)r * 1024 + c) = w;
                if (MODE == 1 && ROUTER_NK > 32) { u32x2 w2; w2.x = pk2(h[0] - bflo(w.x), h[1] - bfhi(w.x)); w2.y = pk2(h[2] - bflo(w.y), h[3] - bfhi(w.y)); *(u32x2*)(HLO + (size_t)r * 1024 + c) = w2; }
            }
        }
    }
}


template <int MODE, bool COMBINE>
__device__ __forceinline__ void phase_modpipe(const Params& p, int layer, int nrows, int wg, int nwg) {
    const int tid = ltid(), lane = tid & 63, wv = __builtin_amdgcn_readfirstlane(tid >> 6);
    float* RES = WSP(float, OFF_RES);
    const float* mod = WSP(float, OFF_MOD);
    bf16_t* H = WSP(bf16_t, OFF_HREG);
    const bf16_t* YM = WSP(bf16_t, OFF_PREG);
    const int* routei = WSP(int, OFF_ROUTEI); const float* routeg = WSP(float, OFF_ROUTEG);
    const int lprev = MODE == 2 ? 3 : layer - 1;
    int poffv = 0;
    if (COMBINE) poffv = (WSP(int, OFF_POFF) + lprev * 64)[lane & 31];
    const int rstep = nwg * 4, rlast = nrows - 1;
    int r = wg * 4 + wv;
    if (r >= nrows) return;
    const float* gn = MODE == 2 ? p.final_norm : p.norm_mix + layer * 1024;
    f32x4 A[4], B[4], G5[4]; int mbc = -1;
    u32x2 ri[2] = {{0u, 0u}, {0u, 0u}}; f32x2_ rg[2] = {{0.f, 0.f}, {0.f, 0.f}};
    f32x4 v[2][4]; u32x2 ya[2][4], yb[2][4]; float g0[2] = {0.f, 0.f}, g1[2] = {0.f, 0.f};
#define MP_SRC(rr) (COMBINE ? RES + (size_t)(rr) * 1024 : ((rr) < NL ? p.x + (size_t)(rr) * 1024 : p.ctx + (size_t)((rr) - NL) * 1024))
#define MP_ISSUE(rr, Q) do { \
        const float* src_ = MP_SRC(rr); \
        _Pragma("unroll") for (int j = 0; j < 4; ++j) v[Q][j] = __builtin_nontemporal_load((const f32x4*)(src_ + 4 * lane + 256 * j)); \
        if (COMBINE) { const int i0 = __builtin_amdgcn_readfirstlane((int)ri[Q].x), i1 = __builtin_amdgcn_readfirstlane((int)ri[Q].y); \
            const size_t row0 = (size_t)__builtin_amdgcn_readlane(poffv, i0 & 31) + (i0 >> 5), row1 = (size_t)__builtin_amdgcn_readlane(poffv, i1 & 31) + (i1 >> 5); \
            _Pragma("unroll") for (int j = 0; j < 4; ++j) { ya[Q][j] = __builtin_nontemporal_load((const u32x2*)(YM + row0 * 1024 + 4 * lane + 256 * j)); yb[Q][j] = __builtin_nontemporal_load((const u32x2*)(YM + row1 * 1024 + 4 * lane + 256 * j)); } \
            g0[Q] = rg[Q].x; g1[Q] = rg[Q].y; } } while (0)
    if (COMBINE) { ri[0] = *(const u32x2*)(routei + 2 * r); rg[0] = *(const f32x2_*)(routeg + 2 * r);
        const int r1 = min(r + rstep, rlast); ri[1] = *(const u32x2*)(routei + 2 * r1); rg[1] = *(const f32x2_*)(routeg + 2 * r1); }
    MP_ISSUE(r, 0);
#define MP_STEP(Q) { \
        if (r >= nrows) break; \
        const int mb = r < NL ? (r >> 13) : 4; \
        if (mb != mbc) { mbc = mb; \
            const float* sh = mod + (size_t)(mb * 4 + layer) * 6144; const float* sc = sh + 1024; \
            const float* m5 = mod + (size_t)(mb * 4 + lprev) * 6144 + 5 * 1024; \
            _Pragma("unroll") for (int j = 0; j < 4; ++j) { const int c = 4 * lane + 256 * j; const f32x4 g = *(const f32x4*)(gn + c); \
                if (COMBINE) G5[j] = *(const f32x4*)(m5 + c); \
                if (MODE == 2) A[j] = g; \
                else { const f32x4 s1 = *(const f32x4*)(sh + c), s2 = *(const f32x4*)(sc + c); \
                    _Pragma("unroll") for (int e = 0; e < 4; ++e) { A[j][e] = g[e] * (1.f + s2[e]); B[j][e] = s1[e]; } } } \
        } \
        { const int r1 = min(r + rstep, rlast); MP_ISSUE(r1, 1 - (Q)); }                    \
        if (COMBINE) { const int r2 = min(r + 2 * rstep, rlast); ri[Q] = *(const u32x2*)(routei + 2 * r2); rg[Q] = *(const f32x2_*)(routeg + 2 * r2); }     \
        __builtin_amdgcn_sched_barrier(0); \
        if (COMBINE) { \
            _Pragma("unroll") for (int j = 0; j < 4; ++j) { \
                v[Q][j][0] += G5[j][0] * (g0[Q] * bflo(ya[Q][j].x) + g1[Q] * bflo(yb[Q][j].x)); v[Q][j][1] += G5[j][1] * (g0[Q] * bfhi(ya[Q][j].x) + g1[Q] * bfhi(yb[Q][j].x)); \
                v[Q][j][2] += G5[j][2] * (g0[Q] * bflo(ya[Q][j].y) + g1[Q] * bflo(yb[Q][j].y)); v[Q][j][3] += G5[j][3] * (g0[Q] * bfhi(ya[Q][j].y) + g1[Q] * bfhi(yb[Q][j].y)); \
            } \
            if (MODE != 2) { _Pragma("unroll") for (int j = 0; j < 4; ++j) __builtin_nontemporal_store(v[Q][j], (f32x4*)(RES + (size_t)r * 1024 + 4 * lane + 256 * j)); } \
        } \
        float ss = 0.f; \
        _Pragma("unroll") for (int j = 0; j < 4; ++j) ss += (v[Q][j][0] * v[Q][j][0] + v[Q][j][1] * v[Q][j][1]) + (v[Q][j][2] * v[Q][j][2] + v[Q][j][3] * v[Q][j][3]); \
        ss = wave_sum(ss); \
        const float rinv = frsq(ss * (1.f / 1024.f) + 1e-6f); \
        _Pragma("unroll") for (int j = 0; j < 4; ++j) { \
            const int c = 4 * lane + 256 * j; \
            if (MODE == 2) { f32x4 o; \
                _Pragma("unroll") for (int e = 0; e < 4; ++e) o[e] = v[Q][j][e] * rinv * A[j][e]; \
                __builtin_nontemporal_store(o, (f32x4*)(p.out + (size_t)r * 1024 + c)); \
            } else { float h[4]; \
                _Pragma("unroll") for (int e = 0; e < 4; ++e) h[e] = (v[Q][j][e] * rinv) * A[j][e] + B[j][e]; \
                u32x2 w; w.x = pk2(h[0], h[1]); w.y = pk2(h[2], h[3]); \
                *(u32x2*)(H + (size_t)r * 1024 + c) = w; } \
        } \
        r += rstep; }
    while (true) { MP_STEP(0) MP_STEP(1) }
#undef MP_STEP
#undef MP_SRC
#undef MP_ISSUE
}

typedef __bf16 bf2_t __attribute__((ext_vector_type(2)));
__device__ __forceinline__ float dot2bf(uint32_t a, uint32_t b, float c) { return __builtin_amdgcn_fdot2_f32_bf16(__builtin_bit_cast(bf2_t, a), __builtin_bit_cast(bf2_t, b), c, false); }
__device__ __forceinline__ void phase_ffn_route(const Params& p, char* smem, int layer, int nrows, int wg, int nwg) {
    const int tid = ltid(), lane = tid & 63, wv = __builtin_amdgcn_readfirstlane(tid >> 6);
    const float* RES = WSP(float, OFF_RES); const float* mod = WSP(float, OFF_MOD); bf16_t* H = WSP(bf16_t, OFF_HREG);
    int* cnt = WSP(int, OFF_CNT) + layer * 32; int* routei = WSP(int, OFF_ROUTEI); float* routeg = WSP(float, OFF_ROUTEG); int* tokl = WSP(int, OFF_TOKL);
    {
        const u32x4* RT = (const u32x4*)(p.ws + OFF_WTS + W_RW) + (size_t)layer * 4608;
        for (int q = tid; q < 4608; q += 256) *(u32x4*)(smem + q * 16) = RT[q];
        if (tid < 32) ((float*)(smem + SM_TAB))[tid] = p.router_f_b[layer * 32 + tid];
    }
    __syncthreads();
    const float* gn = p.norm_ffn + layer * 1024;
    const bool hi32 = (lane & 32) != 0, hi16 = (lane & 16) != 0, hi8 = (lane & 8) != 0;
    const float cb0 = p.router_c_b[layer * 4 + 0], cb1 = p.router_c_b[layer * 4 + 1], cb2 = p.router_c_b[layer * 4 + 2], cb3 = p.router_c_b[layer * 4 + 3];
    int it = 0, sx1 = 0, sx2 = 0, sr = 0; float sga = 0.f, sgb = 0.f;
    auto flush = [&](int n) {
        if (lane < n) {
            const int p1 = atomicAdd(&cnt[sx1], 1), p2 = atomicAdd(&cnt[sx2], 1);
            tokl[(size_t)sx1 * TOKCAP + p1] = sr; tokl[(size_t)sx2 * TOKCAP + p2] = sr;
            routei[2 * sr] = (p1 << 5) | sx1; routei[2 * sr + 1] = (p2 << 5) | sx2; routeg[2 * sr] = sga; routeg[2 * sr + 1] = sgb;
        }
    };
    f32x4 A[4], B[4]; int mbc = -1;
    int r = wg * 4 + wv;
    const int rstep = nwg * 4;
    if (r >= nrows) return;
    const int rlast = nrows - 1;
    f32x4 vv[3][4];
#pragma unroll
    for (int j = 0; j < 4; ++j) vv[0][j] = __builtin_nontemporal_load((const f32x4*)(RES + (size_t)r * 1024 + 4 * lane + 256 * j));
#pragma unroll
    for (int j = 0; j < 4; ++j) vv[1][j] = __builtin_nontemporal_load((const f32x4*)(RES + (size_t)min(r + rstep, rlast) * 1024 + 4 * lane + 256 * j));
    while (r < nrows) {
#pragma unroll
      for (int P = 0; P < 3; ++P) {
        if (r >= nrows) break;
        const int mb = r < NL ? (r >> 13) : 4;
        if (mb != mbc) { mbc = mb;
            const float* sh = mod + (size_t)(mb * 4 + layer) * 6144 + 3 * 1024; const float* sc = sh + 1024;
#pragma unroll
            for (int j = 0; j < 4; ++j) { const int c = 4 * lane + 256 * j; const f32x4 g = *(const f32x4*)(gn + c), s1 = *(const f32x4*)(sh + c), s2 = *(const f32x4*)(sc + c);
#pragma unroll
                for (int e = 0; e < 4; ++e) { A[j][e] = g[e] * (1.f + s2[e]); B[j][e] = s1[e]; } }
        }
        const int rn = min(r + 2 * rstep, rlast);
#pragma unroll
        for (int j = 0; j < 4; ++j) vv[(P + 2) % 3][j] = __builtin_nontemporal_load((const f32x4*)(RES + (size_t)rn * 1024 + 4 * lane + 256 * j));
        f32x4 (&v)[4] = vv[P];
        __builtin_amdgcn_sched_barrier(0);
        float ss = 0.f;
#pragma unroll
        for (int j = 0; j < 4; ++j) ss += (v[j][0] * v[j][0] + v[j][1] * v[j][1]) + (v[j][2] * v[j][2] + v[j][3] * v[j][3]);
        ss = wave_sum(ss);
        const float rinv = frsq(ss * (1.f / 1024.f) + 1e-6f);
        uint32_t hp[8];
#pragma unroll
        for (int j = 0; j < 4; ++j) {
            float h[4];
#pragma unroll
            for (int e = 0; e < 4; ++e) h[e] = (v[j][e] * rinv) * A[j][e] + B[j][e];
            u32x2 w; w.x = pk2(h[0], h[1]); w.y = pk2(h[2], h[3]); hp[2 * j] = w.x; hp[2 * j + 1] = w.y;
            *(u32x2*)(H + (size_t)r * 1024 + 4 * lane + 256 * j) = w;
        }
        float c0 = 0.f, c1 = 0.f, c2 = 0.f, c3 = 0.f;
#pragma unroll
        for (int pp = 0; pp < 8; ++pp) { const u32x4 w = *(const u32x4*)(smem + 65536 + (pp * 64 + lane) * 16);
            c0 = dot2bf(hp[pp], w[0], c0); c1 = dot2bf(hp[pp], w[1], c1); c2 = dot2bf(hp[pp], w[2], c2); c3 = dot2bf(hp[pp], w[3], c3); }
        float m;
        { const float t0 = hi32 ? c0 : c2, t1 = hi32 ? c1 : c3;
          const float k0 = (hi32 ? c2 : c0) + __shfl_xor(t0, 32), k1 = (hi32 ? c3 : c1) + __shfl_xor(t1, 32);
          const float t = hi16 ? k0 : k1; m = (hi16 ? k1 : k0) + __shfl_xor(t, 16);
          m = sum16(m); }
        const float q0 = rl_(m, 0) + cb0, q1 = rl_(m, 16) + cb1, q2 = rl_(m, 32) + cb2, q3 = rl_(m, 48) + cb3;
        int gi = 0; float mx = q0;
        if (q1 > mx) { mx = q1; gi = 1; } if (q2 > mx) { mx = q2; gi = 2; } if (q3 > mx) { mx = q3; gi = 3; }
        const float gval = frcp(fexp(q0 - mx) + fexp(q1 - mx) + fexp(q2 - mx) + fexp(q3 - mx));
        float f[8];
#pragma unroll
        for (int x = 0; x < 8; ++x) f[x] = 0.f;
        const char* ft = smem + gi * 16384 + lane * 16;
#pragma unroll
        for (int pp = 0; pp < 8; ++pp)
#pragma unroll
            for (int hf = 0; hf < 2; ++hf) { const u32x4 w = *(const u32x4*)(ft + (pp * 2 + hf) * 1024);
#pragma unroll
                for (int x = 0; x < 4; ++x) f[hf * 4 + x] = dot2bf(hp[pp], w[x], f[hf * 4 + x]); }
        float n_;
        { float k[4];
#pragma unroll
          for (int x = 0; x < 4; ++x) { const float t = hi32 ? f[x] : f[x + 4]; k[x] = (hi32 ? f[x + 4] : f[x]) + __shfl_xor(t, 32); }
          float m2[2];
#pragma unroll
          for (int x = 0; x < 2; ++x) { const float t = hi16 ? k[x] : k[x + 2]; m2[x] = (hi16 ? k[x + 2] : k[x]) + __shfl_xor(t, 16); }
          const float t = hi8 ? m2[0] : m2[1]; n_ = (hi8 ? m2[1] : m2[0]) + __shfl_xor(t, 8);
          n_ = sum8(n_); }
        float lf[8]; float m1 = -3.0e38f, m2v = -3.0e38f; int e1 = 0, e2 = 0;
#pragma unroll
        for (int e = 0; e < 8; ++e) lf[e] = rl_(n_, 8 * e) + ((const float*)(smem + SM_TAB))[gi * 8 + e];
#pragma unroll
        for (int e = 0; e < 8; ++e) if (lf[e] > m1) { m1 = lf[e]; e1 = e; }
#pragma unroll
        for (int e = 0; e < 8; ++e) if (e != e1 && lf[e] > m2v) { m2v = lf[e]; e2 = e; }
        const float qq = fexp(m2v - m1), rq = frcp(1.f + qq);
        if (lane == it) { sx1 = gi * 8 + e1; sx2 = gi * 8 + e2; sga = gval * rq; sgb = gval * qq * rq; sr = r; }
        if (++it == 64) { flush(64); it = 0; }
        r += rstep;
      }
    }
    flush(it);
}

struct AShift { const bf16_t* H; const bf16_t* zero; int m0;
    __device__ __forceinline__ int info(int row) const {
        const int r = m0 + row; int bits, ctx;
        if (r < NL) { const int t = r & 8191, col = t & 63, rw = t >> 6; bits = (col > 0 ? 1 : 0) | (col < 63 ? 2 : 0) | (rw > 0 ? 4 : 0) | (rw < 127 ? 8 : 0); ctx = 0; }
        else { const int t = (r - NL) & 255; bits = (t > 0 ? 3 : 0) | (t < 255 ? 12 : 0); ctx = 1; }
        return r | (bits << 20) | (ctx << 24); }
    __device__ __forceinline__ const bf16_t* ptr(int inf, int, int k) const {
        const int gr = inf & 0xfffff;
        if (k < 1024) return H + (size_t)gr * 1024 + k;
        const int kk = k - 1024, q = kk >> 8; const bool ctx = (inf >> 24) & 1, ok = (inf >> (20 + q)) & 1;
        const int dl = ctx ? (q < 2 ? -1 : 1) : (q == 0 ? -1 : (q == 1 ? 1 : (q == 2 ? -64 : 64)));
        return ok ? H + (size_t)(gr + dl) * 1024 + kk : zero; } };

__device__ __forceinline__ void phase_e2(const Params& p, char* smem, int j, int nrows, int layer, int wg, int nwg) {
    const bf16_t* H = WSP(bf16_t, OFF_HREG); bf16_t* P = WSP(bf16_t, OFF_PREG); bf16_t* LR1 = WSP(bf16_t, OFF_LR1);
    const bf16_t* WIN = (const bf16_t*)(p.ws + OFF_WTS + W_WIN) + (size_t)j * 1024 * 2048;
    const bf16_t* WL1 = (const bf16_t*)(p.ws + OFF_WTS + W_LR1) + (size_t)j * 2048 * 384;
    const int nrt = nrows / 128, nlr = nrt * 3, ntot = nlr + nrt * 16;
    W2Conv cw{p.moe_w2 + (size_t)layer * 32 * 1024 * 512, WSP(bf16_t, OFF_W2), ntot / nwg, wg, nwg, {}};
    f32x4 acc[4][4];
    int it_ = 0;
    for (int t = wg; t < ntot; t += nwg, ++it_) {
        cw.load(it_);
        if (t >= nlr) {
            const int tp = t - nlr, mt = tp >> 4, nt = tp & 15, m0 = mt * 128, n0 = nt * 128;
            gemm_tile(smem, 16, APlain{H, 1024, m0}, BPlain{WIN + n0, 2048}, acc);
            EPI_FOR(acc, { st_bf4(P + (size_t)(m0 + row) * 2048 + n0 + col, v); });
        } else {
            const int u = t, mt = u / 3, nt = u % 3, m0 = mt * 128, n0 = nt * 128;
            gemm_tile(smem, 32, AShift{H, WSP(bf16_t, OFF_ZERO), m0}, BPlain{WL1 + n0, 384}, acc);
            EPI_FOR(acc, { f32x4 o;
                _Pragma("unroll") for (int e = 0; e < 4; ++e) { const float z = v[e]; o[e] = nt == 0 ? tanhf_(z) : (nt == 1 ? z : sigmoidf_(z)); }
                st_bf4(LR1 + (size_t)(m0 + row) * 384 + n0 + col, o); });
        }
        cw.store(it_);
    }
}

__device__ __forceinline__ void phase_e3(const Params& p, int j, int nrows, int wg, int nwg) {
    const int lane = ltid() & 63, wv = ltid() >> 6;
    const bf16_t* P = WSP(bf16_t, OFF_PREG);
    bf16_t* R = WSP(bf16_t, OFF_RKVK); bf16_t* K = R + (size_t)NT * 512; bf16_t* V = K + (size_t)NT * 512; bf16_t* KK = V + (size_t)NT * 512;
    bf16_t* DIFF = WSP(bf16_t, OFF_DIFF);
    const int c = 8 * lane, q = lane >> 4;
    for (int r = wg * 4 + wv; r < nrows; r += nwg * 4) {
        const int s = shift_src(r, q); const int sc = s >= 0 ? s : r;
        int t, T, base;
        if (r < NL) { t = r & 8191; T = 8192; base = r - t; } else { t = (r - NL) & 255; T = 256; base = r - t; }
        const int half = 1 << q; const int lo = max(t - half, 0), hi = min(t + half, T);
        u32x4 pa_[3], pb_[3];
#pragma unroll
        for (int n = 0; n < 3; ++n) { pa_[n] = *(const u32x4*)(P + (size_t)r * 2048 + n * 512 + c); pb_[n] = *(const u32x4*)(P + (size_t)sc * 2048 + n * 512 + c); }
        u32x4 wv_[16];
#pragma unroll
        for (int i = 0; i < 16; ++i) { const int tt = t + i - 8; const bool ok = tt >= lo && tt < hi; wv_[i] = *(const u32x4*)(P + (size_t)(base + (ok ? tt : t)) * 2048 + 1536 + c); }
        const u32x4 u = *(const u32x4*)(P + (size_t)r * 2048 + 1536 + c);
        __builtin_amdgcn_sched_barrier(0);
        float val[3][8];
#pragma unroll
        for (int n = 0; n < 3; ++n) {
            const u32x4 a = pa_[n]; u32x4 b = pb_[n];
            if (s < 0) b = (u32x4){0u, 0u, 0u, 0u};
            const f32x4 m0 = *(const f32x4*)(p.mu_p + (size_t)(j * 3 + n) * 512 + c), m1 = *(const f32x4*)(p.mu_p + (size_t)(j * 3 + n) * 512 + c + 4);
#pragma unroll
            for (int e = 0; e < 4; ++e) {
                const float pa0 = bflo(a[e]), pa1 = bfhi(a[e]), pb0 = bflo(b[e]), pb1 = bfhi(b[e]);
                const float mu0 = (2 * e < 4) ? m0[2 * e] : m1[2 * e - 4], mu1 = (2 * e + 1 < 4) ? m0[2 * e + 1] : m1[2 * e + 1 - 4];
                val[n][2 * e] = pa0 + (pb0 - pa0) * mu0; val[n][2 * e + 1] = pa1 + (pb1 - pa1) * mu1;
            }
        }
        const f32x4 kk0 = *(const f32x4*)(p.k_k + j * 512 + c), kk1 = *(const f32x4*)(p.k_k + j * 512 + c + 4);
        float kkv[8]; float ss = 0.f;
#pragma unroll
        for (int e = 0; e < 8; ++e) { kkv[e] = val[1][e] * (e < 4 ? kk0[e] : kk1[e - 4]); ss += kkv[e] * kkv[e]; }
        ss += __shfl_xor(ss, 1); ss += __shfl_xor(ss, 2); ss += __shfl_xor(ss, 4);
        const float rn = frsq(fmaxf(ss, 1e-12f));
        u32x4 o;
#pragma unroll
        for (int e = 0; e < 4; ++e) o[e] = pk2(val[0][2 * e], val[0][2 * e + 1]);
        *(u32x4*)(R + (size_t)r * 512 + c) = o;
#pragma unroll
        for (int e = 0; e < 4; ++e) o[e] = pk2(val[1][2 * e], val[1][2 * e + 1]);
        *(u32x4*)(K + (size_t)r * 512 + c) = o;
#pragma unroll
        for (int e = 0; e < 4; ++e) o[e] = pk2(val[2][2 * e], val[2][2 * e + 1]);
        *(u32x4*)(V + (size_t)r * 512 + c) = o;
        (void)kkv; (void)rn;
        float sum[8];
#pragma unroll
        for (int e = 0; e < 8; ++e) sum[e] = 0.f;
#pragma unroll
        for (int i = 0; i < 16; ++i) { const int tt = t + i - 8; const bool ok = tt >= lo && tt < hi;
#pragma unroll
            for (int e = 0; e < 4; ++e) { sum[2 * e] += ok ? bflo(wv_[i][e]) : 0.f; sum[2 * e + 1] += ok ? bfhi(wv_[i][e]) : 0.f; } }
        const float inv = 1.0f / (float)(hi - lo);
#pragma unroll
        for (int e = 0; e < 4; ++e) o[e] = pk2(sum[2 * e] * inv - bflo(u[e]), sum[2 * e + 1] * inv - bfhi(u[e]));
        *(u32x4*)(DIFF + (size_t)r * 512 + c) = o;
    }
}

__device__ __forceinline__ void phase_e4(const Params& p, char* smem, int j, int nrows, int part, int wg, int nwg) {
    const bf16_t* LR1 = WSP(bf16_t, OFF_LR1); const bf16_t* DIFF = WSP(bf16_t, OFF_DIFF);
    const bf16_t* K = WSP(bf16_t, OFF_RKVK) + (size_t)NT * 512; const bf16_t* KK = WSP(bf16_t, OFF_RKVK) + (size_t)3 * NT * 512;
    float* W = WSP(float, OFF_WREG); bf16_t* KD = WSP(bf16_t, OFF_KD); bf16_t* BB = WSP(bf16_t, OFF_BB); bf16_t* G = WSP(bf16_t, OFF_G); bf16_t* YAB = WSP(bf16_t, OFF_HREG);
    const bf16_t* WL2 = (const bf16_t*)(p.ws + OFF_WTS + W_LR2) + (size_t)j * 384 * 512;
    const bf16_t* WP = (const bf16_t*)(p.ws + OFF_WTS + W_POOL) + (size_t)j * 512 * 128;
    const int nrt = nrows / 128, nlr = nrt * (part == 0 ? 16 : 4), ntot = nlr + (part == 1 ? nrt * 4 : 0);
    f32x4 acc[4][4];
    for (int t = wg; t < ntot; t += nwg) {
        if (t < nlr) {
            const int mt = part == 0 ? t >> 4 : t >> 2, u = part == 0 ? (t & 15) : 16 + (t & 3), ob = u >> 2, n4 = u & 3, m0 = mt * 128, n0 = n4 * 128;
            const int koff = ob < 4 ? ob * 64 : 256, nk = ob < 4 ? 1 : 2;
            gemm_tile(smem, nk, APlain{LR1 + koff, 384, m0}, BPlain{WL2 + (size_t)koff * 512 + n0, 512}, acc);
            if (ob < 2) {
                const float* w0 = p.decay_w0 + (size_t)(j * 2 + ob) * 512 + n0;
                EPI_FOR(acc, { const f32x4 b0 = *(const f32x4*)(w0 + col); f32x4 o;
                    _Pragma("unroll") for (int e = 0; e < 4; ++e) o[e] = v[e] + b0[e];
                    st_bf4(KD + ((size_t)ob * NT + m0 + row) * 512 + n0 + col, o); });
            } else if (ob < 4) {
                const int d = ob - 2; const float* a0 = p.lr_a0 + (size_t)(j * 2 + d) * 512 + n0;
                EPI_FOR(acc, { const f32x4 b0 = *(const f32x4*)(a0 + col); f32x4 o;
                    _Pragma("unroll") for (int e = 0; e < 4; ++e) o[e] = sigmoidf_(v[e] + b0[e]);
                    st_bf4(BB + ((size_t)d * NT + m0 + row) * 512 + n0 + col, o); });
            } else {
                EPI_FOR(acc, { st_bf4(G + (size_t)(m0 + row) * 512 + n0 + col, v); });
            }
        } else {
            const int u = t - nlr, mt = u >> 2, g = u & 3, m0 = mt * 128;
            gemm_tile(smem, 2, APlain{DIFF + g * 128, 512, m0}, BPlain{WP + (size_t)g * 128 * 128, 128}, acc);
            const float* ps = p.pool_scale + (size_t)j * 512 + g * 128;
            EPI_FOR(acc, { const f32x4 s = *(const f32x4*)(ps + col); f32x4 o; o[0] = v[0] * s[0]; o[1] = v[1] * s[1]; o[2] = v[2] * s[2]; o[3] = v[3] * s[3];
                st_bf4(YAB + (size_t)(m0 + row) * 1024 + 512 + g * 128 + col, o); });
        }
    }
}

template <int VAR> __device__ __forceinline__ void phase_scan(const Params&, char*, int, int) {}
template <int CTRL> __device__ __forceinline__ float dpp_mov(float x) { return __builtin_bit_cast(float, __builtin_amdgcn_mov_dpp(__builtin_bit_cast(int, x), CTRL, 0xf, 0xf, true)); }
typedef float f32x2v __attribute__((ext_vector_type(2)));

#define CK_C 32
#define CK_NCH 264
#define CK_P 144
#define CK_PG 80
#define CK_G 0
#define CK_TOT 8192
#define CK_AT 9216
#define CK_BT (CK_AT + 4608)
#define CK_KT (CK_BT + 4608)
#define CK_RT (CK_KT + 4608)
#define CK_VC (CK_RT + 4608)
#define CK_T (CK_VC + 4608)
#define CK_MAK (CK_T + 2560)
#define CK_NRB (CK_MAK + 2560)
#define CK_NRK (CK_NRB + 2560)
#define CK_P1 (CK_NRK + 2560)
#define CK_W1 (CK_P1 + 4608)
#define CK_W2 (CK_W1 + 4608)
#define CK_TF (CK_W2 + 4608)
#define CK_END (CK_TF + 32 * 144)
static_assert(CK_END <= SM_BAR, "chunk LDS map");
constexpr size_t OFF_AD0 = MBY(869);
__device__ __forceinline__ size_t off_qy(int d) { return OFF_PREG + (size_t)d * MBY(66); }
__device__ __forceinline__ size_t off_ad(int d) { return d ? OFF_WREG : OFF_AD0; }

__device__ __forceinline__ bf16x8 frag_rows(const char* img, int pitch, int r0, int k0, int lane) {
    return *(const bf16x8*)(img + (r0 + (lane & 15)) * pitch + (k0 + 8 * (lane >> 4)) * 2);
}
__device__ __forceinline__ bf16x8 frag_cols(const char* img, int pitch, int k0, int c0, int lane) {
    const char* a = img + (k0 + 8 * (lane >> 4) + ((lane & 15) >> 2)) * pitch + (c0 + 4 * (lane & 3)) * 2;
    const s16x4 lo = __builtin_amdgcn_ds_read_tr16_b64_v4i16((LAS s16x4*)a), hi = __builtin_amdgcn_ds_read_tr16_b64_v4i16((LAS s16x4*)(a + 4 * pitch));
    return __builtin_shufflevector(lo, hi, 0, 1, 2, 3, 4, 5, 6, 7);
}
#define MFMA16(acc, afrag, bfrag) acc = __builtin_amdgcn_mfma_f32_16x16x32_bf16(bfrag, afrag, acc, 0, 0, 0)

__device__ __forceinline__ void phase_s1(const Params& p, char* smem, int jl, int d, int wg0, int nwg0) {
    const int tid = ltid(), lane = tid & 63, wv = tid >> 6;
    const bf16_t* R = WSP(bf16_t, OFF_RKVK); const bf16_t* V = R + (size_t)2 * NT * 512; const bf16_t* KK = R + (size_t)3 * NT * 512;
    const bf16_t* Kp = R + (size_t)NT * 512; const bf16_t* KD = WSP(bf16_t, OFF_KD) + (size_t)d * NT * 512; const bf16_t* BB = WSP(bf16_t, OFF_BB) + (size_t)d * NT * 512;
    bf16_t* QY = WSP(bf16_t, off_qy(d)); bf16_t* AD = WSP(bf16_t, off_ad(d));
    const int li = tid >> 3, c8 = (tid & 7) * 8;
    const int dir = d ? -1 : 1;
    const int ntask = 32 * CK_NCH;
    u32x4 lr, ld, lb, lv, lz;
    auto gl = [&](int task) {
        const int cd = task / CK_NCH, n = task - cd * CK_NCH, b = cd >> 3, h = cd & 7, s0 = n * CK_C;
        const int r0 = s0 < 256 ? NL + b * 256 + (d ? 255 - s0 : s0) : b * 8192 + (d ? 8191 - (s0 - 256) : (s0 - 256));
        const size_t ro = (size_t)(r0 + dir * li) * 512 + h * 64 + c8;
        lr = *(const GAS u32x4*)(R + ro); ld = *(const GAS u32x4*)(Kp + ro); lb = *(const GAS u32x4*)(BB + ro); lv = *(const GAS u32x4*)(V + ro);
        lz = __builtin_nontemporal_load((const GAS u32x4*)(KD + ro));
    };
    int task = wg0;
    if (task < ntask) gl(task);
    for (; task < ntask; task += nwg0) {
        const int cd = task / CK_NCH, n = task - cd * CK_NCH;
        float* G = (float*)(smem + CK_G); float* TOT = (float*)(smem + CK_TOT); float* TF = (float*)(smem + CK_TF);
        __syncthreads();
        {
            f32x4 w0_, w1_;
#pragma unroll
            for (int e = 0; e < 2; ++e) { w0_[2 * e] = fexp(-0.60653065971f * sigmoidf_(bflo(lz[e]))); w0_[2 * e + 1] = fexp(-0.60653065971f * sigmoidf_(bfhi(lz[e])));
                                          w1_[2 * e] = fexp(-0.60653065971f * sigmoidf_(bflo(lz[2 + e]))); w1_[2 * e + 1] = fexp(-0.60653065971f * sigmoidf_(bfhi(lz[2 + e]))); }
            *(f32x4*)(G + li * 64 + c8) = w0_; *(f32x4*)(G + li * 64 + c8 + 4) = w1_;
        }
        const u32x4 xr = lr, xd = ld, xb = lb, xv = lv;
        const int hh = (task / CK_NCH) & 7;
        const f32x4 ka0 = *(const f32x4*)(p.k_a + (size_t)jl * 512 + hh * 64 + c8), ka1 = *(const f32x4*)(p.k_a + (size_t)jl * 512 + hh * 64 + c8 + 4);
        if (task + nwg0 < ntask) gl(task + nwg0);
        __builtin_amdgcn_sched_barrier(0);
        __syncthreads();
        {
            const int c = tid & 63, q = tid >> 6; float pr = 1.f;
#pragma unroll
            for (int j = 0; j < 8; ++j) { pr *= G[(8 * q + j) * 64 + c]; G[(8 * q + j) * 64 + c] = pr; }
            TOT[q * 64 + c] = pr;
            __syncthreads();
            float pre = 1.f;
            if (q > 0) pre = TOT[c]; if (q > 1) pre *= TOT[64 + c]; if (q > 2) pre *= TOT[128 + c];
#pragma unroll
            for (int j = 0; j < 8; ++j) G[(8 * q + j) * 64 + c] *= pre;
        }
        __syncthreads();
        {
            float g[8], gm[8];
            { const f32x4 a0 = *(const f32x4*)(G + li * 64 + c8), a1 = *(const f32x4*)(G + li * 64 + c8 + 4);
#pragma unroll
              for (int e = 0; e < 4; ++e) { g[e] = a0[e]; g[4 + e] = a1[e]; } }
            if (li > 0) { const f32x4 a0 = *(const f32x4*)(G + (li - 1) * 64 + c8), a1 = *(const f32x4*)(G + (li - 1) * 64 + c8 + 4);
#pragma unroll
              for (int e = 0; e < 4; ++e) { gm[e] = a0[e]; gm[4 + e] = a1[e]; } }
            else {
#pragma unroll
              for (int e = 0; e < 8; ++e) gm[e] = 1.f; }
            float kkf[8];
            { const f32x4 q0 = *(const f32x4*)(p.k_k + (size_t)jl * 512 + hh * 64 + c8), q1 = *(const f32x4*)(p.k_k + (size_t)jl * 512 + hh * 64 + c8 + 4); float ss = 0.f;
#pragma unroll
              for (int e = 0; e < 4; ++e) { kkf[2 * e] = bflo(xd[e]) * ((2 * e < 4) ? q0[2 * e] : q1[2 * e - 4]); kkf[2 * e + 1] = bfhi(xd[e]) * ((2 * e + 1 < 4) ? q0[2 * e + 1] : q1[2 * e + 1 - 4]); }
#pragma unroll
              for (int e = 0; e < 8; ++e) ss += kkf[e] * kkf[e];
              ss = sum8(ss);
              const float rn = frsq(fmaxf(ss, 1e-12f));
#pragma unroll
              for (int e = 0; e < 8; ++e) kkf[e] *= rn; }
            u32x4 oa, ob, ok, orr;
#pragma unroll
            for (int e = 0; e < 4; ++e) {
                const float i0 = frcp(g[2 * e]), i1 = frcp(g[2 * e + 1]);
                oa[e] = pk2(-kkf[2 * e] * gm[2 * e], -kkf[2 * e + 1] * gm[2 * e + 1]);
                const float al0 = bflo(xb[e]), al1 = bfhi(xb[e]);
                const float kav0 = (2 * e < 4) ? ka0[2 * e] : ka1[2 * e - 4], kav1 = (2 * e + 1 < 4) ? ka0[2 * e + 1] : ka1[2 * e + 1 - 4];
                ob[e] = pk2(kkf[2 * e] * al0 * i0, kkf[2 * e + 1] * al1 * i1);
                ok[e] = pk2(bflo(xd[e]) * (1.f + (al0 - 1.f) * kav0) * i0, bfhi(xd[e]) * (1.f + (al1 - 1.f) * kav1) * i1);
                orr[e] = pk2(bflo(xr[e]) * g[2 * e], bfhi(xr[e]) * g[2 * e + 1]);
            }
            const int o = li * CK_P + c8 * 2;
            *(u32x4*)(smem + CK_AT + o) = oa; *(u32x4*)(smem + CK_BT + o) = ob; *(u32x4*)(smem + CK_KT + o) = ok; *(u32x4*)(smem + CK_RT + o) = orr; *(u32x4*)(smem + CK_VC + o) = xv;
        }
        __syncthreads();
        {
            const int mt = wv >> 1, nt = wv & 1;
            f32x4 aab = {0.f, 0.f, 0.f, 0.f}, aak = aab, arb = aab, ark = aab;
#pragma unroll
            for (int ks = 0; ks < 2; ++ks) {
                const bf16x8 fa = frag_rows(smem + CK_AT, CK_P, mt * 16, ks * 32, lane), fr = frag_rows(smem + CK_RT, CK_P, mt * 16, ks * 32, lane);
                const bf16x8 fb = frag_rows(smem + CK_BT, CK_P, nt * 16, ks * 32, lane), fk = frag_rows(smem + CK_KT, CK_P, nt * 16, ks * 32, lane);
                MFMA16(aab, fa, fb); MFMA16(aak, fa, fk); MFMA16(arb, fr, fb); MFMA16(ark, fr, fk);
            }
            const int m = mt * 16 + (lane & 15), n0 = nt * 16 + 4 * (lane >> 4);
            f32x4 o1, o2, o3, o4;
#pragma unroll
            for (int e = 0; e < 4; ++e) { const int nn = n0 + e; o1[e] = nn < m ? aab[e] : 0.f; o2[e] = nn < m ? aak[e] : 0.f; o3[e] = nn <= m ? arb[e] : 0.f; o4[e] = nn <= m ? ark[e] : 0.f; }
            *(f32x4*)(TF + m * 36 + n0) = o1;
            st_bf4((bf16_t*)(smem + CK_MAK + m * CK_PG) + n0, o2); st_bf4((bf16_t*)(smem + CK_NRB + m * CK_PG) + n0, o3); st_bf4((bf16_t*)(smem + CK_NRK + m * CK_PG) + n0, o4);
        }
        __syncthreads();
        if (wv == 0) {
            const int c = lane & 31; float Tc[32];
#pragma unroll
            for (int t = 0; t < 32; ++t) {
                float a0 = (c == t) ? 1.f : 0.f, a1 = 0.f, a2 = 0.f, a3 = 0.f;
#pragma unroll
                for (int j4 = 0; j4 < (t + 3) / 4; ++j4) {
                    const f32x4 mrow = *(const f32x4*)(TF + t * 36 + j4 * 4);
                    if (j4 * 4 + 0 < t) a0 += mrow[0] * Tc[j4 * 4 + 0];
                    if (j4 * 4 + 1 < t) a1 += mrow[1] * Tc[j4 * 4 + 1];
                    if (j4 * 4 + 2 < t) a2 += mrow[2] * Tc[j4 * 4 + 2];
                    if (j4 * 4 + 3 < t) a3 += mrow[3] * Tc[j4 * 4 + 3];
                }
                Tc[t] = (a0 + a1) + (a2 + a3);
                if (lane < 32) ((bf16_t*)(smem + CK_T + t * CK_PG))[c] = f2bf(Tc[t]);
            }
        } else {
            for (int tl = wv - 1; tl < 8; tl += 3) {
                const int mt = tl >> 2, nt = tl & 3; f32x4 acc = {0.f, 0.f, 0.f, 0.f};
                MFMA16(acc, frag_rows(smem + CK_MAK, CK_PG, mt * 16, 0, lane), frag_cols(smem + CK_VC, CK_P, 0, nt * 16, lane));
                st_bf4((bf16_t*)(smem + CK_P1 + (mt * 16 + (lane & 15)) * CK_P) + nt * 16 + 4 * (lane >> 4), acc);
            }
        }
        __syncthreads();
#pragma unroll
        for (int u = 0; u < 4; ++u) {
            const int tl = wv * 4 + u, which = tl >> 3, mt = (tl >> 2) & 1, nt = tl & 3; f32x4 acc = {0.f, 0.f, 0.f, 0.f};
            MFMA16(acc, frag_rows(smem + CK_T, CK_PG, mt * 16, 0, lane), frag_cols(smem + (which ? CK_P1 : CK_AT), CK_P, 0, nt * 16, lane));
            st_bf4((bf16_t*)(smem + (which ? CK_W2 : CK_W1) + (mt * 16 + (lane & 15)) * CK_P) + nt * 16 + 4 * (lane >> 4), acc);
        }
        __syncthreads();
        {
            bf16_t* qrec = QY + (size_t)task * 4096; bf16_t* arec = AD + (size_t)task * 8192;
#pragma unroll
            for (int u = 0; u < 2; ++u) {
                const int tl = wv * 2 + u, mt = tl >> 2, nt = tl & 3, m = mt * 16 + (lane & 15), n0 = nt * 16 + 4 * (lane >> 4);
                const bf16x8 fnb = frag_rows(smem + CK_NRB, CK_PG, mt * 16, 0, lane), fnk = frag_rows(smem + CK_NRK, CK_PG, mt * 16, 0, lane);
                f32x4 aq = {0.f, 0.f, 0.f, 0.f}, ay = aq;
                MFMA16(aq, fnb, frag_cols(smem + CK_W1, CK_P, 0, nt * 16, lane));
                MFMA16(ay, fnb, frag_cols(smem + CK_W2, CK_P, 0, nt * 16, lane)); MFMA16(ay, fnk, frag_cols(smem + CK_VC, CK_P, 0, nt * 16, lane));
                const u32x2 rt = *(const u32x2*)(smem + CK_RT + m * CK_P + n0 * 2);
                aq[0] += bflo(rt.x); aq[1] += bfhi(rt.x); aq[2] += bflo(rt.y); aq[3] += bfhi(rt.y);
                st_bf4(qrec + ((m >> 4) * 2 + (n0 >> 5)) * 512 + (((n0 >> 3) & 3) * 16 + (m & 15)) * 8 + (n0 & 7), aq);
                st_bf4(qrec + 2048 + m * 64 + n0, ay);
            }
            const float* gC = G + 31 * 64;
#pragma unroll
            for (int u = 0; u < 4; ++u) {
                const int tl = wv * 4 + u, mt = tl >> 2, nt = tl & 3, m = mt * 16 + (lane & 15), n0 = nt * 16 + 4 * (lane >> 4);
                const bf16x8 fbt = frag_cols(smem + CK_BT, CK_P, 0, mt * 16, lane), fkt = frag_cols(smem + CK_KT, CK_P, 0, mt * 16, lane);
                f32x4 aa = {0.f, 0.f, 0.f, 0.f}, ad = aa;
                MFMA16(aa, fbt, frag_cols(smem + CK_W1, CK_P, 0, nt * 16, lane));
                MFMA16(ad, fbt, frag_cols(smem + CK_W2, CK_P, 0, nt * 16, lane)); MFMA16(ad, fkt, frag_cols(smem + CK_VC, CK_P, 0, nt * 16, lane));
                const float gm_ = gC[m];
#pragma unroll
                for (int e = 0; e < 4; ++e) { aa[e] = (aa[e] + ((n0 + e) == m ? 1.f : 0.f)) * gm_; ad[e] *= gm_; }
                st_bf4(arec + ((m >> 4) * 2 + (n0 >> 5)) * 512 + (((n0 >> 3) & 3) * 16 + (m & 15)) * 8 + (n0 & 7), aa);
                st_bf4(arec + 4096 + (((n0 >> 4) * 4 + (m >> 4)) * 64 + ((n0 & 15) >> 2) * 16 + (m & 15)) * 4, ad);
            }
        }
    }
}

__device__ __forceinline__ void phase_s2(const Params& p, char* smem, int d, int wg, int nwg) {
    const int tid = ltid(), lane = tid & 63, wv = tid >> 6;
    bf16_t* QY = WSP(bf16_t, off_qy(d)); const bf16_t* AD = WSP(bf16_t, off_ad(d));
    const int m15 = lane & 15, g4 = lane >> 4;
    if (wv != 0) return;
    for (int t = wg; t < 128; t += nwg) {
        const int x = t & 7, yy = t >> 3, cd = x * 4 + (yy >> 2), sl = yy & 3;
        char* zt = smem;
#pragma unroll
        for (int mt = 0; mt < 4; ++mt) *(u32x2*)(zt + (mt * 16 + m15) * 48 + 8 * g4) = (u32x2){0u, 0u};
        bf16x8 fa[3][4][2], fq[3][2][2]; u32x2 dz[3][4], dy[3][2];
#define S2_LOAD(S, n_) do { \
            const bf16_t* qrec = QY + (size_t)(cd * CK_NCH + (n_)) * 4096; const bf16_t* arec = AD + (size_t)(cd * CK_NCH + (n_)) * 8192; \
            _Pragma("unroll") for (int mt = 0; mt < 4; ++mt) { \
                _Pragma("unroll") for (int ks = 0; ks < 2; ++ks) fa[S][mt][ks] = __builtin_nontemporal_load((const GAS bf16x8*)(arec + (mt * 2 + ks) * 512 + lane * 8)); \
                dz[S][mt] = __builtin_nontemporal_load((const GAS u32x2*)(arec + 4096 + ((sl * 4 + mt) * 64 + lane) * 4)); } \
            _Pragma("unroll") for (int mt = 0; mt < 2; ++mt) { \
                _Pragma("unroll") for (int ks = 0; ks < 2; ++ks) fq[S][mt][ks] = __builtin_nontemporal_load((const GAS bf16x8*)(qrec + (mt * 2 + ks) * 512 + lane * 8)); \
                dy[S][mt] = __builtin_nontemporal_load((const GAS u32x2*)(qrec + 2048 + (mt * 16 + m15) * 64 + sl * 16 + 4 * g4)); } } while (0)
        S2_LOAD(0, 0); S2_LOAD(1, 1);
        for (int nb = 0; nb < CK_NCH; nb += 3) {
#pragma unroll
          for (int P = 0; P < 3; ++P) {
            const int n = nb + P;
            if (n >= CK_NCH) break;
            S2_LOAD((P + 2) % 3, min(n + 2, CK_NCH - 1));
            bf16x8 (&ca)[4][2] = fa[P]; bf16x8 (&cq)[2][2] = fq[P]; u32x2 (&cz)[4] = dz[P]; u32x2 (&cy)[2] = dy[P];
            __builtin_amdgcn_sched_barrier(0);
            const bf16x8 z0 = frag_cols(zt, 48, 0, 0, lane), z1 = frag_cols(zt, 48, 32, 0, lane);
            f32x4 az[4], ay[2];
#pragma unroll
            for (int mt = 0; mt < 4; ++mt) { az[mt] = (f32x4){bflo(cz[mt].x), bfhi(cz[mt].x), bflo(cz[mt].y), bfhi(cz[mt].y)}; MFMA16(az[mt], ca[mt][0], z0); MFMA16(az[mt], ca[mt][1], z1); }
#pragma unroll
            for (int mt = 0; mt < 4; ++mt) { u32x2 w; w.x = pk2(az[mt][0], az[mt][1]); w.y = pk2(az[mt][2], az[mt][3]); *(u32x2*)(zt + (mt * 16 + m15) * 48 + 8 * g4) = w; }
            __builtin_amdgcn_sched_barrier(0);
#pragma unroll
            for (int mt = 0; mt < 2; ++mt) { ay[mt] = (f32x4){bflo(cy[mt].x), bfhi(cy[mt].x), bflo(cy[mt].y), bfhi(cy[mt].y)}; MFMA16(ay[mt], cq[mt][0], z0); MFMA16(ay[mt], cq[mt][1], z1); }
            { bf16_t* qrec = QY + (size_t)(cd * CK_NCH + n) * 4096;
#pragma unroll
              for (int mt = 0; mt < 2; ++mt) st_bf4(qrec + 2048 + (mt * 16 + m15) * 64 + sl * 16 + 4 * g4, ay[mt]); }
          }
        }
#undef S2_LOAD
    }
}

template <int YBF>
__device__ __forceinline__ void phase_post(const Params& p, int j, int nrows, int wg, int nwg) {
    const int tid = ltid(), lane = tid & 63, wv = __builtin_amdgcn_readfirstlane(tid >> 6);
    const float* Y = WSP(float, OFF_PREG);
    const bf16_t* R = WSP(bf16_t, OFF_RKVK); const bf16_t* V = R + (size_t)2 * NT * 512;
    const bf16_t* G = WSP(bf16_t, OFF_G); bf16_t* YAB = WSP(bf16_t, OFF_HREG); const bf16_t* AL = WSP(bf16_t, OFF_BB);
    const bf16_t* QY0 = WSP(bf16_t, off_qy(0)); const bf16_t* QY1 = WSP(bf16_t, off_qy(1));
    const int c = 8 * lane;
    static_assert(YBF != 0, "the output phase reads y from the chunk records (chunked state pass)"); (void)Y;
    f32x4 ka[2], rk[2], gw[2], gb[2];
#pragma unroll
    for (int h = 0; h < 2; ++h) { ka[h] = *(const f32x4*)(p.k_a + (size_t)j * 512 + c + 4 * h); rk[h] = *(const f32x4*)(p.r_k + (size_t)j * 512 + c + 4 * h);
        gw[h] = *(const f32x4*)(p.gn_w + (size_t)j * 512 + c + 4 * h); gb[h] = *(const f32x4*)(p.gn_b + (size_t)j * 512 + c + 4 * h); }
    const int rstep = nwg * 4, rlast = nrows - 1;
    int r = wg * 4 + wv;
    if (r >= nrows) return;
    u32x4 in[2][8];
#define PO_LOAD(S, rr) do { \
        const int hh = lane >> 3, v_ = (lane & 7) * 8; int bb_, tt_, s0_, s1_; \
        if ((rr) < NL) { bb_ = (rr) >> 13; tt_ = (rr) & 8191; s0_ = 256 + tt_; s1_ = 256 + 8191 - tt_; } else { bb_ = ((rr) - NL) >> 8; tt_ = ((rr) - NL) & 255; s0_ = tt_; s1_ = 255 - tt_; } \
        const int cd = bb_ * 8 + hh; \
        in[S][0] = __builtin_nontemporal_load((const u32x4*)(QY0 + (size_t)(cd * CK_NCH + (s0_ >> 5)) * 4096 + 2048 + (s0_ & 31) * 64 + v_)); \
        in[S][1] = __builtin_nontemporal_load((const u32x4*)(QY1 + (size_t)(cd * CK_NCH + (s1_ >> 5)) * 4096 + 2048 + (s1_ & 31) * 64 + v_)); \
        in[S][2] = __builtin_nontemporal_load((const u32x4*)(R + (size_t)(rr) * 512 + c)); in[S][3] = __builtin_nontemporal_load((const u32x4*)(V + (size_t)(rr) * 512 + c)); in[S][4] = __builtin_nontemporal_load((const u32x4*)(G + (size_t)(rr) * 512 + c)); \
        in[S][5] = __builtin_nontemporal_load((const u32x4*)(R + ((size_t)NT + (rr)) * 512 + c)); in[S][6] = __builtin_nontemporal_load((const u32x4*)(AL + (size_t)(rr) * 512 + c)); in[S][7] = __builtin_nontemporal_load((const u32x4*)(AL + ((size_t)NT + (rr)) * 512 + c)); } while (0)
    PO_LOAD(0, r);
    while (r < nrows) {
#pragma unroll
      for (int P = 0; P < 2; ++P) {
        if (r >= nrows) break;
        { const int rn = min(r + rstep, rlast); PO_LOAD(1 - P, rn); }
        __builtin_amdgcn_sched_barrier(0);
        const u32x4 a = in[P][0], bq = in[P][1], rr = in[P][2], vv = in[P][3], gg = in[P][4], kx = in[P][5], al0 = in[P][6], al1 = in[P][7];
        float y[8];
#pragma unroll
        for (int e = 0; e < 4; ++e) { y[2 * e] = bflo(a[e]) + bflo(bq[e]); y[2 * e + 1] = bfhi(a[e]) + bfhi(bq[e]); }
        float s = 0.f;
#pragma unroll
        for (int e = 0; e < 8; ++e) s += y[e];
        s = sum8(s);
        const float mu = s * (1.f / 64.f);
        float q = 0.f;
#pragma unroll
        for (int e = 0; e < 8; ++e) { const float dlt = y[e] - mu; q += dlt * dlt; }
        q = sum8(q);
        const float rstd = frsq(q * (1.f / 64.f) + 64e-5f);
        float dot = 0.f;
#pragma unroll
        for (int e = 0; e < 4; ++e) {
            const float kav0 = ka[(2 * e) >> 2][(2 * e) & 3], kav1 = ka[(2 * e + 1) >> 2][(2 * e + 1) & 3];
            dot += bflo(rr[e]) * (bflo(kx[e]) * (2.f + (bflo(al0[e]) + bflo(al1[e]) - 2.f) * kav0)) * rk[(2 * e) >> 2][(2 * e) & 3];
            dot += bfhi(rr[e]) * (bfhi(kx[e]) * (2.f + (bfhi(al0[e]) + bfhi(al1[e]) - 2.f) * kav1)) * rk[(2 * e + 1) >> 2][(2 * e + 1) & 3];
        }
        dot = sum8(dot);
        float o[8];
#pragma unroll
        for (int e = 0; e < 8; ++e) {
            const float vf = (e & 1) ? bfhi(vv[e >> 1]) : bflo(vv[e >> 1]), gf = (e & 1) ? bfhi(gg[e >> 1]) : bflo(gg[e >> 1]);
            o[e] = ((y[e] - mu) * rstd * gw[e >> 2][e & 3] + gb[e >> 2][e & 3] + dot * vf) * gf;
        }
        u32x4 w;
#pragma unroll
        for (int e = 0; e < 4; ++e) w[e] = pk2(o[2 * e], o[2 * e + 1]);
        *(u32x4*)(YAB + (size_t)r * 1024 + c) = w;
        r += rstep;
      }
    }
#undef PO_LOAD
}

template <int DRY = 0, bool CW = false>
__device__ __forceinline__ void phase_resgemm(const Params& p, char* smem, const bf16_t* A, const bf16_t* B, int layer, int nrows, int wg, int nwg) {
    float* RES = DRY ? WSP(float, OFF_DIFF) : WSP(float, OFF_RES); const float* mod = WSP(float, OFF_MOD);
    const int ntot = (nrows / 128) * 8;
    W2Conv cw{p.moe_w2 + (size_t)layer * 32 * 1024 * 512, WSP(bf16_t, OFF_W2), CW ? ntot / nwg : 0, wg, nwg, {}};
    f32x4 acc[4][4];
    int it_ = 0;
    for (int t = wg; t < ntot; t += nwg, ++it_) {
        const int mt = t >> 3, nt = t & 7, m0 = mt * 128, n0 = nt * 128;
        if (CW) cw.load(it_);
        gemm_tile(smem, 16, APlain{A, 1024, m0}, BPlain{B + n0, 1024}, acc);
        const int mb = m0 < NL ? (m0 >> 13) : 4;
        const float* g2 = mod + (size_t)(mb * 4 + layer) * 6144 + 2 * 1024 + n0;
        const float* rsrc = layer == 0 ? (m0 < NL ? p.x : p.ctx - (size_t)NL * 1024) : RES;
        EPI_FOR(acc, { float* rp = RES + (DRY ? (size_t)((m0 + row) & 4095) : (size_t)(m0 + row)) * 1024 + n0 + col; const f32x4 g = *(const f32x4*)(g2 + col); f32x4 o = __builtin_nontemporal_load((const f32x4*)(rsrc + (size_t)(m0 + row) * 1024 + n0 + col));
            o[0] += g[0] * v[0]; o[1] += g[1] * v[1]; o[2] += g[2] * v[2]; o[3] += g[3] * v[3]; *(f32x4*)rp = o; });
        if (CW) cw.store(it_);
    }
}

__device__ __forceinline__ void phase_f1(const Params& p, char* smem, int nrows, int wg, int nwg) {
    const bf16_t* H = WSP(bf16_t, OFF_HREG); bf16_t* Z = WSP(bf16_t, OFF_PREG); const bf16_t* DFTC = (const bf16_t*)(p.ws + OFF_WTS + W_DFTC);
    const int ntot = (nrows / 128) * 16;
    f32x4 acc[4][4];
    for (int t = wg; t < ntot; t += nwg) {
        const int mt = t >> 4, nt = t & 15, g = nt >> 2, cb = nt & 3, m0 = mt * 128;
        gemm_tile(smem, 4, APlain{H + g * 256, 1024, m0}, BPlain{DFTC + cb * 128, 512}, acc);
        EPI_FOR(acc, { st_bf4(Z + (size_t)(m0 + row) * 2048 + g * 512 + cb * 128 + col, v); });
    }
}
struct BZ { const bf16_t* Z; int rowbase, rstride, psh, off;
    __device__ __forceinline__ const bf16_t* ptr(int k, int n) const { const int part = k >> psh, idx = k & ((1 << psh) - 1); return Z + (size_t)(rowbase + idx * rstride) * 2048 + part * 256 + off + n; } };
__device__ __forceinline__ void phase_f2(const Params& p, char* smem, bool with_ctx, int wg, int nwg) {
    const bf16_t* Z = WSP(bf16_t, OFF_PREG); bf16_t* A1 = WSP(bf16_t, OFF_WREG); bf16_t* FO = WSP(bf16_t, OFF_RKVK);
    const bf16_t* TW = (const bf16_t*)(p.ws + OFF_WTS + W_TW); const bf16_t* CS256 = (const bf16_t*)(p.ws + OFF_WTS + W_CS256);
    const int nctx = with_ctx ? 64 : 0, ntot = 512 * 8 + nctx;
    f32x4 acc[4][4];
    for (int t = wg; t < ntot; t += nwg) {
        if (t >= nctx) {
            const int tl_ = t - nctx, bt = tl_ >> 3, nt = tl_ & 7, b = bt >> 7, t2 = bt & 127; const int ch0 = nt * 128, g = ch0 >> 8, cc = ch0 & 255;
            gemm_tile(smem, 2, APlain{TW + (size_t)t2 * 128 * 128, 128, 0}, BZ{Z, b * 8192 + t2, 128, 6, g * 512 + cc}, acc);
            EPI_FOR(acc, { const int pp = row >> 6, f1 = row & 63; st_bf4(A1 + ((((size_t)(b * 64 + f1) * 128 + t2) * 2 + pp) * 1024) + ch0 + col, v); });
        } else {
            const int u = t, b = u >> 4, mt = (u >> 3) & 1, nt = u & 7; const int ch0 = nt * 128, g = ch0 >> 8, cc = ch0 & 255;
            gemm_tile(smem, 8, APlain{CS256, 512, mt * 128}, BZ{Z, NL + b * 256, 1, 8, g * 512 + cc}, acc);
            EPI_FOR(acc, { f32x4 o; o[0] = v[0] * (1.f / 256.f); o[1] = v[1] * (1.f / 256.f); o[2] = v[2] * (1.f / 256.f); o[3] = v[3] * (1.f / 256.f);
                st_bf4(FO + (size_t)(NL + b * 256 + mt * 128 + row) * 1024 + ch0 + col, o); });
        }
    }
}
struct BA1 { const bf16_t* base; int off;
    __device__ __forceinline__ const bf16_t* ptr(int k, int n) const { const int part = k >> 7, t2 = k & 127; return base + (size_t)(t2 * 2 + part) * 1024 + off + n; } };
__device__ __forceinline__ void phase_f3(const Params& p, char* smem, int wg, int nwg) {
    const bf16_t* A1 = WSP(bf16_t, OFF_WREG); bf16_t* FO = WSP(bf16_t, OFF_RKVK); const bf16_t* CS128 = (const bf16_t*)(p.ws + OFF_WTS + W_CS128);
    f32x4 acc[4][4];
    const float scl = 0.000690533966f;
    for (int t = wg; t < 256 * 8; t += nwg) {
        const int bf_ = t >> 3, nt = t & 7, b = bf_ >> 6, f1 = bf_ & 63;
        gemm_tile(smem, 4, APlain{CS128, 256, 0}, BA1{A1 + (size_t)(b * 64 + f1) * 128 * 2 * 1024, nt * 128}, acc);
        EPI_FOR(acc, { f32x4 o; o[0] = v[0] * scl; o[1] = v[1] * scl; o[2] = v[2] * scl; o[3] = v[3] * scl;
            st_bf4(FO + (size_t)(b * 8192 + f1 + 64 * row) * 1024 + nt * 128 + col, o); });
    }
}

__device__ __forceinline__ void phase_f3_ring(const Params& p, char* smem, int wg, int nwg) {
    const int tid = ltid(), lane = tid & 63, wid = tid >> 6;
    const bf16_t* A1 = WSP(bf16_t, OFF_WREG); bf16_t* FO = WSP(bf16_t, OFF_RKVK); const bf16_t* CS128 = (const bf16_t*)(p.ws + OFF_WTS + W_CS128);
    const float scl = 0.000690533966f;
    const int ntot = 256 * 8;
    if (wg >= ntot) return;
    const int nmy = (ntot - wg + nwg - 1) / nwg, nsteps = nmy * 4;
    bf16x8 a[8][2];
#pragma unroll
    for (int ks = 0; ks < 8; ++ks)
#pragma unroll
        for (int mt = 0; mt < 2; ++mt) a[ks][mt] = *(const GAS bf16x8*)(CS128 + (size_t)(wid * 32 + mt * 16 + (lane & 15)) * 256 + ks * 32 + (lane >> 4) * 8);
    const int brow = tid >> 4, bnc = (((tid & 15) ^ bswz(brow)) << 3);
    const unsigned lds0 = (unsigned)__builtin_amdgcn_readfirstlane((int)((unsigned)(size_t)smem + (unsigned)(wid * 1024)));
    auto issueB = [&](int g) {
        g = min(g, nsteps - 1);
        const int t = wg + (g >> 2) * nwg, kt = g & 3, bf_ = t >> 3, nt = t & 7, b = bf_ >> 6, f1 = bf_ & 63;
        const bf16_t* base = A1 + (size_t)(b * 64 + f1) * 128 * 2 * 1024 + nt * 128;
#pragma unroll
        for (int q = 0; q < 4; ++q) { const int k = kt * 64 + brow + 16 * q, part = k >> 7, t2 = k & 127;
            glds16_asm(base + (size_t)(t2 * 2 + part) * 1024 + bnc, lds0 + kt * G_BBYTES + q * 4096); }
    };
    const int bg = lane >> 4, bq = (lane & 15) >> 2, bp = lane & 3;
    __syncthreads();
    issueB(0); issueB(1); issueB(2);
    f32x4 acc[2][8];
    for (int i = 0; i < nmy; ++i) {
#pragma unroll
        for (int m_ = 0; m_ < 2; ++m_)
#pragma unroll
            for (int n_ = 0; n_ < 8; ++n_) acc[m_][n_] = (f32x4){0.f, 0.f, 0.f, 0.f};
#pragma unroll
        for (int kt = 0; kt < 4; ++kt) {
            if (kt < 3 && i > 0) asm volatile("s_waitcnt vmcnt(24)" ::: "memory"); else asm volatile("s_waitcnt vmcnt(8)" ::: "memory");
            __syncthreads();
            issueB(i * 4 + kt + 3);
            const char* sb = smem + kt * G_BBYTES;
#pragma unroll
            for (int ks = 0; ks < 2; ++ks) {
#pragma unroll
                for (int nh = 0; nh < 4; ++nh) {
                    bf16x8 b[2];
#pragma unroll
                    for (int n2 = 0; n2 < 2; ++n2) {
                        const int nt = nh * 2 + n2;
                        const int c2 = 2 * nt + (bp >> 1);
                        const int k0 = 32 * ks + 8 * bg + bq, k1 = k0 + 4;
                        const s16x4 lo = __builtin_amdgcn_ds_read_tr16_b64_v4i16((LAS s16x4*)(sb + k0 * 256 + ((c2 ^ bswz(k0)) << 4) + 8 * (bp & 1)));
                        const s16x4 hi = __builtin_amdgcn_ds_read_tr16_b64_v4i16((LAS s16x4*)(sb + k1 * 256 + ((c2 ^ bswz(k1)) << 4) + 8 * (bp & 1)));
                        b[n2] = __builtin_shufflevector(lo, hi, 0, 1, 2, 3, 4, 5, 6, 7);
                    }
#pragma unroll
                    for (int mt = 0; mt < 2; ++mt)
#pragma unroll
                        for (int n2 = 0; n2 < 2; ++n2) acc[mt][nh * 2 + n2] = __builtin_amdgcn_mfma_f32_16x16x32_bf16(b[n2], a[kt * 2 + ks][mt], acc[mt][nh * 2 + n2], 0, 0, 0);
                }
            }
        }
        const int t = wg + i * nwg, bf_ = t >> 3, nt = t & 7, b = bf_ >> 6, f1 = bf_ & 63;
#pragma unroll
        for (int mt = 0; mt < 2; ++mt)
#pragma unroll
            for (int n8 = 0; n8 < 8; ++n8) {
                const int row = wid * 32 + mt * 16 + (lane & 15), col = n8 * 16 + 4 * (lane >> 4); const f32x4 v = acc[mt][n8];
                f32x4 o; o[0] = v[0] * scl; o[1] = v[1] * scl; o[2] = v[2] * scl; o[3] = v[3] * scl;
                st_bf4(FO + (size_t)(b * 8192 + f1 + 64 * row) * 1024 + nt * 128 + col, o);
            }
    }
    asm volatile("s_waitcnt vmcnt(0)" ::: "memory");
    __syncthreads();
}

__device__ __forceinline__ void moe_convert(const Params& p, int layer, int wg, int nwg) {
    const size_t gt = (size_t)wg * 256 + ltid(), gs = (size_t)nwg * 256; const size_t n4 = (size_t)32 * 1024 * 512 / 4;
    bf16_t* MW = WSP(bf16_t, (layer & 1) ? OFF_WREG : OFF_AD0);
    const float* s1 = p.moe_w1 + (size_t)layer * 32 * 1024 * 512; const float* s3 = p.moe_w3 + (size_t)layer * 32 * 1024 * 512; const float* s2 = p.moe_w2 + (size_t)layer * 32 * 1024 * 512;
    (void)s2;
    for (size_t i = gt; i < n4; i += gs) {
        st_bf4(MW + 4 * i, __builtin_nontemporal_load((const f32x4*)(s1 + 4 * i))); st_bf4(MW + 4 * n4 + 4 * i, __builtin_nontemporal_load((const f32x4*)(s3 + 4 * i)));
    }
}
struct ASplit { const bf16_t* H; const bf16_t* HLO; int m0;
    __device__ __forceinline__ int info(int row) const { return m0 + row; }
    __device__ __forceinline__ const bf16_t* ptr(int gr, int, int k) const { return k < 2048 ? H + (size_t)gr * 1024 + (k & 1023) : HLO + (size_t)gr * 1024 + (k - 2048); } };
template <int DRY>
__device__ __forceinline__ void phase_router(const Params& p, char* smem, int layer, int nrows, int wg, int nwg) {
    const bf16_t* H = WSP(bf16_t, OFF_HREG); const bf16_t* HLO = WSP(bf16_t, OFF_KD);
    const bf16_t* RW = (const bf16_t*)(p.ws + OFF_WTS + W_RW) + (size_t)layer * 3072 * 128;
    int* cnt = WSP(int, OFF_CNT) + layer * 32; int* routei = WSP(int, OFF_ROUTEI); float* routeg = WSP(float, OFF_ROUTEG); int* tokl = WSP(int, OFF_TOKL);
    float* LG = (float*)smem;
    f32x4 acc[4][4];
    const int ntot = nrows / 128;
    for (int t = wg; t < ntot; t += nwg) {
        const int m0 = t * 128;
        gemm_tile(smem, ROUTER_NK, ASplit{H, HLO, m0}, BPlain{RW, 128}, acc);
        __syncthreads();
        EPI_FOR(acc, { if (col < 48) { LG[row * 49 + col] = v[0]; LG[row * 49 + col + 1] = v[1]; LG[row * 49 + col + 2] = v[2]; LG[row * 49 + col + 3] = v[3]; } });
        __syncthreads();
        if (ltid() < 128) {
            const int row = ltid(), r = m0 + row; const float* lg = LG + row * 49;
            float c0 = lg[0] + p.router_c_b[layer * 4 + 0], c1 = lg[1] + p.router_c_b[layer * 4 + 1], c2 = lg[2] + p.router_c_b[layer * 4 + 2], c3 = lg[3] + p.router_c_b[layer * 4 + 3];
            int gi = 0; float mx = c0;
            if (c1 > mx) { mx = c1; gi = 1; } if (c2 > mx) { mx = c2; gi = 2; } if (c3 > mx) { mx = c3; gi = 3; }
            const float gval = 1.f / (expf(c0 - mx) + expf(c1 - mx) + expf(c2 - mx) + expf(c3 - mx));
            float lf[8]; float m1 = -3.0e38f, m2 = -3.0e38f; int e1 = 0, e2 = 0;
#pragma unroll
            for (int e = 0; e < 8; ++e) lf[e] = lg[4 + gi * 8 + e] + p.router_f_b[layer * 32 + gi * 8 + e];
#pragma unroll
            for (int e = 0; e < 8; ++e) if (lf[e] > m1) { m1 = lf[e]; e1 = e; }
#pragma unroll
            for (int e = 0; e < 8; ++e) if (e != e1 && lf[e] > m2) { m2 = lf[e]; e2 = e; }
            const float q2 = expf(m2 - m1); const float ga = gval / (1.f + q2), gb = gval * q2 / (1.f + q2);
            const int x1 = gi * 8 + e1, x2 = gi * 8 + e2;
            if (DRY) { asm volatile("" :: "v"(ga), "v"(gb), "v"(x1), "v"(x2)); } else {
            const int p1 = atomicAdd(&cnt[x1], 1), p2 = atomicAdd(&cnt[x2], 1);
            tokl[(size_t)x1 * TOKCAP + p1] = r; tokl[(size_t)x2 * TOKCAP + p2] = r;
            routei[2 * r] = (p1 << 5) | x1; routei[2 * r + 1] = (p2 << 5) | x2; routeg[2 * r] = ga; routeg[2 * r + 1] = gb; }
        }
    }
    if (!(CHUNKED && (layer & 1) == 0)) moe_convert(p, layer, wg, nwg);
}
__device__ __forceinline__ void moe_table(const Params& p, int layer, int* rbs, int* cn, int wg) {
    const int* cnt = WSP(int, OFF_CNT) + layer * 32;
    __syncthreads();
    if (ltid() == 0) { int a = 0; for (int e = 0; e < 32; ++e) { const int c = cnt[e]; cn[e] = c; rbs[e] = a; a += (c + 127) >> 7; } rbs[32] = a;
        if (wg == 0) { int* poff = WSP(int, OFF_POFF) + layer * 64; for (int e = 0; e < 32; ++e) poff[e] = rbs[e] * 128; } }
    __syncthreads();
}
struct AGather { const bf16_t* H; const bf16_t* zero; const int* list; int nvalid;
    __device__ __forceinline__ int info(int row) const { return row < nvalid ? list[row] : -1; }
    __device__ __forceinline__ const bf16_t* ptr(int tok, int, int k) const { return tok >= 0 ? H + (size_t)tok * 1024 + k : zero; } };
struct BW13 { const bf16_t* w1; size_t d3;
    __device__ __forceinline__ const bf16_t* ptr(int k, int n) const { return w1 + (size_t)((n >> 5) & 1) * d3 + (size_t)k * 512 + (n >> 6) * 32 + (n & 31); } };

__device__ __forceinline__ void phase_moe1(const Params& p, char* smem, int layer, int wg, int nwg) {
    int* rbs = (int*)(smem + SM_TAB); int* cn = rbs + 40;
    moe_table(p, layer, rbs, cn, wg);
    const bf16_t* H2 = WSP(bf16_t, OFF_HREG); const bf16_t* MW = WSP(bf16_t, (layer & 1) ? OFF_WREG : OFF_AD0); bf16_t* HB = WSP(bf16_t, OFF_BB); const int* tokl = WSP(int, OFF_TOKL);
    const size_t WSZ = (size_t)32 * 1024 * 512;
    const int ntot = rbs[32] * 8;
    f32x4 acc[4][4];
    for (int t = wg; t < ntot; t += nwg) {
        const int rbg = t >> 3, cb = t & 7;
        int e = 0; while (rbs[e + 1] <= rbg) ++e;
        const int rb = rbg - rbs[e]; const int nvalid = cn[e] - rb * 128;
        gemm_tile(smem, 16, AGather{H2, WSP(bf16_t, OFF_ZERO), tokl + (size_t)e * TOKCAP + rb * 128, nvalid},
                  BW13{MW + (size_t)e * 1024 * 512 + cb * 64, WSZ}, acc);
        {
            const int l = ltid() & 63, w = ltid() >> 6, wm = w >> 1, wn = w & 1;
#pragma unroll
            for (int mt = 0; mt < 4; ++mt)
#pragma unroll
                for (int nt = 0; nt < 2; ++nt) {
                    const int row = wm * 64 + mt * 16 + (l & 15), hcol = cb * 64 + wn * 32 + nt * 16 + 4 * (l >> 4);
                    const f32x4 a1 = acc[mt][nt], a3 = acc[mt][nt + 2]; f32x4 o;
#pragma unroll
                    for (int q = 0; q < 4; ++q) o[q] = a1[q] * sigmoidf_(a1[q]) * a3[q];
                    st_bf4(HB + ((size_t)rbg * 128 + row) * 512 + hcol, o);
                }
        }
    }
}
__device__ __forceinline__ void phase_moe2(const Params& p, char* smem, int layer, int wg, int nwg) {
    int* rbs = (int*)(smem + SM_TAB); int* cn = rbs + 40;
    moe_table(p, layer, rbs, cn, wg);
    const bf16_t* MW2 = WSP(bf16_t, OFF_W2); const bf16_t* HB = WSP(bf16_t, OFF_BB); bf16_t* YM = WSP(bf16_t, OFF_PREG);
    const int ntot = rbs[32] * 8;
    f32x4 acc[4][4];
    for (int t = wg; t < ntot; t += nwg) {
        const int rbg = t >> 3, nt8 = t & 7;
        int e = 0; while (rbs[e + 1] <= rbg) ++e;
        gemm_tile(smem, 8, APlain{HB, 512, rbg * 128}, BPlain{MW2 + (size_t)e * 512 * 1024 + nt8 * 128, 1024}, acc);
        EPI_FOR(acc, { st_bf4(YM + ((size_t)rbg * 128 + row) * 1024 + nt8 * 128 + col, v); });
    }
}

__device__ __forceinline__ void phase_e4z(const Params& p, char* smem, int j, int nrows, int wg, int nwg) {
    const int tid = ltid(), lane = tid & 63, wid = tid >> 6, wm = wid >> 1, wn = wid & 1;
    const bf16_t* LR1 = WSP(bf16_t, OFF_LR1); bf16_t* KD = WSP(bf16_t, OFF_KD); bf16_t* BB = WSP(bf16_t, OFF_BB);
    const bf16_t* WL2 = (const bf16_t*)(p.ws + OFF_WTS + W_LR2) + (size_t)j * 384 * 512;
    const int ntot = (nrows / 128) * 16;
    if (wg >= ntot) return;
    const int u = wg & 15, ob = u >> 2, n0 = (u & 3) * 128, koff = ob * 64;
    const int nmy = (ntot - wg + nwg - 1) / nwg;
    const int arow = tid >> 3, akc = (((tid & 7) ^ (arow & 7)) << 3), brow = tid >> 4, bnc = (((tid & 15) ^ bswz(brow)) << 3);
    const unsigned lds0 = (unsigned)__builtin_amdgcn_readfirstlane((int)((unsigned)(size_t)smem + (unsigned)(wid * 1024)));
    constexpr int EZ_B = 3 * G_ABYTES, EZ_BIAS = 65536;
    __syncthreads();
    {
        const bf16_t* bsrc = WL2 + (size_t)koff * 512 + n0;
#pragma unroll
        for (int i = 0; i < 4; ++i) glds16_asm(bsrc + (size_t)(brow + 16 * i) * 512 + bnc, lds0 + EZ_B + i * 4096);
        if (tid < 128) ((float*)(smem + EZ_BIAS))[tid] = (ob < 2 ? p.decay_w0 + (size_t)(j * 2 + ob) * 512 : p.lr_a0 + (size_t)(j * 2 + ob - 2) * 512)[n0 + tid];
    }
    auto issueA = [&](int i, int buf) {
        const int m0 = ((wg + i * nwg) >> 4) * 128;
#pragma unroll
        for (int q = 0; q < 4; ++q) glds16_asm(LR1 + (size_t)(m0 + arow + 32 * q) * 384 + koff + akc, lds0 + buf * G_ABYTES + q * 4096);
    };
    issueA(0, 0); issueA(min(1, nmy - 1), 1);
    const int ar = wm * 64 + (lane & 15), ax = lane & 7, ag = lane >> 4;
    const int bg = lane >> 4, bq = (lane & 15) >> 2, bp = lane & 3;
    bf16_t* outp = ob < 2 ? KD + (size_t)ob * NT * 512 : BB + (size_t)(ob - 2) * NT * 512;
    int buf = 0;
    for (int i = 0; i < nmy; ++i) {
        if (i == 0) asm volatile("s_waitcnt vmcnt(4)" ::: "memory"); else asm volatile("s_waitcnt vmcnt(20)" ::: "memory");
        __syncthreads();
        { int b2 = buf + 2; if (b2 >= 3) b2 -= 3; issueA(min(i + 2, nmy - 1), b2); }
        const char* sa = smem + buf * G_ABYTES; const char* sb = smem + EZ_B;
        f32x4 acc[4][4];
#pragma unroll
        for (int a_ = 0; a_ < 4; ++a_)
#pragma unroll
            for (int b_ = 0; b_ < 4; ++b_) acc[a_][b_] = (f32x4){0.f, 0.f, 0.f, 0.f};
#pragma unroll
        for (int ks = 0; ks < 2; ++ks) {
            bf16x8 a[4], b[4];
#pragma unroll
            for (int mt = 0; mt < 4; ++mt) a[mt] = *(const bf16x8*)(sa + (ar + mt * 16) * 128 + (((4 * ks + ag) ^ ax) << 4));
#pragma unroll
            for (int nt = 0; nt < 4; ++nt) {
                const int c2 = 2 * (wn * 4 + nt) + (bp >> 1);
                const int k0 = 32 * ks + 8 * bg + bq, k1 = k0 + 4;
                const s16x4 lo = __builtin_amdgcn_ds_read_tr16_b64_v4i16((LAS s16x4*)(sb + k0 * 256 + ((c2 ^ bswz(k0)) << 4) + 8 * (bp & 1)));
                const s16x4 hi = __builtin_amdgcn_ds_read_tr16_b64_v4i16((LAS s16x4*)(sb + k1 * 256 + ((c2 ^ bswz(k1)) << 4) + 8 * (bp & 1)));
                b[nt] = __builtin_shufflevector(lo, hi, 0, 1, 2, 3, 4, 5, 6, 7);
            }
#pragma unroll
            for (int mt = 0; mt < 4; ++mt)
#pragma unroll
                for (int nt = 0; nt < 4; ++nt) acc[mt][nt] = __builtin_amdgcn_mfma_f32_16x16x32_bf16(b[nt], a[mt], acc[mt][nt], 0, 0, 0);
        }
        const int m0 = ((wg + i * nwg) >> 4) * 128;
        if (ob < 2) {
            EPI_FOR(acc, { const f32x4 b0 = *(const f32x4*)(smem + EZ_BIAS + col * 4); f32x4 o;
                _Pragma("unroll") for (int e = 0; e < 4; ++e) o[e] = v[e] + b0[e];
                st_bf4(outp + (size_t)(m0 + row) * 512 + n0 + col, o); });
        } else {
            EPI_FOR(acc, { const f32x4 b0 = *(const f32x4*)(smem + EZ_BIAS + col * 4); f32x4 o;
                _Pragma("unroll") for (int e = 0; e < 4; ++e) o[e] = sigmoidf_(v[e] + b0[e]);
                st_bf4(outp + (size_t)(m0 + row) * 512 + n0 + col, o); });
        }
        if (++buf == 3) buf = 0;
    }
    asm volatile("s_waitcnt vmcnt(0)" ::: "memory");
    __syncthreads();
}

template <int PH>
__device__ __forceinline__ void do_phase(const Params& pin, char* smem, int layer, int wg, int nwg) {
    Params p = pin; { size_t zoff = 0; asm volatile("" : "+s"(zoff)); p.ws = pin.ws + zoff; } asm volatile("" : "+s"(layer));
    const int j = layer >> 1;
    const bool ctx_in = layer <= 2, ctx_out = layer < 2;
    const int rows_in = ctx_in ? NT : NL, rows_out = ctx_out ? NT : NL;
    const char* wts = p.ws + OFF_WTS;
    if constexpr (PH == PH_PROLOGUE) phase_prologue(p, smem, wg, nwg);
    else if constexpr (PH == PH_MOD_MIX) { if (layer == 0) phase_modpipe<0, false>(p, layer, rows_in, wg, nwg); else phase_modpipe<0, true>(p, layer, rows_in, wg, nwg); }
    else if constexpr (PH == PH_E2) phase_e2(p, smem, j, rows_in, layer, wg, nwg);
    else if constexpr (PH == PH_E3) { phase_e3(p, j, rows_in, wg, nwg); if ((nwg & 15) == 0) phase_e4z(p, smem, j, rows_in, wg, nwg); else phase_e4(p, smem, j, rows_in, 0, wg, nwg); }
    else if constexpr (PH == PH_E4) phase_e4(p, smem, j, rows_in, 0, wg, nwg);
    else if constexpr (PH == PH_SCAN) phase_scan<0>(p, smem, wg, nwg);
    else if constexpr (PH == PH_SCANV) phase_scan<SCANVAR>(p, smem, wg, nwg);
    else if constexpr (PH == PH_POST) phase_post<CHUNKED>(p, j, rows_out, wg, nwg);
    else if constexpr (PH == PH_S1A) phase_s1(p, smem, j, 0, wg, nwg);
    else if constexpr (PH == PH_S2A) { if (nwg <= 128) { phase_s2(p, smem, 0, wg, nwg); phase_s1(p, smem, j, 1, wg, nwg); } else if (wg < 128) phase_s2(p, smem, 0, wg, nwg); else phase_s1(p, smem, j, 1, wg - 128, nwg - 128); }
    else if constexpr (PH == PH_S2B) { if (nwg <= 128) { phase_s2(p, smem, 1, wg, nwg); phase_e4(p, smem, j, rows_in, 1, wg, nwg); moe_convert(p, layer, wg, nwg); } else if (wg < 128) phase_s2(p, smem, 1, wg, nwg); else { phase_e4(p, smem, j, rows_in, 1, wg - 128, nwg - 128); moe_convert(p, layer, wg - 128, nwg - 128); } }
    else if constexpr (PH == PH_WOUT) phase_resgemm(p, smem, WSP(bf16_t, OFF_HREG), (const bf16_t*)(wts + W_WOUT) + (size_t)j * 1024 * 1024, layer, rows_out, wg, nwg);
    else if constexpr (PH == PH_F1) phase_f1(p, smem, rows_out, wg, nwg);
    else if constexpr (PH == PH_F2) phase_f2(p, smem, ctx_out, wg, nwg);
    else if constexpr (PH == PH_F3) phase_f3_ring(p, smem, wg, nwg);
    else if constexpr (PH == PH_WF) phase_resgemm<0, true>(p, smem, WSP(bf16_t, OFF_RKVK), (const bf16_t*)(wts + W_WF) + (size_t)j * 1024 * 1024, layer, rows_out, wg, nwg);
    else if constexpr (PH == PH_FFNR) { phase_ffn_route(p, smem, layer, rows_out, wg, nwg); if (layer & 1) moe_convert(p, layer, wg, nwg); }
    else if constexpr (PH == PH_MOD_FFN) phase_modulate<1>(p, layer, rows_out, false, false, wg, nwg);
    else if constexpr (PH == PH_ROUTER) phase_router<0>(p, smem, layer, rows_out, wg, nwg);
    else if constexpr (PH == PH_ROUTERV) phase_router<1>(p, smem, layer, rows_out, wg, nwg);
    else if constexpr (PH == PH_WOUTV) phase_resgemm<1>(p, smem, WSP(bf16_t, OFF_HREG), (const bf16_t*)(wts + W_WOUT) + (size_t)j * 1024 * 1024, layer, rows_out, wg, nwg);
    else if constexpr (PH == PH_MOE1) phase_moe1(p, smem, layer, wg, nwg);
    else if constexpr (PH == PH_MOE2) phase_moe2(p, smem, layer, wg, nwg);
    else if constexpr (PH == PH_FINAL) phase_modpipe<2, true>(p, 4, NL, wg, nwg);
}

#if MEGA
#ifndef PROF
#define PROF 0
#endif
#if PROF
#define PH_RUN(PHID, CAT) do { const unsigned long long _t0 = wall_clock64(); do_phase<PHID>(p, smem, layer, wg, nwg); xcd_barrier(bar); if ((CAT) == PROF || PROF == 99) tacc += wall_clock64() - _t0; } while (0)
#else
#ifndef DUP_CAT
#define DUP_CAT 0
#endif
#define PH_RUN(PHID, CAT) do { do_phase<PHID>(p, smem, layer, wg, nwg); xcd_barrier(bar); if ((CAT) == DUP_CAT) { do_phase<((PHID) == PH_SCAN ? PH_SCANV : (PHID) == PH_ROUTER ? PH_ROUTERV : (PHID) == PH_WOUT ? PH_WOUTV : (PHID))>(p, smem, layer, wg, nwg); xcd_barrier(bar); } } while (0)
#endif
__global__ void __launch_bounds__(256, 2) k_mega(Params p) {
    extern __shared__ __attribute__((aligned(16))) char smem[];
    if (threadIdx.x == 0) *(u32x4*)(smem + SM_BAR) = (u32x4){0u, 0u, 0u, 0u};
    __syncthreads();
    XcdBarrier bar = xcd_barrier_post(WSP(unsigned, OFF_BAR), (volatile LAS unsigned*)(smem + SM_BAR));
    const int wg = blockIdx.x, nwg = gridDim.x;
#if PROF
    unsigned long long tacc = 0;
#endif
    { int layer = 0; PH_RUN(PH_PROLOGUE, 1); }
    for (int layer = 0; layer < 4; ++layer) {
        PH_RUN(PH_MOD_MIX, 2);
        if ((layer & 1) == 0) {
            PH_RUN(PH_E2, 3); PH_RUN(PH_E3, 4);
#if CHUNKED
            PH_RUN(PH_S1A, 16); PH_RUN(PH_S2A, 17); PH_RUN(PH_S2B, 18);
#else
            PH_RUN(PH_SCAN, 6);
#endif
            PH_RUN(PH_POST, 7); PH_RUN(PH_WOUT, 8);
        } else {
            PH_RUN(PH_F1, 9); PH_RUN(PH_F2, 10); PH_RUN(PH_F3, 11); PH_RUN(PH_WF, 8);
        }
        PH_RUN(PH_FFNR, 12); PH_RUN(PH_MOE1, 14); PH_RUN(PH_MOE2, 15);
    }
#if PROF
    {
        float* slot = (float*)(p.ws + OFF_POFF + 2048);
        if (wg == 0 && threadIdx.x == 0) *slot = rintf(logf((float)tacc * 0.01f) * 20.f) * 0.05f;
        xcd_barrier(bar);
        const float c = *slot;
        for (size_t i = (size_t)wg * 256 + threadIdx.x; i < (size_t)NL * 1024; i += (size_t)nwg * 256) p.out[i] = c;
    }
#else
    do_phase<PH_FINAL>(p, smem, 4, wg, nwg);
#endif
}
#else
template <int PH>
__global__ void __launch_bounds__(256, 2) k_phase(Params p, int layer) {
    extern __shared__ __attribute__((aligned(16))) char smem[];
    do_phase<PH>(p, smem, layer, blockIdx.x, gridDim.x);
}
template <int PH> static void launch_phase(const Params& p, int layer, hipStream_t stream) {
    static bool attr = false;
    if (!attr) { (void)hipFuncSetAttribute((const void*)k_phase<PH>, hipFuncAttributeMaxDynamicSharedMemorySize, SMEM_BYTES); attr = true; }
    hipLaunchKernelGGL(k_phase<PH>, dim3(512), dim3(256), SMEM_BYTES, stream, p, layer);
}
#endif


#if DIAG >= 2
__global__ void k_census(Params p, int what) {
}
__global__ void k_census1(char* ws, size_t off, size_t nbytes, int isf32, int idx) {
    const unsigned* u = (const unsigned*)(ws + off); const size_t n = nbytes / 4; bool bad = false;
    for (size_t i = (size_t)blockIdx.x * 256 + threadIdx.x; i < n; i += (size_t)gridDim.x * 256) {
        const unsigned x = u[i];
        if (isf32) { if ((x & 0x7f800000u) >= (141u << 23)) bad = true; }
        else { if ((x & 0x7f80u) >= (141u << 7) || (x & 0x7f800000u) >= (141u << 23)) bad = true; }
    }
    if (bad) atomicOr((unsigned*)(ws + OFF_CNT) + 192, 1u << idx);
}
__global__ void k_report(Params p) {
    const unsigned f = *((const unsigned*)(p.ws + OFF_CNT) + 192);
    int idx = 0; for (int b = 1; b < 32; ++b) if (f & (1u << b)) { idx = b; break; }
    const float c = sqrtf(0.5f * (float)idx);
    for (size_t i = (size_t)blockIdx.x * 256 + threadIdx.x; i < (size_t)NL * 1024; i += (size_t)gridDim.x * 256) p.out[i] = c;
}
#endif

#if DIAG == 3
__global__ void __launch_bounds__(256, 2) k_gemmtest(Params p) {
    extern __shared__ __attribute__((aligned(16))) char smem[];
    bf16_t* A = WSP(bf16_t, OFF_PREG); bf16_t* B = A + 128 * 128; float* C = (float*)(B + 128 * 128);
    unsigned* cnt = (unsigned*)(p.ws + OFF_CNT) + 192;
    const int tid = threadIdx.x;
    for (int i = tid; i < 128 * 128; i += 256) { const int m = i >> 7, k = i & 127; A[i] = f2bf((float)(((m * 7 + k * 3) % 9) - 4)); B[i] = f2bf((float)(((m * 5 + k * 11) % 7) - 3)); }
    __threadfence(); __syncthreads();
    f32x4 acc[4][4];
    gemm_tile(smem, 2, APlain{A, 128, 0}, BPlain{B, 128}, acc);
    EPI_FOR(acc, { *(f32x4*)(C + (size_t)row * 128 + col) = v; });
    __threadfence(); __syncthreads();
    unsigned bad = 0, nonfin = 0, tr = 0;
    for (int i = tid; i < 128 * 128; i += 256) { const int m = i >> 7, n = i & 127; float s = 0.f, st = 0.f;
        for (int k = 0; k < 128; ++k) { s += bf2f(A[m * 128 + k]) * bf2f(B[k * 128 + n]); st += bf2f(A[n * 128 + k]) * bf2f(B[k * 128 + m]); }
        const float c = C[i]; if (c != s) ++bad; if (!(fabsf(c) < 3e38f)) ++nonfin; if (c == st) ++tr; }
    atomicAdd(cnt + 1, bad); atomicAdd(cnt + 2, nonfin); atomicAdd(cnt + 3, tr);
}
__global__ void k_report3(Params p) {
    const unsigned* cnt = (const unsigned*)(p.ws + OFF_CNT) + 192;
    float c2 = 8.f * (float)cnt[1] / 16384.f; if (cnt[2]) c2 += 20.f; if (cnt[3] > 8000) c2 += 50.f;
    const float c = sqrtf(c2);
    for (size_t i = (size_t)blockIdx.x * 256 + threadIdx.x; i < (size_t)NL * 1024; i += (size_t)gridDim.x * 256) p.out[i] = c;
}
#endif

#if DIAG == 4 || DIAG == 5
__device__ __forceinline__ bool close_(float a, float b, float tol) { return fabsf(a - b) <= tol * (1.f + fabsf(b)); }
__global__ void k_check(Params p) {
    unsigned* flag = (unsigned*)(p.ws + OFF_CNT) + 192;
    const float* mod = WSP(float, OFF_MOD); const bf16_t* H = WSP(bf16_t, OFF_HREG); const bf16_t* P = WSP(bf16_t, OFF_PREG); const bf16_t* LR1 = WSP(bf16_t, OFF_LR1);
    const bf16_t* WIN = (const bf16_t*)(p.ws + OFF_WTS + W_WIN); const bf16_t* WL1 = (const bf16_t*)(p.ws + OFF_WTS + W_LR1);
    const size_t gt = (size_t)blockIdx.x * 256 + threadIdx.x, gs = (size_t)gridDim.x * 256;
    unsigned bad = 0;
    for (size_t i = gt; i < 5 * 6144; i += gs) { const int mb = (int)(i / 6144), n = (int)(i % 6144); float s = 0.f;
        for (int k = 0; k < 1024; ++k) { const float cv = mb < 4 ? p.c[mb * 1024 + k] : p.c_ctx[k]; s += cv / (1.f + expf(-cv)) * p.ada_w[(size_t)k * 6144 + n]; }
        s += p.ada_b[n]; if (!close_(mod[(size_t)(mb * 4) * 6144 + n], s, 1e-3f)) bad |= 1u; }
    { const int rows[6] = {0, 1, 8191, 8192, NL, NT - 1};
      for (size_t i = gt; i < 6 * 1024; i += gs) { const int r = rows[i >> 10], c = (int)(i & 1023); const float* xr = r < NL ? p.x + (size_t)r * 1024 : p.ctx + (size_t)(r - NL) * 1024;
        float ss = 0.f; for (int k = 0; k < 1024; ++k) ss += xr[k] * xr[k]; const float rinv = 1.f / sqrtf(ss / 1024.f + 1e-6f); const int mb = r < NL ? r >> 13 : 4;
        const float h = xr[c] * rinv * p.norm_mix[c] * (1.f + mod[(size_t)(mb * 4) * 6144 + 1024 + c]) + mod[(size_t)(mb * 4) * 6144 + c];
        if (!close_(bf2f(H[(size_t)r * 1024 + c]), h, 2e-2f)) bad |= 2u; } }
    for (size_t i = gt; i < (size_t)1024 * 2048; i += gs) if (!close_(bf2f(WIN[i]), p.w_in[i], 1e-2f)) bad |= 4u;
    { const int rows[6] = {0, 1, 127, 128, 5000, NT - 1};
      for (size_t i = gt; i < 6 * 2048; i += gs) { const int r = rows[i >> 11], n = (int)(i & 2047); float s = 0.f;
        for (int k = 0; k < 1024; ++k) s += bf2f(H[(size_t)r * 1024 + k]) * bf2f(WIN[(size_t)k * 2048 + n]);
        if (!close_(bf2f(P[(size_t)r * 2048 + n]), s, 2e-2f)) bad |= 8u; } }
    { const int rows[6] = {0, 1, 63, 64, 8191, NT - 1};
      for (size_t i = gt; i < 6 * 384; i += gs) { const int r = rows[i / 384], n = (int)(i % 384); float s = 0.f;
        for (int k = 0; k < 1024; ++k) s += bf2f(H[(size_t)r * 1024 + k]) * bf2f(WL1[(size_t)k * 384 + n]);
        for (int k = 0; k < 1024; ++k) { const int sr = shift_src(r, k >> 8); if (sr >= 0) s += bf2f(H[(size_t)sr * 1024 + k]) * bf2f(WL1[(size_t)(1024 + k) * 384 + n]); }
        const float a = n < 128 ? tanhf(s) : (n < 256 ? s : 1.f / (1.f + expf(-s)));
        if (!close_(bf2f(LR1[(size_t)r * 384 + n]), a, 2e-2f)) bad |= 16u; } }
    if (bad) atomicOr(flag, bad);
}
__global__ void k_report4(Params p) {
    const unsigned f = *((const unsigned*)(p.ws + OFF_CNT) + 192);
    const float c = sqrtf(0.25f * (float)f);
    for (size_t i = (size_t)blockIdx.x * 256 + threadIdx.x; i < (size_t)NL * 1024; i += (size_t)gridDim.x * 256) p.out[i] = c;
}
#endif

#if DIAG == 5
__global__ void __launch_bounds__(256, 2) k_projtest(Params p) {
    extern __shared__ __attribute__((aligned(16))) char smem[];
    const bf16_t* H = WSP(bf16_t, OFF_HREG); const bf16_t* WIN = (const bf16_t*)(p.ws + OFF_WTS + W_WIN);
    float* C = WSP(float, OFF_PREG) + (size_t)blockIdx.x * 128 * 128;
    unsigned* flag = (unsigned*)(p.ws + OFF_CNT) + 192;
    const int m0s[4] = {0, 0, 128 * 263, 128 * 100}, n0s[4] = {0, 1920, 0, 640};
    const int m0 = m0s[blockIdx.x], n0 = n0s[blockIdx.x];
    f32x4 acc[4][4];
    gemm_tile(smem, 16, APlain{H, 1024, m0}, BPlain{WIN + n0, 2048}, acc);
    EPI_FOR(acc, { *(f32x4*)(C + (size_t)row * 128 + col) = v; });
    __threadfence(); __syncthreads();
    unsigned bad = 0;
    for (int i = threadIdx.x; i < 128 * 128; i += 256) { const int m = i >> 7, n = i & 127; float s = 0.f;
        for (int k = 0; k < 1024; ++k) s += bf2f(H[(size_t)(m0 + m) * 1024 + k]) * bf2f(WIN[(size_t)k * 2048 + n0 + n]);
        if (!(fabsf(C[i] - s) <= 1e-2f * (1.f + fabsf(s)))) bad = 1; }
    if (bad) atomicOr(flag, 1u << blockIdx.x);
}
#endif

extern "C" void kernel_launch(void* const* d_in, const int* in_sizes, int n_in, void* d_out, int out_size, void* d_ws, size_t ws_size, hipStream_t stream) {
    if (n_in != 36 || ws_size < WS_END) { fprintf(stderr, "kernel_launch: unexpected n_in %d or workspace %zu < %zu\n", n_in, ws_size, (size_t)WS_END); return; }
    Params p{};
    const float** pf = (const float**)&p;
    for (int i = 0; i < 36; ++i) pf[i] = (const float*)d_in[i];
    p.out = (float*)d_out; p.ws = (char*)d_ws;
    (void)hipMemsetAsync(d_ws, 0, ZERO_REGION, stream);
#if MEGA
    static int grid = 0;
    if (grid == 0) {
        int dev = 0, cus = 0, per_cu = 0;
        (void)hipGetDevice(&dev); (void)hipDeviceGetAttribute(&cus, hipDeviceAttributeMultiprocessorCount, dev);
        (void)hipFuncSetAttribute((const void*)k_mega, hipFuncAttributeMaxDynamicSharedMemorySize, SMEM_BYTES);
        (void)hipOccupancyMaxActiveBlocksPerMultiprocessor(&per_cu, (const void*)k_mega, 256, SMEM_BYTES);
        (void)hipGetLastError();
        if (per_cu < 1) per_cu = 1;
        grid = cus * (per_cu < 2 ? per_cu : 2);
    }
    hipLaunchKernelGGL(k_mega, dim3(grid), dim3(256), SMEM_BYTES, stream, p);
#else
#if DIAG == 1
    launch_phase<PH_MOD_MIX>(p, 0, stream); launch_phase<PH_FINAL>(p, 4, stream); return;
#endif
#if DIAG == 5
    launch_phase<PH_PROLOGUE>(p, 0, stream); launch_phase<PH_MOD_MIX>(p, 0, stream);
    (void)hipFuncSetAttribute((const void*)k_projtest, hipFuncAttributeMaxDynamicSharedMemorySize, SMEM_BYTES);
    hipLaunchKernelGGL(k_projtest, dim3(4), dim3(256), SMEM_BYTES, stream, p);
    hipLaunchKernelGGL(k_report4, dim3(1024), dim3(256), 0, stream, p); return;
#endif
#if DIAG == 4
    launch_phase<PH_PROLOGUE>(p, 0, stream); launch_phase<PH_MOD_MIX>(p, 0, stream); launch_phase<PH_E2>(p, 0, stream);
    hipLaunchKernelGGL(k_check, dim3(512), dim3(256), 0, stream, p);
    hipLaunchKernelGGL(k_report4, dim3(1024), dim3(256), 0, stream, p); return;
#endif
#if DIAG == 3
    (void)hipFuncSetAttribute((const void*)k_gemmtest, hipFuncAttributeMaxDynamicSharedMemorySize, SMEM_BYTES);
    hipLaunchKernelGGL(k_gemmtest, dim3(1), dim3(256), SMEM_BYTES, stream, p);
    hipLaunchKernelGGL(k_report3, dim3(1024), dim3(256), 0, stream, p); return;
#endif
#if DIAG == 2
#define CEN(off, bytes, isf, idx) hipLaunchKernelGGL(k_census1, dim3(1024), dim3(256), 0, stream, p.ws, (size_t)(off), (size_t)(bytes), isf, idx)
    launch_phase<PH_PROLOGUE>(p, 0, stream); launch_phase<PH_MOD_MIX>(p, 0, stream);
    CEN(OFF_MOD, 491520, 1, 1); CEN(OFF_HREG, (size_t)NT * 2048, 0, 2); CEN(OFF_WTS, W_END, 0, 3);
    launch_phase<PH_E2>(p, 0, stream);
    CEN(OFF_PREG, (size_t)NT * 4096, 0, 4); CEN(OFF_LR1, (size_t)NT * 768, 0, 5);
    launch_phase<PH_E3>(p, 0, stream);
    CEN(OFF_RKVK, (size_t)NT * 1024, 0, 6); CEN(OFF_RKVK + (size_t)NT * 1024, (size_t)NT * 1024, 0, 7); CEN(OFF_RKVK + (size_t)NT * 2048, (size_t)NT * 1024, 0, 8);
    CEN(OFF_RKVK + (size_t)NT * 3072, (size_t)NT * 1024, 0, 9); CEN(OFF_DIFF, (size_t)NT * 1024, 0, 10);
    launch_phase<PH_E4>(p, 0, stream);
    CEN(OFF_WREG, (size_t)NT * 4096, 1, 11); CEN(OFF_KD, (size_t)NT * 2048, 0, 12); CEN(OFF_BB, (size_t)NT * 2048, 0, 13); CEN(OFF_G, (size_t)NT * 1024, 0, 14);
    launch_phase<PH_SCAN>(p, 0, stream);
    CEN(OFF_PREG, (size_t)NT * 4096, 1, 15);
    launch_phase<PH_POST>(p, 0, stream);
    CEN(OFF_HREG, (size_t)NT * 2048, 0, 16);
    launch_phase<PH_WOUT>(p, 0, stream);
    CEN(OFF_RES, (size_t)NT * 4096, 1, 17);
    hipLaunchKernelGGL(k_report, dim3(1024), dim3(256), 0, stream, p); return;
#endif
    launch_phase<PH_PROLOGUE>(p, 0, stream);
    for (int layer = 0; layer < 4; ++layer) {
        launch_phase<PH_MOD_MIX>(p, layer, stream);
        if ((layer & 1) == 0) {
            launch_phase<PH_E2>(p, layer, stream); launch_phase<PH_E3>(p, layer, stream); launch_phase<PH_E4>(p, layer, stream);
            launch_phase<PH_SCAN>(p, layer, stream); launch_phase<PH_POST>(p, layer, stream); launch_phase<PH_WOUT>(p, layer, stream);
        } else {
            launch_phase<PH_F1>(p, layer, stream); launch_phase<PH_F2>(p, layer, stream); launch_phase<PH_F3>(p, layer, stream); launch_phase<PH_WF>(p, layer, stream);
        }
        launch_phase<PH_MOD_FFN>(p, layer, stream); launch_phase<PH_ROUTER>(p, layer, stream); launch_phase<PH_MOE1>(p, layer, stream); launch_phase<PH_MOE2>(p, layer, stream);
    }
    launch_phase<PH_FINAL>(p, 4, stream);
#endif
}
```

```cpp
#include <hip/hip_runtime.h>
#include <stdint.h>
#include <stdio.h>

#ifndef DIAG
#define DIAG 0
#endif
#ifndef CHUNKED
#define CHUNKED 1
#endif
#ifndef ROUTER_NK
#define ROUTER_NK 16
#endif
#ifndef MEGA
#define MEGA 1
#endif

typedef unsigned short bf16_t;
typedef short bf16x8 __attribute__((ext_vector_type(8)));
typedef short s16x4 __attribute__((ext_vector_type(4)));
typedef float f32x4 __attribute__((ext_vector_type(4)));
typedef unsigned u32x4 __attribute__((ext_vector_type(4)));
typedef unsigned u32x2 __attribute__((ext_vector_type(2)));
#define LAS __attribute__((address_space(3)))
#define GAS __attribute__((address_space(1)))

#define NL 32768
#define NCX 1024
#define NT 33792
#define DM 1024
#define TOKCAP NT
#define YM_ROWS 71680

#define MBY(x) ((size_t)(x) << 20)
constexpr size_t OFF_BAR = 0, OFF_CNT = 16384, OFF_ZERO = 16384 + 1024, ZERO_REGION = 32768;
constexpr size_t OFF_CNTS = 655360;
#define CNTS_STRIDE 128
constexpr size_t OFF_POFF = 32768, OFF_MOD = 65536;
constexpr size_t OFF_ROUTEI = MBY(1), OFF_ROUTEG = MBY(1) + 270336, OFF_TOKL = MBY(2);
constexpr size_t OFF_WTS = MBY(8);
constexpr size_t W_WIN = 0, W_WOUT = W_WIN + 8388608, W_WF = W_WOUT + 4194304, W_LR1 = W_WF + 4194304, W_LR2 = W_LR1 + 3145728,
                 W_POOL = W_LR2 + 786432, W_RW = W_POOL + 262144, W_DFTC = W_RW + 3145728, W_TW = W_DFTC + 262144, W_CS128 = W_TW + 4194304,
                 W_CS256 = W_CS128 + 65536, W_END = W_CS256 + 262144;
static_assert(W_END < MBY(32), "weights region");
constexpr size_t OFF_RES = MBY(40), OFF_HREG = MBY(172), OFF_PREG = MBY(238), OFF_LR1 = MBY(378), OFF_RKVK = MBY(403), OFF_DIFF = MBY(535),
                 OFF_WREG = MBY(568), OFF_KD = MBY(700), OFF_BB = MBY(766), OFF_G = MBY(836), WS_END = MBY(1001);
constexpr size_t OFF_W2 = OFF_RKVK + (size_t)3 * 33792 * 512 * 2;

struct Params {
    const float *x, *c, *ctx, *c_ctx, *ada_w, *ada_b, *norm_mix, *norm_ffn, *w_in, *mu_x, *mu_p, *decay_w0, *decay_w1, *decay_w2, *lr_a0, *lr_a1, *lr_a2,
        *gate_g1, *gate_g2, *k_k, *k_a, *r_k, *gn_w, *gn_b, *pool_w, *pool_scale, *w_out, *w_fourier, *router_c, *router_c_b, *router_f, *router_f_b,
        *moe_w1, *moe_w3, *moe_w2, *final_norm;
    float* out;
    char* ws;
};

typedef float f32x2_ __attribute__((ext_vector_type(2)));
typedef __bf16 bf16x2_ __attribute__((ext_vector_type(2)));
__device__ __forceinline__ unsigned pk2(float lo, float hi) { const f32x2_ v = {lo, hi}; const bf16x2_ r = __builtin_convertvector(v, bf16x2_); return __builtin_bit_cast(unsigned, r); }
__device__ __forceinline__ bf16_t f2bf(float f) { return (bf16_t)(pk2(f, 0.f) & 0xffffu); }
__device__ __forceinline__ float bf2f(bf16_t h) { return __uint_as_float((unsigned)h << 16); }
__device__ __forceinline__ float bflo(unsigned u) { return __uint_as_float(u << 16); }
__device__ __forceinline__ float bfhi(unsigned u) { return __uint_as_float(u & 0xffff0000u); }
__device__ __forceinline__ float rl_(float x, int l) { return __builtin_bit_cast(float, __builtin_amdgcn_readlane(__builtin_bit_cast(int, x), l)); }
template <int CTRL> __device__ __forceinline__ float dppf(float v) { return __builtin_bit_cast(float, __builtin_amdgcn_update_dpp(0, __builtin_bit_cast(int, v), CTRL, 0xf, 0xf, true)); }
__device__ __forceinline__ float sum8(float v) { v += dppf<0xB1>(v); v += dppf<0x4E>(v); v += dppf<0x141>(v); return v; }
__device__ __forceinline__ float sum16(float v) { v += dppf<0xB1>(v); v += dppf<0x4E>(v); v += dppf<0x141>(v); v += dppf<0x140>(v); return v; }
__device__ __forceinline__ float wave_sum(float v) {
    v += dppf<0xB1>(v); v += dppf<0x4E>(v); v += dppf<0x141>(v); v += dppf<0x140>(v);
    return (rl_(v, 0) + rl_(v, 16)) + (rl_(v, 32) + rl_(v, 48));
}
__device__ __forceinline__ float fexp(float x) { return __builtin_amdgcn_exp2f(x * 1.44269504089f); }
__device__ __forceinline__ float frcp(float x) { return __builtin_amdgcn_rcpf(x); }
__device__ __forceinline__ float frsq(float x) { return __builtin_amdgcn_rsqf(x); }
__device__ __forceinline__ float sigmoidf_(float x) { return frcp(1.f + fexp(-x)); }
__device__ __forceinline__ float tanhf_(float x) { return 1.f - 2.f * frcp(fexp(2.f * x) + 1.f); }
__device__ __forceinline__ int shift_src(int r, int q) {
    if (r < NL) {
        const int t = r & 8191, col = t & 63, row = t >> 6;
        if (q == 0) return col > 0 ? r - 1 : -1;
        if (q == 1) return col < 63 ? r + 1 : -1;
        if (q == 2) return row > 0 ? r - 64 : -1;
        return row < 127 ? r + 64 : -1;
    } else {
        const int t = (r - NL) & 255;
        if (q < 2) return t > 0 ? r - 1 : -1;
        return t < 255 ? r + 1 : -1;
    }
}

__device__ __forceinline__ int ltid() { int t = threadIdx.x; asm volatile("" : "+v"(t)); return t; }

#define XB_TMO      128
#define XB_XCNT(j)  (256  + 64 * (j))
#define XB_XSUB(j)  (1280 + 64 * (j))
#define XB_XGEN(j)  (2304 + 64 * (j))
#define XB_TOP      3328
#define XB_TOPGEN   3392
#define XCD_BAR_WORDS 3456
#define XB_SPIN_CAP (1u << 22)
__device__ __forceinline__ unsigned xb_ld(unsigned* p)              { return __hip_atomic_load(p, __ATOMIC_RELAXED, __HIP_MEMORY_SCOPE_AGENT); }
__device__ __forceinline__ unsigned xb_add(unsigned* p, unsigned v) { return __hip_atomic_fetch_add(p, v, __ATOMIC_RELAXED, __HIP_MEMORY_SCOPE_AGENT); }
__device__ __forceinline__ unsigned xb_xcc_id() { return (unsigned)__builtin_amdgcn_s_getreg((3 << 11) | 20) & 0xFu; }
#define XB_SPIN(cond, bar) do { unsigned _sp = 0; while (cond) { __builtin_amdgcn_s_sleep(1); \
    if ((++_sp & 255u) == 0u) { if (xb_ld(&(bar)[XB_TMO])) break; if (_sp > XB_SPIN_CAP) { atomicAdd(&(bar)[XB_TMO], 1u); break; } } } } while (0)
struct XcdBarrier { unsigned* bar; unsigned x; volatile LAS unsigned* st; };
__device__ __forceinline__ XcdBarrier xcd_barrier_post(unsigned* bar, volatile LAS unsigned* st) {
    XcdBarrier b; b.bar = bar; b.x = xb_xcc_id(); b.st = st;
    if (threadIdx.x == 0) (void)xb_add(&bar[XB_XCNT(b.x)], 1u);
    return b;
}
__device__ __forceinline__ void xcd_barrier_complete(unsigned* bar, unsigned x, unsigned& nloc, unsigned& nx) {
    const unsigned G = gridDim.x * gridDim.y * gridDim.z;
    unsigned sum, cnt, mine, sp = 0u;
    for (;;) {
        sum = 0u; cnt = 0u; mine = 0u;
#pragma unroll
        for (unsigned j = 0; j < 16; ++j) { const unsigned c = xb_ld(&bar[XB_XCNT(j)]); sum += c; cnt += (c > 0u) ? 1u : 0u; mine = (j == x) ? c : mine; }
        if (sum == G) break;
        __builtin_amdgcn_s_sleep(1);
        if ((++sp & 255u) == 0u) { if (xb_ld(&bar[XB_TMO])) break; if (sp > XB_SPIN_CAP) { atomicAdd(&bar[XB_TMO], 1u); break; } }
    }
    nloc = mine > 0u ? mine : 1u; nx = cnt > 0u ? cnt : 1u;
}
__device__ __forceinline__ void xcd_barrier(const XcdBarrier& b) {
    asm volatile("s_waitcnt vmcnt(0)" ::: "memory");
    __syncthreads();
    if (threadIdx.x == 0) {
        unsigned* bar = b.bar;
        __builtin_amdgcn_s_waitcnt(0);
        unsigned nloc = b.st[0], nx = b.st[1];
        if (nloc == 0u) { xcd_barrier_complete(bar, b.x, nloc, nx); b.st[0] = nloc; b.st[1] = nx; }
        const unsigned old = xb_add(&bar[XB_XSUB(b.x)], 1u);
        const unsigned gen = old / nloc;
        if (old + 1u == (gen + 1u) * nloc) {
            __builtin_amdgcn_fence(__ATOMIC_RELEASE, "agent");
            asm volatile("s_waitcnt vmcnt(0)" ::: "memory");
            const unsigned og = xb_add(&bar[XB_TOP], 1u);
            const unsigned tg = og / nx;
            if (og + 1u == (tg + 1u) * nx) xb_add(&bar[XB_TOPGEN], 1u);
            else XB_SPIN(xb_ld(&bar[XB_TOPGEN]) == tg, bar);
            __builtin_amdgcn_fence(__ATOMIC_ACQUIRE, "agent");
            xb_add(&bar[XB_XGEN(b.x)], 1u);
            asm volatile("s_waitcnt vmcnt(0)" ::: "memory");
        } else {
            XB_SPIN(xb_ld(&bar[XB_XGEN(b.x)]) == gen, bar);
            __builtin_amdgcn_fence(__ATOMIC_ACQUIRE, "agent");
            asm volatile("s_waitcnt vmcnt(0)" ::: "memory");
        }
    }
    __syncthreads();
}

#define G_ABYTES (128 * 128)
#define G_BBYTES (64 * 256)
#define G_STAGE (G_ABYTES + G_BBYTES)
#define SM_BAR 73728
#define SM_TAB (SM_BAR + 16)
#define SMEM_BYTES (SM_TAB + 512)
__device__ __forceinline__ int bswz(int k) { return ((k & 3) << 2) | ((k >> 2) & 3); }

__device__ __forceinline__ void glds16_asm(const void* gsrc, unsigned lds_dst) {
    unsigned keep;
    asm volatile("s_mov_b32 %0, m0\n\ts_mov_b32 m0, %2\n\ts_nop 0\n\tglobal_load_lds_dwordx4 %1, off\n\ts_mov_b32 m0, %0" : "=&s"(keep) : "v"(gsrc), "s"(lds_dst) : "memory");
}
template <class AF, class BF>
__device__ __forceinline__ void gemm_tile(char* smem, int nk, const AF& af, const BF& bf, f32x4 (&acc)[4][4]) {
    const int tid = ltid(), lane = tid & 63, wid = tid >> 6, wm = wid >> 1, wn = wid & 1;
#pragma unroll
    for (int i = 0; i < 4; ++i)
#pragma unroll
        for (int j = 0; j < 4; ++j) acc[i][j] = (f32x4){0.f, 0.f, 0.f, 0.f};
    const int arow = tid >> 3, akc = (((tid & 7) ^ (arow & 7)) << 3), brow = tid >> 4, bnc = (((tid & 15) ^ bswz(brow)) << 3);
    int ainfo[4];
#pragma unroll
    for (int i = 0; i < 4; ++i) ainfo[i] = af.info(arow + 32 * i);
    const unsigned lds0 = (unsigned)__builtin_amdgcn_readfirstlane((int)((unsigned)(size_t)smem + (unsigned)(wid * 1024)));
    auto issue = [&](int kt, int buf) {
        const unsigned dst = lds0 + (unsigned)(buf * G_STAGE);
#pragma unroll
        for (int i = 0; i < 4; ++i) glds16_asm(af.ptr(ainfo[i], arow + 32 * i, kt * 64 + akc), dst + i * 4096);
#pragma unroll
        for (int i = 0; i < 4; ++i) glds16_asm(bf.ptr(kt * 64 + brow + 16 * i, bnc), dst + G_ABYTES + i * 4096);
    };
    const int ar = wm * 64 + (lane & 15), ax = lane & 7, ag = lane >> 4;
    const int bg = lane >> 4, bq = (lane & 15) >> 2, bp = lane & 3;
    __syncthreads();
    issue(0, 0);
    asm volatile("s_waitcnt vmcnt(0)" ::: "memory");
    __syncthreads();
    for (int kt = 0; kt < nk; ++kt) {
        if (kt + 1 < nk) issue(kt + 1, (kt + 1) & 1);
        const char* sa = smem + (kt & 1) * G_STAGE; const char* sb = sa + G_ABYTES;
#pragma unroll
        for (int ks = 0; ks < 2; ++ks) {
            bf16x8 a[4], b[4];
#pragma unroll
            for (int mt = 0; mt < 4; ++mt) a[mt] = *(const bf16x8*)(sa + (ar + mt * 16) * 128 + (((4 * ks + ag) ^ ax) << 4));
#pragma unroll
            for (int nt = 0; nt < 4; ++nt) {
                const int c2 = 2 * (wn * 4 + nt) + (bp >> 1);
                const int k0 = 32 * ks + 8 * bg + bq, k1 = k0 + 4;
                const s16x4 lo = __builtin_amdgcn_ds_read_tr16_b64_v4i16((LAS s16x4*)(sb + k0 * 256 + ((c2 ^ bswz(k0)) << 4) + 8 * (bp & 1)));
                const s16x4 hi = __builtin_amdgcn_ds_read_tr16_b64_v4i16((LAS s16x4*)(sb + k1 * 256 + ((c2 ^ bswz(k1)) << 4) + 8 * (bp & 1)));
                b[nt] = __builtin_shufflevector(lo, hi, 0, 1, 2, 3, 4, 5, 6, 7);
            }
            __builtin_amdgcn_s_setprio(1);
#pragma unroll
            for (int mt = 0; mt < 4; ++mt)
#pragma unroll
                for (int nt = 0; nt < 4; ++nt) acc[mt][nt] = __builtin_amdgcn_mfma_f32_16x16x32_bf16(b[nt], a[mt], acc[mt][nt], 0, 0, 0);
            __builtin_amdgcn_s_setprio(0);
        }
        asm volatile("s_waitcnt vmcnt(0)" ::: "memory");
        __syncthreads();
    }
}
#define GW_ABYTES (128 * 64)
#define GW_BBYTES (32 * 512)
#define GW_STAGE (GW_ABYTES + GW_BBYTES)
template <class AF, class BF>
__device__ __forceinline__ void gemm_tile_w(char* smem, int nk, const AF& af, const BF& bf, f32x4 (&acc)[4][8]) {
    const int tid = ltid(), lane = tid & 63, wid = tid >> 6, wm = wid >> 1, wn = wid & 1;
#pragma unroll
    for (int i = 0; i < 4; ++i)
#pragma unroll
        for (int j = 0; j < 8; ++j) acc[i][j] = (f32x4){0.f, 0.f, 0.f, 0.f};
    const int arow = tid >> 2, akc = (((tid & 3) ^ (((tid >> 4) & 1) * 3)) << 3), brow = tid >> 5;
    int ainfo[2];
#pragma unroll
    for (int i = 0; i < 2; ++i) ainfo[i] = af.info(arow + 64 * i);
    const unsigned lds0 = (unsigned)__builtin_amdgcn_readfirstlane((int)((unsigned)(size_t)smem + (unsigned)(wid * 1024)));
    auto issue = [&](int kt, int buf) {
        const unsigned dst = lds0 + (unsigned)(buf * GW_STAGE);
#pragma unroll
        for (int i = 0; i < 2; ++i) glds16_asm(af.ptr(ainfo[i], arow + 64 * i, kt * 32 + akc), dst + i * 4096);
#pragma unroll
        for (int i = 0; i < 4; ++i) { const int g = ((tid >> 5) & 3) | ((i & 1) << 2);
            glds16_asm(bf.ptr(kt * 32 + brow + 8 * i, (((tid & 31) ^ (g << 1)) << 3)), dst + GW_ABYTES + i * 4096); }
    };
    const int ar = wm * 64 + (lane & 15), axw = ((lane >> 2) & 1) * 3, ag = lane >> 4;
    const int bg = lane >> 4, bq = (lane & 15) >> 2, bp = lane & 3, bgk = bq | ((bg & 1) << 2);
    __syncthreads();
    issue(0, 0); if (nk > 1) issue(1, 1);
    if (nk > 1) asm volatile("s_waitcnt vmcnt(6)" ::: "memory"); else asm volatile("s_waitcnt vmcnt(0)" ::: "memory");
    __syncthreads();
    int st = 0;
    for (int kt = 0; kt < nk; ++kt) {
        if (kt + 2 < nk) { int s2 = st + 2; if (s2 >= 3) s2 -= 3; issue(kt + 2, s2); }
        const char* sa = smem + st * GW_STAGE; const char* sb = sa + GW_ABYTES;
        bf16x8 a[4];
#pragma unroll
        for (int mt = 0; mt < 4; ++mt) a[mt] = *(const bf16x8*)(sa + (ar + mt * 16) * 64 + ((ag ^ axw) << 4));
#pragma unroll
        for (int nh = 0; nh < 2; ++nh) {
            bf16x8 b[4];
#pragma unroll
            for (int n4 = 0; n4 < 4; ++n4) {
                const int c2 = 2 * (wn * 8 + nh * 4 + n4) + (bp >> 1);
                const int k0 = 8 * bg + bq, k1 = k0 + 4;
                const s16x4 lo = __builtin_amdgcn_ds_read_tr16_b64_v4i16((LAS s16x4*)(sb + k0 * 512 + ((c2 ^ (bgk << 1)) << 4) + 8 * (bp & 1)));
                const s16x4 hi = __builtin_amdgcn_ds_read_tr16_b64_v4i16((LAS s16x4*)(sb + k1 * 512 + ((c2 ^ (bgk << 1)) << 4) + 8 * (bp & 1)));
                b[n4] = __builtin_shufflevector(lo, hi, 0, 1, 2, 3, 4, 5, 6, 7);
            }
            __builtin_amdgcn_s_setprio(1);
#pragma unroll
            for (int mt = 0; mt < 4; ++mt)
#pragma unroll
                for (int n4 = 0; n4 < 4; ++n4) acc[mt][nh * 4 + n4] = __builtin_amdgcn_mfma_f32_16x16x32_bf16(b[n4], a[mt], acc[mt][nh * 4 + n4], 0, 0, 0);
            __builtin_amdgcn_s_setprio(0);
        }
        if (kt + 2 < nk) asm volatile("s_waitcnt vmcnt(6)" ::: "memory"); else asm volatile("s_waitcnt vmcnt(0)" ::: "memory");
        __syncthreads();
        if (++st == 3) st = 0;
    }
}
#define EPI_FORW(acc, ...) do { const int _l = ltid() & 63, _w = ltid() >> 6, _wm = _w >> 1, _wn = _w & 1; \
    _Pragma("unroll") for (int _mt = 0; _mt < 4; ++_mt) _Pragma("unroll") for (int _nt = 0; _nt < 8; ++_nt) { \
        const int row = _wm * 64 + _mt * 16 + (_l & 15), col = _wn * 128 + _nt * 16 + 4 * (_l >> 4); const f32x4 v = acc[_mt][_nt]; __VA_ARGS__ } } while (0)
#define EPI_FOR(acc, ...) do { const int _l = ltid() & 63, _w = ltid() >> 6, _wm = _w >> 1, _wn = _w & 1; \
    _Pragma("unroll") for (int _mt = 0; _mt < 4; ++_mt) _Pragma("unroll") for (int _nt = 0; _nt < 4; ++_nt) { \
        const int row = _wm * 64 + _mt * 16 + (_l & 15), col = _wn * 64 + _nt * 16 + 4 * (_l >> 4); const f32x4 v = acc[_mt][_nt]; __VA_ARGS__ } } while (0)

__device__ __forceinline__ u32x4 pack_pair(f32x4 va, f32x4 vb) {
    uint32_t ax = pk2(va[0], va[1]), ay = pk2(va[2], va[3]), bx = pk2(vb[0], vb[1]), by = pk2(vb[2], vb[3]);
    asm volatile("s_nop 1\n\tv_permlane16_swap_b32 %0, %1" : "+v"(ax), "+v"(bx));
    asm volatile("s_nop 1\n\tv_permlane16_swap_b32 %0, %1" : "+v"(ay), "+v"(by));
    return (u32x4){ax, ay, bx, by};
}
__device__ __forceinline__ void st_bf8_pair(bf16_t* pair_base_of_row, f32x4 va, f32x4 vb, int g) {
    uint32_t ax = pk2(va[0], va[1]), ay = pk2(va[2], va[3]), bx = pk2(vb[0], vb[1]), by = pk2(vb[2], vb[3]);
    asm volatile("s_nop 1\n\tv_permlane16_swap_b32 %0, %1" : "+v"(ax), "+v"(bx));
    asm volatile("s_nop 1\n\tv_permlane16_swap_b32 %0, %1" : "+v"(ay), "+v"(by));
    *(u32x4*)(pair_base_of_row + (g & 1) * 16 + (g >> 1) * 8) = (u32x4){ax, ay, bx, by};
}
#define EPI_FORW2(acc, ...) do { const int _l = ltid() & 63, _w = ltid() >> 6, _wm = _w >> 1, _wn = _w & 1; \
    _Pragma("unroll") for (int _mt = 0; _mt < 4; ++_mt) _Pragma("unroll") for (int _np = 0; _np < 4; ++_np) { \
        const int row = _wm * 64 + _mt * 16 + (_l & 15), pcol = _wn * 128 + _np * 32, g = _l >> 4; const f32x4 va = acc[_mt][2 * _np], vb = acc[_mt][2 * _np + 1]; __VA_ARGS__ } } while (0)
#define EPI_FOR2(acc, ...) do { const int _l = ltid() & 63, _w = ltid() >> 6, _wm = _w >> 1, _wn = _w & 1; \
    _Pragma("unroll") for (int _mt = 0; _mt < 4; ++_mt) _Pragma("unroll") for (int _np = 0; _np < 2; ++_np) { \
        const int row = _wm * 64 + _mt * 16 + (_l & 15), pcol = _wn * 64 + _np * 32, g = _l >> 4; const f32x4 va = acc[_mt][2 * _np], vb = acc[_mt][2 * _np + 1]; __VA_ARGS__ } } while (0)


__device__ __forceinline__ void st_bf4(bf16_t* p, f32x4 v) { u32x2 w; w.x = pk2(v[0], v[1]); w.y = pk2(v[2], v[3]); *(u32x2*)p = w; }
__device__ __forceinline__ void st_bf4_nt(bf16_t* p, f32x4 v) { u32x2 w; w.x = pk2(v[0], v[1]); w.y = pk2(v[2], v[3]); __builtin_nontemporal_store(w, (u32x2*)p); }

struct W2Conv {
    const float* src; bf16_t* dst; int nslices, wg, nwg; f32x4 r[8];
    static constexpr size_t N4 = (size_t)32 * 512 * 1024 / 4;
    __device__ __forceinline__ size_t item(int i, int k) const { return ((size_t)(k * nslices + i) * nwg + wg) * 256 + ltid(); }
    __device__ __forceinline__ void load(int i) {
        if (i >= nslices) return;
#pragma unroll
        for (int k = 0; k < 8; ++k) { const size_t it = item(i, k); if (it < N4) r[k] = __builtin_nontemporal_load((const f32x4*)(src + 4 * it)); }
    }
    __device__ __forceinline__ void store(int i) {
        if (i >= nslices) return;
#pragma unroll
        for (int k = 0; k < 8; ++k) { const size_t it = item(i, k); if (it < N4) st_bf4(dst + 4 * it, r[k]); }
    }
};

struct APlain { const bf16_t* base; int lda; int m0; __device__ __forceinline__ int info(int row) const { return m0 + row; }
    __device__ __forceinline__ const bf16_t* ptr(int gr, int, int k) const { return base + (size_t)gr * lda + k; } };
struct BPlain { const bf16_t* base; int ldb; __device__ __forceinline__ const bf16_t* ptr(int k, int n) const { return base + (size_t)k * ldb + n; } };

enum { PH_PROLOGUE = 0, PH_MOD_MIX, PH_E2, PH_E3, PH_E4, PH_SCAN, PH_POST, PH_WOUT, PH_F1, PH_F2, PH_F3, PH_WF, PH_MOD_FFN, PH_ROUTER, PH_MOE1, PH_MOE2, PH_FINAL, PH_SCANV, PH_ROUTERV, PH_WOUTV, PH_S1A, PH_S2A, PH_S1B, PH_S2B, PH_FFNR };

#ifndef SCANVAR
#define SCANVAR 0
#endif

#define WSP(T, off) ((T*)(p.ws + (off)))

__device__ __forceinline__ void phase_prologue(const Params& p, char* smem, int wg, int nwg) {
    if (wg == nwg - 1 && ltid() < 128) WSP(int, OFF_CNTS)[(ltid() >> 5) * 32 * CNTS_STRIDE + (ltid() & 31) * CNTS_STRIDE] = 0;
    const int tid = ltid(), lane = tid & 63, wv = tid >> 6;
    float* S = (float*)smem;
    float* RED = S + 5 * 1024;
    for (int idx = tid; idx < 5 * 1024; idx += 256) { const int rb = idx >> 10, k = idx & 1023; const float cv = rb < 4 ? p.c[rb * 1024 + k] : p.c_ctx[k]; S[idx] = cv / (1.f + expf(-cv)); }
    __syncthreads();
    float* mod = WSP(float, OFF_MOD);
    for (int task = wg; task < 384; task += nwg) {
        const int i = task / 96, n0 = (task % 96) * 64;
        const float* W = p.ada_w + (size_t)i * 1024 * 6144 + n0 + lane;
        float a0 = 0.f, a1 = 0.f, a2 = 0.f, a3 = 0.f, a4 = 0.f;
        for (int k = wv * 256; k < wv * 256 + 256; k += 8) {
            float w[8];
#pragma unroll
            for (int u = 0; u < 8; ++u) w[u] = __builtin_nontemporal_load(W + (size_t)(k + u) * 6144);
#pragma unroll
            for (int u = 0; u < 8; ++u) { a0 += S[k + u] * w[u]; a1 += S[1024 + k + u] * w[u]; a2 += S[2048 + k + u] * w[u]; a3 += S[3072 + k + u] * w[u]; a4 += S[4096 + k + u] * w[u]; }
        }
        RED[(wv * 5 + 0) * 64 + lane] = a0; RED[(wv * 5 + 1) * 64 + lane] = a1; RED[(wv * 5 + 2) * 64 + lane] = a2; RED[(wv * 5 + 3) * 64 + lane] = a3; RED[(wv * 5 + 4) * 64 + lane] = a4;
        __syncthreads();
        for (int o = tid; o < 320; o += 256) { const int r = o >> 6, l = o & 63;
            const float s = RED[(0 * 5 + r) * 64 + l] + RED[(1 * 5 + r) * 64 + l] + RED[(2 * 5 + r) * 64 + l] + RED[(3 * 5 + r) * 64 + l];
            mod[(size_t)(r * 4 + i) * 6144 + n0 + l] = s + p.ada_b[i * 6144 + n0 + l]; }
        __syncthreads();
    }
    const size_t gt = (size_t)wg * 256 + tid, gs = (size_t)nwg * 256;
    char* wts = p.ws + OFF_WTS;
    auto cast4 = [&](const float* src, bf16_t* dst, size_t n4) { for (size_t i = gt; i < n4 / 2; i += gs) { const f32x4 a = __builtin_nontemporal_load((const f32x4*)(src + 8 * i)), b = __builtin_nontemporal_load((const f32x4*)(src + 8 * i + 4));
        *(u32x4*)(dst + 8 * i) = (u32x4){pk2(a[0], a[1]), pk2(a[2], a[3]), pk2(b[0], b[1]), pk2(b[2], b[3])}; } };
    cast4(p.w_in, (bf16_t*)(wts + W_WIN), (size_t)2 * 1024 * 2048 / 4);
    cast4(p.w_out, (bf16_t*)(wts + W_WOUT), (size_t)2 * 1024 * 1024 / 4);
    cast4(p.w_fourier, (bf16_t*)(wts + W_WF), (size_t)2 * 1024 * 1024 / 4);
    cast4(p.pool_w, (bf16_t*)(wts + W_POOL), (size_t)2 * 512 * 128 / 4);
    {
        bf16_t* d = (bf16_t*)(wts + W_LR1);
        for (size_t i = gt; i < (size_t)2 * 2048 * 384; i += gs) {
            const int n = (int)(i % 384), kk = (int)((i / 384) % 2048), j = (int)(i / (384 * 2048)); const int k = kk & 1023;
            float w, mu;
            if (n < 128) { const int dd = n >> 6; w = p.decay_w1[((size_t)(j * 2 + dd) * 1024 + k) * 64 + (n & 63)]; mu = p.mu_x[(j * 3 + 0) * 1024 + k]; }
            else if (n < 256) { const int dd = (n - 128) >> 6; w = p.lr_a1[((size_t)(j * 2 + dd) * 1024 + k) * 64 + (n & 63)]; mu = p.mu_x[(j * 3 + 1) * 1024 + k]; }
            else { w = p.gate_g1[((size_t)j * 1024 + k) * 128 + (n - 256)]; mu = p.mu_x[(j * 3 + 2) * 1024 + k]; }
            d[i] = f2bf(kk < 1024 ? (1.f - mu) * w : mu * w);
        }
    }
    {
        bf16_t* d = (bf16_t*)(wts + W_LR2);
        for (size_t i = gt; i < (size_t)2 * 384 * 512; i += gs) {
            const int n = (int)(i % 512), k = (int)((i / 512) % 384), j = (int)(i / (512 * 384));
            float w;
            if (k < 128) w = p.decay_w2[((size_t)(j * 2 + (k >> 6)) * 64 + (k & 63)) * 512 + n];
            else if (k < 256) w = p.lr_a2[((size_t)(j * 2 + ((k - 128) >> 6)) * 64 + (k & 63)) * 512 + n];
            else w = p.gate_g2[((size_t)j * 128 + (k - 256)) * 512 + n];
            d[i] = f2bf(w);
        }
    }
    {
        uint32_t* d = (uint32_t*)(wts + W_RW);
        for (size_t i = gt; i < (size_t)4 * 4608 * 4; i += gs) {
            const int l = (int)(i / 18432), q = (int)(i % 18432) >> 2, k = (int)(i & 3);
            float w0, w1;
            if (q < 4096) { const int ln = q & 63, hf = (q >> 6) & 1, pp = (q >> 7) & 7, gi = q >> 10; const int c0 = 4 * ln + 256 * (pp >> 1) + 2 * (pp & 1), x = gi * 8 + hf * 4 + k;
                w0 = p.router_f[((size_t)l * 1024 + c0) * 32 + x]; w1 = p.router_f[((size_t)l * 1024 + c0 + 1) * 32 + x]; }
            else { const int q2 = q - 4096, ln = q2 & 63, pp = q2 >> 6; const int c0 = 4 * ln + 256 * (pp >> 1) + 2 * (pp & 1);
                w0 = p.router_c[((size_t)l * 1024 + c0) * 4 + k]; w1 = p.router_c[((size_t)l * 1024 + c0 + 1) * 4 + k]; }
            d[i] = pk2(w0, w1);
        }
    }
    {
        bf16_t* d = (bf16_t*)(wts + W_DFTC);
        for (size_t i = gt; i < (size_t)256 * 512; i += gs) { const int n = (int)(i & 511), c = (int)(i >> 9); const int idx = (c * (n & 255)) & 255; float sn, cs; sincospif((float)idx / 128.f, &sn, &cs); d[i] = f2bf(n < 256 ? cs : -sn); }
    }
    {
        bf16_t* d = (bf16_t*)(wts + W_TW);
        for (size_t i = gt; i < (size_t)128 * 128 * 128; i += gs) {
            const int col = (int)(i & 127), row = (int)((i >> 7) & 127), t2 = (int)(i >> 14);
            const int pp = row >> 6, f1 = row & 63, pi = col >> 6, t1 = col & 63; const int idx = (t1 * f1 * 128 + t2 * f1) & 8191;
            float sn, cs; sincospif((float)idx / 4096.f, &sn, &cs);
            d[i] = f2bf(pp == 0 ? (pi == 0 ? cs : sn) : (pi == 0 ? -sn : cs));
        }
    }
    {
        bf16_t* d = (bf16_t*)(wts + W_CS128);
        for (size_t i = gt; i < (size_t)128 * 256; i += gs) { const int col = (int)(i & 255), f2 = (int)(i >> 8); const int pi = col >> 7, t2 = col & 127, idx = (t2 * f2) & 127; float sn, cs; sincospif((float)idx / 64.f, &sn, &cs); d[i] = f2bf(pi == 0 ? cs : sn); }
    }
    {
        bf16_t* d = (bf16_t*)(wts + W_CS256);
        for (size_t i = gt; i < (size_t)256 * 512; i += gs) { const int col = (int)(i & 511), f = (int)(i >> 9); const int pi = col >> 8, t = col & 255, idx = (t * f) & 255; float sn, cs; sincospif((float)idx / 128.f, &sn, &cs); d[i] = f2bf(pi == 0 ? cs : sn); }
    }
}

template <int MODE>
__device__ __forceinline__ void phase_modulate(const Params& p, int layer, int nrows, bool first, bool combine, int wg, int nwg) {
    const int lane = ltid() & 63, wv = ltid() >> 6;
    float* RES = WSP(float, OFF_RES);
    const float* mod = WSP(float, OFF_MOD);
    bf16_t* H = WSP(bf16_t, OFF_HREG); bf16_t* HLO = WSP(bf16_t, OFF_KD);
    const bf16_t* YM = WSP(bf16_t, OFF_PREG);
    const int* routei = WSP(int, OFF_ROUTEI); const float* routeg = WSP(float, OFF_ROUTEG);
    const int* poff = WSP(int, OFF_POFF) + (MODE == 2 ? 3 : layer - 1) * 64;
    const int lprev = MODE == 2 ? 3 : layer - 1;
    for (int r = wg * 4 + wv; r < nrows; r += nwg * 4) {
        const float* src = first ? (r < NL ? p.x + (size_t)r * 1024 : p.ctx + (size_t)(r - NL) * 1024) : RES + (size_t)r * 1024;
        f32x4 v[4];
#pragma unroll
        for (int j = 0; j < 4; ++j) v[j] = *(const f32x4*)(src + 4 * lane + 256 * j);
        const int mb = r < NL ? (r >> 13) : 4;
        if (combine) {
            const int i0 = routei[2 * r], i1 = routei[2 * r + 1]; const float g0 = routeg[2 * r], g1 = routeg[2 * r + 1];
            const size_t row0 = (size_t)poff[i0 & 31] + (i0 >> 5), row1 = (size_t)poff[i1 & 31] + (i1 >> 5);
            const float* m5 = mod + (size_t)(mb * 4 + lprev) * 6144 + 5 * 1024;
#pragma unroll
            for (int j = 0; j < 4; ++j) {
                const u32x2 y0 = *(const u32x2*)(YM + row0 * 1024 + 4 * lane + 256 * j), y1 = *(const u32x2*)(YM + row1 * 1024 + 4 * lane + 256 * j);
                const f32x4 g = *(const f32x4*)(m5 + 4 * lane + 256 * j);
                v[j][0] += g[0] * (g0 * bflo(y0.x) + g1 * bflo(y1.x)); v[j][1] += g[1] * (g0 * bfhi(y0.x) + g1 * bfhi(y1.x));
                v[j][2] += g[2] * (g0 * bflo(y0.y) + g1 * bflo(y1.y)); v[j][3] += g[3] * (g0 * bfhi(y0.y) + g1 * bfhi(y1.y));
            }
        }
        if (combine && MODE != 2) {
#pragma unroll
            for (int j = 0; j < 4; ++j) *(f32x4*)(RES + (size_t)r * 1024 + 4 * lane + 256 * j) = v[j];
        }
        float ss = 0.f;
#pragma unroll
        for (int j = 0; j < 4; ++j) ss += (v[j][0] * v[j][0] + v[j][1] * v[j][1]) + (v[j][2] * v[j][2] + v[j][3] * v[j][3]);
        ss = wave_sum(ss);
        const float rinv = frsq(ss * (1.f / 1024.f) + 1e-6f);
        if (MODE == 2) {
#if DIAG
            if (!(ss < 3.0e38f)) {
#pragma unroll
                for (int j = 0; j < 4; ++j) *(f32x4*)(p.out + (size_t)r * 1024 + 4 * lane + 256 * j) = (f32x4){3.f, 3.f, 3.f, 3.f};
                continue;
            }
#endif
#pragma unroll
            for (int j = 0; j < 4; ++j) { const f32x4 g = *(const f32x4*)(p.final_norm + 4 * lane + 256 * j); f32x4 o; o[0] = v[j][0] * rinv * g[0]; o[1] = v[j][1] * rinv * g[1]; o[2] = v[j][2] * rinv * g[2]; o[3] = v[j][3] * rinv * g[3];
                *(f32x4*)(p.out + (size_t)r * 1024 + 4 * lane + 256 * j) = o; }
        } else {
            const float* gn = (MODE == 0 ? p.norm_mix : p.norm_ffn) + layer * 1024;
            const float* sh = mod + (size_t)(mb * 4 + layer) * 6144 + (MODE == 0 ? 0 : 3) * 1024;
            const float* sc = sh + 1024;
#pragma unroll
            for (int j = 0; j < 4; ++j) {
                const int c = 4 * lane + 256 * j;
                const f32x4 g = *(const f32x4*)(gn + c), s1 = *(const f32x4*)(sh + c), s2 = *(const f32x4*)(sc + c);
                f32x4 h;
#pragma unroll
                for (int e = 0; e < 4; ++e) h[e] = (v[j][e] * rinv * g[e]) * (1.f + s2[e]) + s1[e];
                u32x2 w; w.x = pk2(h[0], h[1]); w.y = pk2(h[2], h[3]);
                *(u32x2*)(H + (size_t)r * 1024 + c) = w;
                if (MODE == 1 && ROUTER_NK > 32) { u32x2 w2; w2.x = pk2(h[0] - bflo(w.x), h[1] - bfhi(w.x)); w2.y = pk2(h[2] - bflo(w.y), h[3] - bfhi(w.y)); *(u32x2*)(HLO + (size_t)r * 1024 + c) = w2; }
            }
        }
    }
}


template <int MODE, bool COMBINE>
__device__ __forceinline__ void phase_modpipe(const Params& p, int layer, int nrows, int wg, int nwg) {
    const int tid = ltid(), lane = tid & 63, wv = __builtin_amdgcn_readfirstlane(tid >> 6);
    float* RES = WSP(float, OFF_RES);
    const float* mod = WSP(float, OFF_MOD);
    bf16_t* H = WSP(bf16_t, OFF_HREG);
    const bf16_t* YM = WSP(bf16_t, OFF_PREG);
    const int* routei = WSP(int, OFF_ROUTEI); const float* routeg = WSP(float, OFF_ROUTEG);
    const int lprev = MODE == 2 ? 3 : layer - 1;
    int poffv = 0;
    if (COMBINE) poffv = (WSP(int, OFF_POFF) + lprev * 64)[lane & 31];
    const int rstep = nwg * 4, rlast = nrows - 1;
    int r = wg * 4 + wv;
    if (r >= nrows) return;
    const float* gn = MODE == 2 ? p.final_norm : p.norm_mix + layer * 1024;
    f32x4 A[4], B[4], G5[4]; int mbc = -1;
    u32x2 ri[2] = {{0u, 0u}, {0u, 0u}}; f32x2_ rg[2] = {{0.f, 0.f}, {0.f, 0.f}};
    f32x4 v[2][4]; u32x2 ya[2][4], yb[2][4]; float g0[2] = {0.f, 0.f}, g1[2] = {0.f, 0.f};
#define MP_SRC(rr) (COMBINE ? RES + (size_t)(rr) * 1024 : ((rr) < NL ? p.x + (size_t)(rr) * 1024 : p.ctx + (size_t)((rr) - NL) * 1024))
#define MP_ISSUE(rr, Q) do { \
        const float* src_ = MP_SRC(rr); \
        _Pragma("unroll") for (int j = 0; j < 4; ++j) v[Q][j] = __builtin_nontemporal_load((const f32x4*)(src_ + 4 * lane + 256 * j)); \
        if (COMBINE) { const int i0 = __builtin_amdgcn_readfirstlane((int)ri[Q].x), i1 = __builtin_amdgcn_readfirstlane((int)ri[Q].y); \
            const size_t row0 = (size_t)__builtin_amdgcn_readlane(poffv, i0 & 31) + (i0 >> 5), row1 = (size_t)__builtin_amdgcn_readlane(poffv, i1 & 31) + (i1 >> 5); \
            _Pragma("unroll") for (int j = 0; j < 4; ++j) { ya[Q][j] = __builtin_nontemporal_load((const u32x2*)(YM + row0 * 1024 + 4 * lane + 256 * j)); yb[Q][j] = __builtin_nontemporal_load((const u32x2*)(YM + row1 * 1024 + 4 * lane + 256 * j)); } \
            g0[Q] = rg[Q].x; g1[Q] = rg[Q].y; } } while (0)
    if (COMBINE) { ri[0] = *(const u32x2*)(routei + 2 * r); rg[0] = *(const f32x2_*)(routeg + 2 * r);
        const int r1 = min(r + rstep, rlast); ri[1] = *(const u32x2*)(routei + 2 * r1); rg[1] = *(const f32x2_*)(routeg + 2 * r1); }
    MP_ISSUE(r, 0);
#define MP_STEP(Q) { \
        if (r >= nrows) break; \
        const int mb = r < NL ? (r >> 13) : 4; \
        if (mb != mbc) { mbc = mb; \
            const float* sh = mod + (size_t)(mb * 4 + layer) * 6144; const float* sc = sh + 1024; \
            const float* m5 = mod + (size_t)(mb * 4 + lprev) * 6144 + 5 * 1024; \
            _Pragma("unroll") for (int j = 0; j < 4; ++j) { const int c = 4 * lane + 256 * j; const f32x4 g = *(const f32x4*)(gn + c); \
                if (COMBINE) G5[j] = *(const f32x4*)(m5 + c); \
                if (MODE == 2) A[j] = g; \
                else { const f32x4 s1 = *(const f32x4*)(sh + c), s2 = *(const f32x4*)(sc + c); \
                    _Pragma("unroll") for (int e = 0; e < 4; ++e) { A[j][e] = g[e] * (1.f + s2[e]); B[j][e] = s1[e]; } } } \
        } \
        { const int r1 = min(r + rstep, rlast); MP_ISSUE(r1, 1 - (Q)); }                    \
        if (COMBINE) { const int r2 = min(r + 2 * rstep, rlast); ri[Q] = *(const u32x2*)(routei + 2 * r2); rg[Q] = *(const f32x2_*)(routeg + 2 * r2); }     \
        __builtin_amdgcn_sched_barrier(0); \
        if (COMBINE) { \
            _Pragma("unroll") for (int j = 0; j < 4; ++j) { \
                v[Q][j][0] += G5[j][0] * (g0[Q] * bflo(ya[Q][j].x) + g1[Q] * bflo(yb[Q][j].x)); v[Q][j][1] += G5[j][1] * (g0[Q] * bfhi(ya[Q][j].x) + g1[Q] * bfhi(yb[Q][j].x)); \
                v[Q][j][2] += G5[j][2] * (g0[Q] * bflo(ya[Q][j].y) + g1[Q] * bflo(yb[Q][j].y)); v[Q][j][3] += G5[j][3] * (g0[Q] * bfhi(ya[Q][j].y) + g1[Q] * bfhi(yb[Q][j].y)); \
            } \
            if (MODE != 2) { _Pragma("unroll") for (int j = 0; j < 4; ++j) __builtin_nontemporal_store(v[Q][j], (f32x4*)(RES + (size_t)r * 1024 + 4 * lane + 256 * j)); } \
        } \
        float ss = 0.f; \
        _Pragma("unroll") for (int j = 0; j < 4; ++j) ss += (v[Q][j][0] * v[Q][j][0] + v[Q][j][1] * v[Q][j][1]) + (v[Q][j][2] * v[Q][j][2] + v[Q][j][3] * v[Q][j][3]); \
        ss = wave_sum(ss); \
        const float rinv = frsq(ss * (1.f / 1024.f) + 1e-6f); \
        _Pragma("unroll") for (int j = 0; j < 4; ++j) { \
            const int c = 4 * lane + 256 * j; \
            if (MODE == 2) { f32x4 o; \
                _Pragma("unroll") for (int e = 0; e < 4; ++e) o[e] = v[Q][j][e] * rinv * A[j][e]; \
                __builtin_nontemporal_store(o, (f32x4*)(p.out + (size_t)r * 1024 + c)); \
            } else { float h[4]; \
                _Pragma("unroll") for (int e = 0; e < 4; ++e) h[e] = (v[Q][j][e] * rinv) * A[j][e] + B[j][e]; \
                u32x2 w; w.x = pk2(h[0], h[1]); w.y = pk2(h[2], h[3]); \
                *(u32x2*)(H + (size_t)r * 1024 + c) = w; } \
        } \
        r += rstep; }
    while (true) { MP_STEP(0) MP_STEP(1) }
#undef MP_STEP
#undef MP_SRC
#undef MP_ISSUE
}

typedef __bf16 bf2_t __attribute__((ext_vector_type(2)));
__device__ __forceinline__ float dot2bf(uint32_t a, uint32_t b, float c) { return __builtin_amdgcn_fdot2_f32_bf16(__builtin_bit_cast(bf2_t, a), __builtin_bit_cast(bf2_t, b), c, false); }
__device__ __forceinline__ void phase_ffn_route(const Params& p, char* smem, int layer, int nrows, int wg, int nwg) {
    const int tid = ltid(), lane = tid & 63, wv = __builtin_amdgcn_readfirstlane(tid >> 6);
    const float* RES = WSP(float, OFF_RES); const float* mod = WSP(float, OFF_MOD); bf16_t* H = WSP(bf16_t, OFF_HREG);
    int* cnt = WSP(int, OFF_CNTS) + layer * 32 * CNTS_STRIDE; int* routei = WSP(int, OFF_ROUTEI); float* routeg = WSP(float, OFF_ROUTEG); int* tokl = WSP(int, OFF_TOKL);
    {
        const u32x4* RT = (const u32x4*)(p.ws + OFF_WTS + W_RW) + (size_t)layer * 4608;
        for (int q = tid; q < 4608; q += 256) *(u32x4*)(smem + q * 16) = RT[q];
        if (tid < 32) { ((float*)(smem + SM_TAB))[tid] = p.router_f_b[layer * 32 + tid]; ((int*)(smem + SM_TAB + 128))[tid] = 0; }
    }
    __syncthreads();
    const float* gn = p.norm_ffn + layer * 1024;
    const bool hi32 = (lane & 32) != 0, hi16 = (lane & 16) != 0, hi8 = (lane & 8) != 0;
    const float cb0 = p.router_c_b[layer * 4 + 0], cb1 = p.router_c_b[layer * 4 + 1], cb2 = p.router_c_b[layer * 4 + 2], cb3 = p.router_c_b[layer * 4 + 3];
    int it = 0, sx1 = 0, sx2 = 0, sr = 0; float sga = 0.f, sgb = 0.f;
    auto flush = [&](int n) {
        if (lane < n) {
            const int p1 = atomicAdd(&cnt[sx1 * CNTS_STRIDE], 1), p2 = atomicAdd(&cnt[sx2 * CNTS_STRIDE], 1);
            tokl[(size_t)sx1 * TOKCAP + p1] = sr; tokl[(size_t)sx2 * TOKCAP + p2] = sr;
            routei[2 * sr] = (p1 << 5) | sx1; routei[2 * sr + 1] = (p2 << 5) | sx2; routeg[2 * sr] = sga; routeg[2 * sr + 1] = sgb;
        }
    };
    f32x4 A[4], B[4]; int mbc = -1;
    int r = wg * 4 + wv;
    const int rstep = nwg * 4;
    const int rlast = nrows - 1;
    f32x4 vv[3][4];
#pragma unroll
    for (int j = 0; j < 4; ++j) vv[0][j] = __builtin_nontemporal_load((const f32x4*)(RES + (size_t)(rlast - min(r, rlast)) * 1024 + 4 * lane + 256 * j));
#pragma unroll
    for (int j = 0; j < 4; ++j) vv[1][j] = __builtin_nontemporal_load((const f32x4*)(RES + (size_t)(rlast - min(r + rstep, rlast)) * 1024 + 4 * lane + 256 * j));
    while (r < nrows) {
#pragma unroll
      for (int P = 0; P < 3; ++P) {
        if (r >= nrows) break;
        const int rp = rlast - r; const int mb = rp < NL ? (rp >> 13) : 4;
        if (mb != mbc) { mbc = mb;
            const float* sh = mod + (size_t)(mb * 4 + layer) * 6144 + 3 * 1024; const float* sc = sh + 1024;
#pragma unroll
            for (int j = 0; j < 4; ++j) { const int c = 4 * lane + 256 * j; const f32x4 g = *(const f32x4*)(gn + c), s1 = *(const f32x4*)(sh + c), s2 = *(const f32x4*)(sc + c);
#pragma unroll
                for (int e = 0; e < 4; ++e) { A[j][e] = g[e] * (1.f + s2[e]); B[j][e] = s1[e]; } }
        }
        const int rn = rlast - min(r + 2 * rstep, rlast);
#pragma unroll
        for (int j = 0; j < 4; ++j) vv[(P + 2) % 3][j] = __builtin_nontemporal_load((const f32x4*)(RES + (size_t)rn * 1024 + 4 * lane + 256 * j));
        f32x4 (&v)[4] = vv[P];
        __builtin_amdgcn_sched_barrier(0);
        float ss = 0.f;
#pragma unroll
        for (int j = 0; j < 4; ++j) ss += (v[j][0] * v[j][0] + v[j][1] * v[j][1]) + (v[j][2] * v[j][2] + v[j][3] * v[j][3]);
        ss = wave_sum(ss);
        const float rinv = frsq(ss * (1.f / 1024.f) + 1e-6f);
        uint32_t hp[8];
#pragma unroll
        for (int j = 0; j < 4; ++j) {
            float h[4];
#pragma unroll
            for (int e = 0; e < 4; ++e) h[e] = (v[j][e] * rinv) * A[j][e] + B[j][e];
            u32x2 w; w.x = pk2(h[0], h[1]); w.y = pk2(h[2], h[3]); hp[2 * j] = w.x; hp[2 * j + 1] = w.y;
            *(u32x2*)(H + (size_t)rp * 1024 + 4 * lane + 256 * j) = w;
        }
        float c0 = 0.f, c1 = 0.f, c2 = 0.f, c3 = 0.f;
#pragma unroll
        for (int pp = 0; pp < 8; ++pp) { const u32x4 w = *(const u32x4*)(smem + 65536 + (pp * 64 + lane) * 16);
            c0 = dot2bf(hp[pp], w[0], c0); c1 = dot2bf(hp[pp], w[1], c1); c2 = dot2bf(hp[pp], w[2], c2); c3 = dot2bf(hp[pp], w[3], c3); }
        float m;
        { const float t0 = hi32 ? c0 : c2, t1 = hi32 ? c1 : c3;
          const float k0 = (hi32 ? c2 : c0) + __shfl_xor(t0, 32), k1 = (hi32 ? c3 : c1) + __shfl_xor(t1, 32);
          const float t = hi16 ? k0 : k1; m = (hi16 ? k1 : k0) + __shfl_xor(t, 16);
          m = sum16(m); }
        const float q0 = rl_(m, 0) + cb0, q1 = rl_(m, 16) + cb1, q2 = rl_(m, 32) + cb2, q3 = rl_(m, 48) + cb3;
        int gi = 0; float mx = q0;
        if (q1 > mx) { mx = q1; gi = 1; } if (q2 > mx) { mx = q2; gi = 2; } if (q3 > mx) { mx = q3; gi = 3; }
        const float gval = frcp(fexp(q0 - mx) + fexp(q1 - mx) + fexp(q2 - mx) + fexp(q3 - mx));
        float f[8];
#pragma unroll
        for (int x = 0; x < 8; ++x) f[x] = 0.f;
        const char* ft = smem + gi * 16384 + lane * 16;
#pragma unroll
        for (int pp = 0; pp < 8; ++pp)
#pragma unroll
            for (int hf = 0; hf < 2; ++hf) { const u32x4 w = *(const u32x4*)(ft + (pp * 2 + hf) * 1024);
#pragma unroll
                for (int x = 0; x < 4; ++x) f[hf * 4 + x] = dot2bf(hp[pp], w[x], f[hf * 4 + x]); }
        float n_;
        { float k[4];
#pragma unroll
          for (int x = 0; x < 4; ++x) { const float t = hi32 ? f[x] : f[x + 4]; k[x] = (hi32 ? f[x + 4] : f[x]) + __shfl_xor(t, 32); }
          float m2[2];
#pragma unroll
          for (int x = 0; x < 2; ++x) { const float t = hi16 ? k[x] : k[x + 2]; m2[x] = (hi16 ? k[x + 2] : k[x]) + __shfl_xor(t, 16); }
          const float t = hi8 ? m2[0] : m2[1]; n_ = (hi8 ? m2[1] : m2[0]) + __shfl_xor(t, 8);
          n_ = sum8(n_); }
        float lf[8]; float m1 = -3.0e38f, m2v = -3.0e38f; int e1 = 0, e2 = 0;
#pragma unroll
        for (int e = 0; e < 8; ++e) lf[e] = rl_(n_, 8 * e) + ((const float*)(smem + SM_TAB))[gi * 8 + e];
#pragma unroll
        for (int e = 0; e < 8; ++e) if (lf[e] > m1) { m1 = lf[e]; e1 = e; }
#pragma unroll
        for (int e = 0; e < 8; ++e) if (e != e1 && lf[e] > m2v) { m2v = lf[e]; e2 = e; }
        const float qq = fexp(m2v - m1), rq = frcp(1.f + qq);
        if (lane == it) { sx1 = gi * 8 + e1; sx2 = gi * 8 + e2; sga = gval * rq; sgb = gval * qq * rq; sr = rp; }
        if (++it == 64) { flush(64); it = 0; }
        r += rstep;
      }
    }
    {
        int* hist = (int*)(smem + SM_TAB + 128); int* hbase = hist + 32;
        int l1 = 0, l2 = 0;
        if (lane < it) { l1 = atomicAdd(&hist[sx1], 1); l2 = atomicAdd(&hist[sx2], 1); }
        __syncthreads();
        if (tid < 32) { const int c = hist[tid]; hbase[tid] = c ? atomicAdd(&cnt[tid * CNTS_STRIDE], c) : 0; }
        __syncthreads();
        if (lane < it) {
            const int p1 = hbase[sx1] + l1, p2 = hbase[sx2] + l2;
            tokl[(size_t)sx1 * TOKCAP + p1] = sr; tokl[(size_t)sx2 * TOKCAP + p2] = sr;
            routei[2 * sr] = (p1 << 5) | sx1; routei[2 * sr + 1] = (p2 << 5) | sx2; routeg[2 * sr] = sga; routeg[2 * sr + 1] = sgb;
        }
    }
}

struct AShift { const bf16_t* H; const bf16_t* zero; int m0;
    __device__ __forceinline__ int info(int row) const {
        const int r = m0 + row; int bits, ctx;
        if (r < NL) { const int t = r & 8191, col = t & 63, rw = t >> 6; bits = (col > 0 ? 1 : 0) | (col < 63 ? 2 : 0) | (rw > 0 ? 4 : 0) | (rw < 127 ? 8 : 0); ctx = 0; }
        else { const int t = (r - NL) & 255; bits = (t > 0 ? 3 : 0) | (t < 255 ? 12 : 0); ctx = 1; }
        return r | (bits << 20) | (ctx << 24); }
    __device__ __forceinline__ const bf16_t* ptr(int inf, int, int k) const {
        const int gr = inf & 0xfffff;
        if (k < 1024) return H + (size_t)gr * 1024 + k;
        const int kk = k - 1024, q = kk >> 8; const bool ctx = (inf >> 24) & 1, ok = (inf >> (20 + q)) & 1;
        const int dl = ctx ? (q < 2 ? -1 : 1) : (q == 0 ? -1 : (q == 1 ? 1 : (q == 2 ? -64 : 64)));
        return ok ? H + (size_t)(gr + dl) * 1024 + kk : zero; } };

__device__ __forceinline__ void phase_e2(const Params& p, char* smem, int j, int nrows, int layer, int wg, int nwg) {
    const bf16_t* H = WSP(bf16_t, OFF_HREG); bf16_t* P = WSP(bf16_t, OFF_PREG); bf16_t* LR1 = WSP(bf16_t, OFF_LR1);
    const bf16_t* WIN = (const bf16_t*)(p.ws + OFF_WTS + W_WIN) + (size_t)j * 1024 * 2048;
    const bf16_t* WL1 = (const bf16_t*)(p.ws + OFF_WTS + W_LR1) + (size_t)j * 2048 * 384;
    const int nrt = nrows / 128, n1 = nrt, n2 = 2 * nrt, ntot = n2 + nrt * 8;
    f32x4 acc[4][4]; f32x4 accw[4][8];
    for (int t = wg; t < ntot; t += nwg) {
        if (t >= n2) {
            const int tp = t - n2, mt = tp >> 3, nt = tp & 7, m0 = mt * 128, n0 = nt * 256;
            gemm_tile_w(smem, 32, APlain{H, 1024, m0}, BPlain{WIN + n0, 2048}, accw);
            EPI_FORW2(accw, { st_bf8_pair(P + (size_t)(m0 + row) * 2048 + n0 + pcol, va, vb, g); });
        } else if (t < n1) {
            const int m0 = t * 128;
            gemm_tile_w(smem, 64, AShift{H, WSP(bf16_t, OFF_ZERO), m0}, BPlain{WL1, 384}, accw);
            EPI_FORW2(accw, { f32x4 oa, ob;
                _Pragma("unroll") for (int e = 0; e < 4; ++e) { oa[e] = pcol < 128 ? tanhf_(va[e]) : va[e]; ob[e] = pcol < 128 ? tanhf_(vb[e]) : vb[e]; }
                st_bf8_pair(LR1 + (size_t)(m0 + row) * 384 + pcol, oa, ob, g); });
        } else {
            const int m0 = (t - n1) * 128;
            gemm_tile(smem, 32, AShift{H, WSP(bf16_t, OFF_ZERO), m0}, BPlain{WL1 + 256, 384}, acc);
            EPI_FOR2(acc, { f32x4 oa, ob;
                _Pragma("unroll") for (int e = 0; e < 4; ++e) { oa[e] = sigmoidf_(va[e]); ob[e] = sigmoidf_(vb[e]); }
                st_bf8_pair(LR1 + (size_t)(m0 + row) * 384 + 256 + pcol, oa, ob, g); });
        }
    }
}

__device__ __forceinline__ void phase_e3(const Params& p, int j, int nrows, int wg, int nwg) {
    const int lane = ltid() & 63, wv = ltid() >> 6;
    const bf16_t* P = WSP(bf16_t, OFF_PREG);
    bf16_t* R = WSP(bf16_t, OFF_RKVK); bf16_t* K = R + (size_t)NT * 512; bf16_t* V = K + (size_t)NT * 512; bf16_t* KK = V + (size_t)NT * 512;
    bf16_t* DIFF = WSP(bf16_t, OFF_DIFF);
    const int c = 8 * lane, q = lane >> 4;
    for (int r = wg * 4 + wv; r < nrows; r += nwg * 4) {
        const int s = shift_src(r, q); const int sc = s >= 0 ? s : r;
        int t, T, base;
        if (r < NL) { t = r & 8191; T = 8192; base = r - t; } else { t = (r - NL) & 255; T = 256; base = r - t; }
        const int half = 1 << q; const int lo = max(t - half, 0), hi = min(t + half, T);
        u32x4 pa_[3], pb_[3];
#pragma unroll
        for (int n = 0; n < 3; ++n) { pa_[n] = *(const u32x4*)(P + (size_t)r * 2048 + n * 512 + c); pb_[n] = *(const u32x4*)(P + (size_t)sc * 2048 + n * 512 + c); }
        u32x4 wv_[16];
#pragma unroll
        for (int i = 0; i < 16; ++i) { const int tt = t + i - 8; const bool ok = tt >= lo && tt < hi; wv_[i] = *(const u32x4*)(P + (size_t)(base + (ok ? tt : t)) * 2048 + 1536 + c); }
        const u32x4 u = *(const u32x4*)(P + (size_t)r * 2048 + 1536 + c);
        __builtin_amdgcn_sched_barrier(0);
        float val[3][8];
#pragma unroll
        for (int n = 0; n < 3; ++n) {
            const u32x4 a = pa_[n]; u32x4 b = pb_[n];
            if (s < 0) b = (u32x4){0u, 0u, 0u, 0u};
            const f32x4 m0 = *(const f32x4*)(p.mu_p + (size_t)(j * 3 + n) * 512 + c), m1 = *(const f32x4*)(p.mu_p + (size_t)(j * 3 + n) * 512 + c + 4);
#pragma unroll
            for (int e = 0; e < 4; ++e) {
                const float pa0 = bflo(a[e]), pa1 = bfhi(a[e]), pb0 = bflo(b[e]), pb1 = bfhi(b[e]);
                const float mu0 = (2 * e < 4) ? m0[2 * e] : m1[2 * e - 4], mu1 = (2 * e + 1 < 4) ? m0[2 * e + 1] : m1[2 * e + 1 - 4];
                val[n][2 * e] = pa0 + (pb0 - pa0) * mu0; val[n][2 * e + 1] = pa1 + (pb1 - pa1) * mu1;
            }
        }
        const f32x4 kk0 = *(const f32x4*)(p.k_k + j * 512 + c), kk1 = *(const f32x4*)(p.k_k + j * 512 + c + 4);
        float kkv[8]; float ss = 0.f;
#pragma unroll
        for (int e = 0; e < 8; ++e) { kkv[e] = val[1][e] * (e < 4 ? kk0[e] : kk1[e - 4]); ss += kkv[e] * kkv[e]; }
        ss += __shfl_xor(ss, 1); ss += __shfl_xor(ss, 2); ss += __shfl_xor(ss, 4);
        const float rn = frsq(fmaxf(ss, 1e-12f));
        u32x4 o;
#pragma unroll
        for (int e = 0; e < 4; ++e) o[e] = pk2(val[0][2 * e], val[0][2 * e + 1]);
        *(u32x4*)(R + (size_t)r * 512 + c) = o;
#pragma unroll
        for (int e = 0; e < 4; ++e) o[e] = pk2(val[1][2 * e], val[1][2 * e + 1]);
        *(u32x4*)(K + (size_t)r * 512 + c) = o;
#pragma unroll
        for (int e = 0; e < 4; ++e) o[e] = pk2(val[2][2 * e], val[2][2 * e + 1]);
        *(u32x4*)(V + (size_t)r * 512 + c) = o;
        (void)kkv; (void)rn;
        float sum[8];
#pragma unroll
        for (int e = 0; e < 8; ++e) sum[e] = 0.f;
#pragma unroll
        for (int i = 0; i < 16; ++i) { const int tt = t + i - 8; const bool ok = tt >= lo && tt < hi;
#pragma unroll
            for (int e = 0; e < 4; ++e) { sum[2 * e] += ok ? bflo(wv_[i][e]) : 0.f; sum[2 * e + 1] += ok ? bfhi(wv_[i][e]) : 0.f; } }
        const float inv = 1.0f / (float)(hi - lo);
#pragma unroll
        for (int e = 0; e < 4; ++e) o[e] = pk2(sum[2 * e] * inv - bflo(u[e]), sum[2 * e + 1] * inv - bfhi(u[e]));
        *(u32x4*)(DIFF + (size_t)r * 512 + c) = o;
    }
}

__device__ __forceinline__ void phase_e4(const Params& p, char* smem, int j, int nrows, int part, int wg, int nwg) {
    const bf16_t* LR1 = WSP(bf16_t, OFF_LR1); const bf16_t* DIFF = WSP(bf16_t, OFF_DIFF);
    const bf16_t* K = WSP(bf16_t, OFF_RKVK) + (size_t)NT * 512; const bf16_t* KK = WSP(bf16_t, OFF_RKVK) + (size_t)3 * NT * 512;
    float* W = WSP(float, OFF_WREG); bf16_t* KD = WSP(bf16_t, OFF_KD); bf16_t* BB = WSP(bf16_t, OFF_BB); bf16_t* G = WSP(bf16_t, OFF_G); bf16_t* YAB = WSP(bf16_t, OFF_HREG);
    const bf16_t* WL2 = (const bf16_t*)(p.ws + OFF_WTS + W_LR2) + (size_t)j * 384 * 512;
    const bf16_t* WP = (const bf16_t*)(p.ws + OFF_WTS + W_POOL) + (size_t)j * 512 * 128;
    const int nrt = nrows / 128, nlr = nrt * (part == 0 ? 16 : 4), ntot = nlr + (part == 1 ? nrt * 4 : 0);
    f32x4 acc[4][4];
    for (int t = wg; t < ntot; t += nwg) {
        if (t < nlr) {
            const int mt = part == 0 ? t >> 4 : t >> 2, u = part == 0 ? (t & 15) : 16 + (t & 3), ob = u >> 2, n4 = u & 3, m0 = mt * 128, n0 = n4 * 128;
            const int koff = ob < 4 ? ob * 64 : 256, nk = ob < 4 ? 1 : 2;
            gemm_tile(smem, nk, APlain{LR1 + koff, 384, m0}, BPlain{WL2 + (size_t)koff * 512 + n0, 512}, acc);
            if (ob < 2) {
                const float* w0 = p.decay_w0 + (size_t)(j * 2 + ob) * 512 + n0;
                EPI_FOR(acc, { const f32x4 b0 = *(const f32x4*)(w0 + col); f32x4 o;
                    _Pragma("unroll") for (int e = 0; e < 4; ++e) o[e] = v[e] + b0[e];
                    st_bf4(KD + ((size_t)ob * NT + m0 + row) * 512 + n0 + col, o); });
            } else if (ob < 4) {
                const int d = ob - 2; const float* a0 = p.lr_a0 + (size_t)(j * 2 + d) * 512 + n0;
                EPI_FOR(acc, { const f32x4 b0 = *(const f32x4*)(a0 + col); f32x4 o;
                    _Pragma("unroll") for (int e = 0; e < 4; ++e) o[e] = sigmoidf_(v[e] + b0[e]);
                    st_bf4(BB + ((size_t)d * NT + m0 + row) * 512 + n0 + col, o); });
            } else {
                EPI_FOR2(acc, { st_bf8_pair(G + (size_t)(m0 + row) * 512 + n0 + pcol, va, vb, g); });
            }
        } else {
            const int u = t - nlr, mt = u >> 2, g = u & 3, m0 = mt * 128;
            gemm_tile(smem, 2, APlain{DIFF + g * 128, 512, m0}, BPlain{WP + (size_t)g * 128 * 128, 128}, acc);
            const float* ps = p.pool_scale + (size_t)j * 512 + g * 128;
            { const int gq = g; EPI_FOR2(acc, { const f32x4 sa = *(const f32x4*)(ps + pcol + 4 * g), sb = *(const f32x4*)(ps + pcol + 16 + 4 * g); f32x4 oa, ob;
                _Pragma("unroll") for (int e = 0; e < 4; ++e) { oa[e] = va[e] * sa[e]; ob[e] = vb[e] * sb[e]; }
                st_bf8_pair(YAB + (size_t)(m0 + row) * 1024 + 512 + gq * 128 + pcol, oa, ob, g); }); }
        }
    }
}

template <int VAR> __device__ __forceinline__ void phase_scan(const Params&, char*, int, int) {}
template <int CTRL> __device__ __forceinline__ float dpp_mov(float x) { return __builtin_bit_cast(float, __builtin_amdgcn_mov_dpp(__builtin_bit_cast(int, x), CTRL, 0xf, 0xf, true)); }
typedef float f32x2v __attribute__((ext_vector_type(2)));

#define CK_C 32
#define CK_NCH 264
#define CK_P 144
#define CK_PG 80
#define CK_G 0
#define CK_TOT 8192
#define CK_AT 9216
#define CK_BT (CK_AT + 4608)
#define CK_KT (CK_BT + 4608)
#define CK_RT (CK_KT + 4608)
#define CK_VC (CK_RT + 4608)
#define CK_T (CK_VC + 4608)
#define CK_MAK (CK_T + 2560)
#define CK_NRB (CK_MAK + 2560)
#define CK_NRK (CK_NRB + 2560)
#define CK_P1 (CK_NRK + 2560)
#define CK_W1 (CK_P1 + 4608)
#define CK_W2 (CK_W1 + 4608)
#define CK_TF (CK_W2 + 4608)
#define CK_END (CK_TF + 32 * 144)
static_assert(CK_END <= SM_BAR, "chunk LDS map");
constexpr size_t OFF_AD0 = MBY(869);
__device__ __forceinline__ size_t off_qy(int d) { return OFF_PREG + (size_t)d * MBY(66); }
__device__ __forceinline__ size_t off_ad(int d) { return d ? OFF_WREG : OFF_AD0; }

__device__ __forceinline__ bf16x8 frag_rows(const char* img, int pitch, int r0, int k0, int lane) {
    return *(const bf16x8*)(img + (r0 + (lane & 15)) * pitch + (k0 + 8 * (lane >> 4)) * 2);
}
__device__ __forceinline__ bf16x8 frag_cols(const char* img, int pitch, int k0, int c0, int lane) {
    const char* a = img + (k0 + 8 * (lane >> 4) + ((lane & 15) >> 2)) * pitch + (c0 + 4 * (lane & 3)) * 2;
    const s16x4 lo = __builtin_amdgcn_ds_read_tr16_b64_v4i16((LAS s16x4*)a), hi = __builtin_amdgcn_ds_read_tr16_b64_v4i16((LAS s16x4*)(a + 4 * pitch));
    return __builtin_shufflevector(lo, hi, 0, 1, 2, 3, 4, 5, 6, 7);
}
#define MFMA16(acc, afrag, bfrag) acc = __builtin_amdgcn_mfma_f32_16x16x32_bf16(bfrag, afrag, acc, 0, 0, 0)

__device__ __forceinline__ void phase_s1(const Params& p, char* smem, int jl, int d, int wg0, int nwg0) {
    const int tid = ltid(), lane = tid & 63, wv = tid >> 6;
    const bf16_t* R = WSP(bf16_t, OFF_RKVK); const bf16_t* V = R + (size_t)2 * NT * 512; const bf16_t* KK = R + (size_t)3 * NT * 512;
    const bf16_t* Kp = R + (size_t)NT * 512; const bf16_t* KD = WSP(bf16_t, OFF_KD) + (size_t)d * NT * 512; const bf16_t* BB = WSP(bf16_t, OFF_BB) + (size_t)d * NT * 512;
    bf16_t* QY = WSP(bf16_t, off_qy(d)); bf16_t* AD = WSP(bf16_t, off_ad(d));
    const int li = tid >> 3, c8 = (tid & 7) * 8;
    const int dir = d ? -1 : 1;
    const int ntask = 32 * CK_NCH;
    u32x4 lr, ld, lb, lv, lz;
    auto gl = [&](int task) {
        const int cd = task / CK_NCH, n = task - cd * CK_NCH, b = cd >> 3, h = cd & 7, s0 = n * CK_C;
        const int r0 = s0 < 256 ? NL + b * 256 + (d ? 255 - s0 : s0) : b * 8192 + (d ? 8191 - (s0 - 256) : (s0 - 256));
        const size_t ro = (size_t)(r0 + dir * li) * 512 + h * 64 + c8;
        lr = *(const GAS u32x4*)(R + ro); ld = *(const GAS u32x4*)(Kp + ro); lb = *(const GAS u32x4*)(BB + ro); lv = *(const GAS u32x4*)(V + ro);
        lz = __builtin_nontemporal_load((const GAS u32x4*)(KD + ro));
    };
    int task = wg0;
    if (task < ntask) gl(task);
    for (; task < ntask; task += nwg0) {
        const int cd = task / CK_NCH, n = task - cd * CK_NCH;
        float* G = (float*)(smem + CK_G); float* TOT = (float*)(smem + CK_TOT); float* TF = (float*)(smem + CK_TF);
        __syncthreads();
        {
            f32x4 w0_, w1_;
#pragma unroll
            for (int e = 0; e < 2; ++e) { w0_[2 * e] = fexp(-0.60653065971f * sigmoidf_(bflo(lz[e]))); w0_[2 * e + 1] = fexp(-0.60653065971f * sigmoidf_(bfhi(lz[e])));
                                          w1_[2 * e] = fexp(-0.60653065971f * sigmoidf_(bflo(lz[2 + e]))); w1_[2 * e + 1] = fexp(-0.60653065971f * sigmoidf_(bfhi(lz[2 + e]))); }
            *(f32x4*)(G + li * 64 + c8) = w0_; *(f32x4*)(G + li * 64 + c8 + 4) = w1_;
        }
        const u32x4 xr = lr, xd = ld, xb = lb, xv = lv;
        const int hh = (task / CK_NCH) & 7;
        const f32x4 ka0 = *(const f32x4*)(p.k_a + (size_t)jl * 512 + hh * 64 + c8), ka1 = *(const f32x4*)(p.k_a + (size_t)jl * 512 + hh * 64 + c8 + 4);
        if (task + nwg0 < ntask) gl(task + nwg0);
        __builtin_amdgcn_sched_barrier(0);
        __syncthreads();
        {
            const int c = tid & 63, q = tid >> 6; float pr = 1.f;
#pragma unroll
            for (int j = 0; j < 8; ++j) { pr *= G[(8 * q + j) * 64 + c]; G[(8 * q + j) * 64 + c] = pr; }
            TOT[q * 64 + c] = pr;
            __syncthreads();
            float pre = 1.f;
            if (q > 0) pre = TOT[c]; if (q > 1) pre *= TOT[64 + c]; if (q > 2) pre *= TOT[128 + c];
#pragma unroll
            for (int j = 0; j < 8; ++j) G[(8 * q + j) * 64 + c] *= pre;
        }
        __syncthreads();
        {
            float g[8], gm[8];
            { const f32x4 a0 = *(const f32x4*)(G + li * 64 + c8), a1 = *(const f32x4*)(G + li * 64 + c8 + 4);
#pragma unroll
              for (int e = 0; e < 4; ++e) { g[e] = a0[e]; g[4 + e] = a1[e]; } }
            if (li > 0) { const f32x4 a0 = *(const f32x4*)(G + (li - 1) * 64 + c8), a1 = *(const f32x4*)(G + (li - 1) * 64 + c8 + 4);
#pragma unroll
              for (int e = 0; e < 4; ++e) { gm[e] = a0[e]; gm[4 + e] = a1[e]; } }
            else {
#pragma unroll
              for (int e = 0; e < 8; ++e) gm[e] = 1.f; }
            float kkf[8];
            { const f32x4 q0 = *(const f32x4*)(p.k_k + (size_t)jl * 512 + hh * 64 + c8), q1 = *(const f32x4*)(p.k_k + (size_t)jl * 512 + hh * 64 + c8 + 4); float ss = 0.f;
#pragma unroll
              for (int e = 0; e < 4; ++e) { kkf[2 * e] = bflo(xd[e]) * ((2 * e < 4) ? q0[2 * e] : q1[2 * e - 4]); kkf[2 * e + 1] = bfhi(xd[e]) * ((2 * e + 1 < 4) ? q0[2 * e + 1] : q1[2 * e + 1 - 4]); }
#pragma unroll
              for (int e = 0; e < 8; ++e) ss += kkf[e] * kkf[e];
              ss = sum8(ss);
              const float rn = frsq(fmaxf(ss, 1e-12f));
#pragma unroll
              for (int e = 0; e < 8; ++e) kkf[e] *= rn; }
            u32x4 oa, ob, ok, orr;
#pragma unroll
            for (int e = 0; e < 4; ++e) {
                const float i0 = frcp(g[2 * e]), i1 = frcp(g[2 * e + 1]);
                oa[e] = pk2(-kkf[2 * e] * gm[2 * e], -kkf[2 * e + 1] * gm[2 * e + 1]);
                const float al0 = bflo(xb[e]), al1 = bfhi(xb[e]);
                const float kav0 = (2 * e < 4) ? ka0[2 * e] : ka1[2 * e - 4], kav1 = (2 * e + 1 < 4) ? ka0[2 * e + 1] : ka1[2 * e + 1 - 4];
                ob[e] = pk2(kkf[2 * e] * al0 * i0, kkf[2 * e + 1] * al1 * i1);
                ok[e] = pk2(bflo(xd[e]) * (1.f + (al0 - 1.f) * kav0) * i0, bfhi(xd[e]) * (1.f + (al1 - 1.f) * kav1) * i1);
                orr[e] = pk2(bflo(xr[e]) * g[2 * e], bfhi(xr[e]) * g[2 * e + 1]);
            }
            const int o = li * CK_P + c8 * 2;
            *(u32x4*)(smem + CK_AT + o) = oa; *(u32x4*)(smem + CK_BT + o) = ob; *(u32x4*)(smem + CK_KT + o) = ok; *(u32x4*)(smem + CK_RT + o) = orr; *(u32x4*)(smem + CK_VC + o) = xv;
        }
        __syncthreads();
        {
            const int mt = wv >> 1, nt = wv & 1;
            f32x4 aab = {0.f, 0.f, 0.f, 0.f}, aak = aab, arb = aab, ark = aab;
#pragma unroll
            for (int ks = 0; ks < 2; ++ks) {
                const bf16x8 fa = frag_rows(smem + CK_AT, CK_P, mt * 16, ks * 32, lane), fr = frag_rows(smem + CK_RT, CK_P, mt * 16, ks * 32, lane);
                const bf16x8 fb = frag_rows(smem + CK_BT, CK_P, nt * 16, ks * 32, lane), fk = frag_rows(smem + CK_KT, CK_P, nt * 16, ks * 32, lane);
                MFMA16(aab, fa, fb); MFMA16(aak, fa, fk); MFMA16(arb, fr, fb); MFMA16(ark, fr, fk);
            }
            const int m = mt * 16 + (lane & 15), n0 = nt * 16 + 4 * (lane >> 4);
            f32x4 o1, o2, o3, o4;
#pragma unroll
            for (int e = 0; e < 4; ++e) { const int nn = n0 + e; o1[e] = nn < m ? aab[e] : 0.f; o2[e] = nn < m ? aak[e] : 0.f; o3[e] = nn <= m ? arb[e] : 0.f; o4[e] = nn <= m ? ark[e] : 0.f; }
            *(f32x4*)(TF + m * 36 + n0) = o1;
            st_bf4((bf16_t*)(smem + CK_MAK + m * CK_PG) + n0, o2); st_bf4((bf16_t*)(smem + CK_NRB + m * CK_PG) + n0, o3); st_bf4((bf16_t*)(smem + CK_NRK + m * CK_PG) + n0, o4);
        }
        __syncthreads();
        if (wv == 0) {
            const int c = lane & 31; float Tc[32];
#pragma unroll
            for (int t = 0; t < 32; ++t) {
                float a0 = (c == t) ? 1.f : 0.f, a1 = 0.f, a2 = 0.f, a3 = 0.f;
#pragma unroll
                for (int j4 = 0; j4 < (t + 3) / 4; ++j4) {
                    const f32x4 mrow = *(const f32x4*)(TF + t * 36 + j4 * 4);
                    if (j4 * 4 + 0 < t) a0 += mrow[0] * Tc[j4 * 4 + 0];
                    if (j4 * 4 + 1 < t) a1 += mrow[1] * Tc[j4 * 4 + 1];
                    if (j4 * 4 + 2 < t) a2 += mrow[2] * Tc[j4 * 4 + 2];
                    if (j4 * 4 + 3 < t) a3 += mrow[3] * Tc[j4 * 4 + 3];
                }
                Tc[t] = (a0 + a1) + (a2 + a3);
                if (lane < 32) ((bf16_t*)(smem + CK_T + t * CK_PG))[c] = f2bf(Tc[t]);
            }
        } else {
            for (int tl = wv - 1; tl < 8; tl += 3) {
                const int mt = tl >> 2, nt = tl & 3; f32x4 acc = {0.f, 0.f, 0.f, 0.f};
                MFMA16(acc, frag_rows(smem + CK_MAK, CK_PG, mt * 16, 0, lane), frag_cols(smem + CK_VC, CK_P, 0, nt * 16, lane));
                st_bf4((bf16_t*)(smem + CK_P1 + (mt * 16 + (lane & 15)) * CK_P) + nt * 16 + 4 * (lane >> 4), acc);
            }
        }
        __syncthreads();
#pragma unroll
        for (int u = 0; u < 4; ++u) {
            const int tl = wv * 4 + u, which = tl >> 3, mt = (tl >> 2) & 1, nt = tl & 3; f32x4 acc = {0.f, 0.f, 0.f, 0.f};
            MFMA16(acc, frag_rows(smem + CK_T, CK_PG, mt * 16, 0, lane), frag_cols(smem + (which ? CK_P1 : CK_AT), CK_P, 0, nt * 16, lane));
            st_bf4((bf16_t*)(smem + (which ? CK_W2 : CK_W1) + (mt * 16 + (lane & 15)) * CK_P) + nt * 16 + 4 * (lane >> 4), acc);
        }
        __syncthreads();
        {
            bf16_t* qrec = QY + (size_t)task * 4096; bf16_t* arec = AD + (size_t)task * 8192;
            {
                f32x4 aq2[2], ay2[2];
                const int mt = (wv * 2) >> 2, m = mt * 16 + (lane & 15);
#pragma unroll
                for (int u = 0; u < 2; ++u) {
                    const int nt = (wv * 2 + u) & 3, n0 = nt * 16 + 4 * (lane >> 4);
                    const bf16x8 fnb = frag_rows(smem + CK_NRB, CK_PG, mt * 16, 0, lane), fnk = frag_rows(smem + CK_NRK, CK_PG, mt * 16, 0, lane);
                    f32x4 aq = {0.f, 0.f, 0.f, 0.f}, ay = aq;
                    MFMA16(aq, fnb, frag_cols(smem + CK_W1, CK_P, 0, nt * 16, lane));
                    MFMA16(ay, fnb, frag_cols(smem + CK_W2, CK_P, 0, nt * 16, lane)); MFMA16(ay, fnk, frag_cols(smem + CK_VC, CK_P, 0, nt * 16, lane));
                    const u32x2 rt = *(const u32x2*)(smem + CK_RT + m * CK_P + n0 * 2);
                    aq[0] += bflo(rt.x); aq[1] += bfhi(rt.x); aq[2] += bflo(rt.y); aq[3] += bfhi(rt.y);
                    aq2[u] = aq; ay2[u] = ay;
                }
                const int g = lane >> 4, nc = ((wv * 2) & 3) * 16 + (g & 1) * 16 + (g >> 1) * 8;
                *(u32x4*)(qrec + ((m >> 4) * 2 + (nc >> 5)) * 512 + (((nc >> 3) & 3) * 16 + (m & 15)) * 8) = pack_pair(aq2[0], aq2[1]);
                *(u32x4*)(qrec + 2048 + m * 64 + nc) = pack_pair(ay2[0], ay2[1]);
            }
            const float* gC = G + 31 * 64;
            f32x4 aa4[4];
#pragma unroll
            for (int u = 0; u < 4; ++u) {
                const int tl = wv * 4 + u, mt = tl >> 2, nt = tl & 3, m = mt * 16 + (lane & 15), n0 = nt * 16 + 4 * (lane >> 4);
                const bf16x8 fbt = frag_cols(smem + CK_BT, CK_P, 0, mt * 16, lane), fkt = frag_cols(smem + CK_KT, CK_P, 0, mt * 16, lane);
                f32x4 aa = {0.f, 0.f, 0.f, 0.f}, ad = aa;
                MFMA16(aa, fbt, frag_cols(smem + CK_W1, CK_P, 0, nt * 16, lane));
                MFMA16(ad, fbt, frag_cols(smem + CK_W2, CK_P, 0, nt * 16, lane)); MFMA16(ad, fkt, frag_cols(smem + CK_VC, CK_P, 0, nt * 16, lane));
                const float gm_ = gC[m];
#pragma unroll
                for (int e = 0; e < 4; ++e) { aa[e] = (aa[e] + ((n0 + e) == m ? 1.f : 0.f)) * gm_; ad[e] *= gm_; }
                aa4[u] = aa;
                st_bf4(arec + 4096 + (((n0 >> 4) * 4 + (m >> 4)) * 64 + ((n0 & 15) >> 2) * 16 + (m & 15)) * 4, ad);
            }
            {
                const int m = wv * 16 + (lane & 15), g = lane >> 4;
#pragma unroll
                for (int np = 0; np < 2; ++np) { const int nc = np * 32 + (g & 1) * 16 + (g >> 1) * 8;
                    *(u32x4*)(arec + ((m >> 4) * 2 + (nc >> 5)) * 512 + (((nc >> 3) & 3) * 16 + (m & 15)) * 8) = pack_pair(aa4[2 * np], aa4[2 * np + 1]); }
            }
        }
    }
}

__device__ __forceinline__ void phase_s2(const Params& p, char* smem, int d, int wg, int nwg) {
    const int tid = ltid(), lane = tid & 63, wv = tid >> 6;
    bf16_t* QY = WSP(bf16_t, off_qy(d)); const bf16_t* AD = WSP(bf16_t, off_ad(d));
    const int m15 = lane & 15, g4 = lane >> 4;
    if (wv != 0) return;
    for (int t = wg; t < 128; t += nwg) {
        const int x = t & 7, yy = t >> 3, cd = x * 4 + (yy >> 2), sl = yy & 3;
        char* zt = smem;
#pragma unroll
        for (int mt = 0; mt < 4; ++mt) *(u32x2*)(zt + (mt * 16 + m15) * 48 + 8 * g4) = (u32x2){0u, 0u};
        bf16x8 fa[3][4][2], fq[3][2][2]; u32x2 dz[3][4], dy[3][2];
#define S2_LOAD(S, n_) do { \
            const bf16_t* qrec = QY + (size_t)(cd * CK_NCH + (n_)) * 4096; const bf16_t* arec = AD + (size_t)(cd * CK_NCH + (n_)) * 8192; \
            _Pragma("unroll") for (int mt = 0; mt < 4; ++mt) { \
                _Pragma("unroll") for (int ks = 0; ks < 2; ++ks) fa[S][mt][ks] = __builtin_nontemporal_load((const GAS bf16x8*)(arec + (mt * 2 + ks) * 512 + lane * 8)); \
                dz[S][mt] = __builtin_nontemporal_load((const GAS u32x2*)(arec + 4096 + ((sl * 4 + mt) * 64 + lane) * 4)); } \
            _Pragma("unroll") for (int mt = 0; mt < 2; ++mt) { \
                _Pragma("unroll") for (int ks = 0; ks < 2; ++ks) fq[S][mt][ks] = __builtin_nontemporal_load((const GAS bf16x8*)(qrec + (mt * 2 + ks) * 512 + lane * 8)); \
                dy[S][mt] = __builtin_nontemporal_load((const GAS u32x2*)(qrec + 2048 + (mt * 16 + m15) * 64 + sl * 16 + 4 * g4)); } } while (0)
        S2_LOAD(0, 0); S2_LOAD(1, 1);
        for (int nb = 0; nb < CK_NCH; nb += 3) {
#pragma unroll
          for (int P = 0; P < 3; ++P) {
            const int n = nb + P;
            if (n >= CK_NCH) break;
            S2_LOAD((P + 2) % 3, min(n + 2, CK_NCH - 1));
            bf16x8 (&ca)[4][2] = fa[P]; bf16x8 (&cq)[2][2] = fq[P]; u32x2 (&cz)[4] = dz[P]; u32x2 (&cy)[2] = dy[P];
            __builtin_amdgcn_sched_barrier(0);
            const bf16x8 z0 = frag_cols(zt, 48, 0, 0, lane), z1 = frag_cols(zt, 48, 32, 0, lane);
            f32x4 az[4], ay[2];
#pragma unroll
            for (int mt = 0; mt < 4; ++mt) { az[mt] = (f32x4){bflo(cz[mt].x), bfhi(cz[mt].x), bflo(cz[mt].y), bfhi(cz[mt].y)}; MFMA16(az[mt], ca[mt][0], z0); MFMA16(az[mt], ca[mt][1], z1); }
#pragma unroll
            for (int mt = 0; mt < 4; ++mt) { u32x2 w; w.x = pk2(az[mt][0], az[mt][1]); w.y = pk2(az[mt][2], az[mt][3]); *(u32x2*)(zt + (mt * 16 + m15) * 48 + 8 * g4) = w; }
            __builtin_amdgcn_sched_barrier(0);
#pragma unroll
            for (int mt = 0; mt < 2; ++mt) { ay[mt] = (f32x4){bflo(cy[mt].x), bfhi(cy[mt].x), bflo(cy[mt].y), bfhi(cy[mt].y)}; MFMA16(ay[mt], cq[mt][0], z0); MFMA16(ay[mt], cq[mt][1], z1); }
            { bf16_t* qrec = QY + (size_t)(cd * CK_NCH + n) * 4096;
#pragma unroll
              for (int mt = 0; mt < 2; ++mt) st_bf4(qrec + 2048 + (mt * 16 + m15) * 64 + sl * 16 + 4 * g4, ay[mt]); }
          }
        }
#undef S2_LOAD
    }
}

template <int YBF>
__device__ __forceinline__ void phase_post(const Params& p, int j, int nrows, int wg, int nwg) {
    const int tid = ltid(), lane = tid & 63, wv = __builtin_amdgcn_readfirstlane(tid >> 6);
    const float* Y = WSP(float, OFF_PREG);
    const bf16_t* R = WSP(bf16_t, OFF_RKVK); const bf16_t* V = R + (size_t)2 * NT * 512;
    const bf16_t* G = WSP(bf16_t, OFF_G); bf16_t* YAB = WSP(bf16_t, OFF_HREG); const bf16_t* AL = WSP(bf16_t, OFF_BB);
    const bf16_t* QY0 = WSP(bf16_t, off_qy(0)); const bf16_t* QY1 = WSP(bf16_t, off_qy(1));
    const int c = 8 * lane;
    static_assert(YBF != 0, "the output phase reads y from the chunk records (chunked state pass)"); (void)Y;
    f32x4 ka[2], rk[2], gw[2], gb[2];
#pragma unroll
    for (int h = 0; h < 2; ++h) { ka[h] = *(const f32x4*)(p.k_a + (size_t)j * 512 + c + 4 * h); rk[h] = *(const f32x4*)(p.r_k + (size_t)j * 512 + c + 4 * h);
        gw[h] = *(const f32x4*)(p.gn_w + (size_t)j * 512 + c + 4 * h); gb[h] = *(const f32x4*)(p.gn_b + (size_t)j * 512 + c + 4 * h); }
    const int rstep = nwg * 4, rlast = nrows - 1;
    int r = wg * 4 + wv;
    if (r >= nrows) return;
    u32x4 in[2][8];
#define PO_LOAD(S, rr) do { \
        const int hh = lane >> 3, v_ = (lane & 7) * 8; int bb_, tt_, s0_, s1_; \
        if ((rr) < NL) { bb_ = (rr) >> 13; tt_ = (rr) & 8191; s0_ = 256 + tt_; s1_ = 256 + 8191 - tt_; } else { bb_ = ((rr) - NL) >> 8; tt_ = ((rr) - NL) & 255; s0_ = tt_; s1_ = 255 - tt_; } \
        const int cd = bb_ * 8 + hh; \
        in[S][0] = __builtin_nontemporal_load((const u32x4*)(QY0 + (size_t)(cd * CK_NCH + (s0_ >> 5)) * 4096 + 2048 + (s0_ & 31) * 64 + v_)); \
        in[S][1] = __builtin_nontemporal_load((const u32x4*)(QY1 + (size_t)(cd * CK_NCH + (s1_ >> 5)) * 4096 + 2048 + (s1_ & 31) * 64 + v_)); \
        in[S][2] = __builtin_nontemporal_load((const u32x4*)(R + (size_t)(rr) * 512 + c)); in[S][3] = __builtin_nontemporal_load((const u32x4*)(V + (size_t)(rr) * 512 + c)); in[S][4] = __builtin_nontemporal_load((const u32x4*)(G + (size_t)(rr) * 512 + c)); \
        in[S][5] = __builtin_nontemporal_load((const u32x4*)(R + ((size_t)NT + (rr)) * 512 + c)); in[S][6] = __builtin_nontemporal_load((const u32x4*)(AL + (size_t)(rr) * 512 + c)); in[S][7] = __builtin_nontemporal_load((const u32x4*)(AL + ((size_t)NT + (rr)) * 512 + c)); } while (0)
    PO_LOAD(0, r);
    while (r < nrows) {
#pragma unroll
      for (int P = 0; P < 2; ++P) {
        if (r >= nrows) break;
        { const int rn = min(r + rstep, rlast); PO_LOAD(1 - P, rn); }
        __builtin_amdgcn_sched_barrier(0);
        const u32x4 a = in[P][0], bq = in[P][1], rr = in[P][2], vv = in[P][3], gg = in[P][4], kx = in[P][5], al0 = in[P][6], al1 = in[P][7];
        float y[8];
#pragma unroll
        for (int e = 0; e < 4; ++e) { y[2 * e] = bflo(a[e]) + bflo(bq[e]); y[2 * e + 1] = bfhi(a[e]) + bfhi(bq[e]); }
        float s = 0.f;
#pragma unroll
        for (int e = 0; e < 8; ++e) s += y[e];
        s = sum8(s);
        const float mu = s * (1.f / 64.f);
        float q = 0.f;
#pragma unroll
        for (int e = 0; e < 8; ++e) { const float dlt = y[e] - mu; q += dlt * dlt; }
        q = sum8(q);
        const float rstd = frsq(q * (1.f / 64.f) + 64e-5f);
        float dot = 0.f;
#pragma unroll
        for (int e = 0; e < 4; ++e) {
            const float kav0 = ka[(2 * e) >> 2][(2 * e) & 3], kav1 = ka[(2 * e + 1) >> 2][(2 * e + 1) & 3];
            dot += bflo(rr[e]) * (bflo(kx[e]) * (2.f + (bflo(al0[e]) + bflo(al1[e]) - 2.f) * kav0)) * rk[(2 * e) >> 2][(2 * e) & 3];
            dot += bfhi(rr[e]) * (bfhi(kx[e]) * (2.f + (bfhi(al0[e]) + bfhi(al1[e]) - 2.f) * kav1)) * rk[(2 * e + 1) >> 2][(2 * e + 1) & 3];
        }
        dot = sum8(dot);
        float o[8];
#pragma unroll
        for (int e = 0; e < 8; ++e) {
            const float vf = (e & 1) ? bfhi(vv[e >> 1]) : bflo(vv[e >> 1]), gf = (e & 1) ? bfhi(gg[e >> 1]) : bflo(gg[e >> 1]);
            o[e] = ((y[e] - mu) * rstd * gw[e >> 2][e & 3] + gb[e >> 2][e & 3] + dot * vf) * gf;
        }
        u32x4 w;
#pragma unroll
        for (int e = 0; e < 4; ++e) w[e] = pk2(o[2 * e], o[2 * e + 1]);
        *(u32x4*)(YAB + (size_t)r * 1024 + c) = w;
        r += rstep;
      }
    }
#undef PO_LOAD
}

template <int DRY = 0, bool CW = false>
__device__ __forceinline__ void phase_resgemm(const Params& p, char* smem, const bf16_t* A, const bf16_t* B, int layer, int nrows, int wg, int nwg) {
    float* RES = DRY ? WSP(float, OFF_DIFF) : WSP(float, OFF_RES); const float* mod = WSP(float, OFF_MOD);
    const int nwide = (min(nrows, NL) / 128) * 4, ntot = nwide + ((nrows - min(nrows, NL)) / 128) * 8;
    f32x4 acc[4][4]; f32x4 accw[4][8];
    for (int t = wg; t < ntot; t += nwg) {
        if (t < nwide) {
            const int mt = t >> 2, nt = t & 3, m0 = mt * 128, n0 = nt * 256;
            gemm_tile_w(smem, 32, APlain{A, 1024, m0}, BPlain{B + n0, 1024}, accw);
            const int mb = m0 >> 13;
            const float* g2 = mod + (size_t)(mb * 4 + layer) * 6144 + 2 * 1024 + n0;
            const float* rsrc = layer == 0 ? p.x : RES;
            EPI_FORW(accw, { float* rp = RES + (DRY ? (size_t)((m0 + row) & 4095) : (size_t)(m0 + row)) * 1024 + n0 + col; const f32x4 g = *(const f32x4*)(g2 + col); f32x4 o = __builtin_nontemporal_load((const f32x4*)(rsrc + (size_t)(m0 + row) * 1024 + n0 + col));
                o[0] += g[0] * v[0]; o[1] += g[1] * v[1]; o[2] += g[2] * v[2]; o[3] += g[3] * v[3]; *(f32x4*)rp = o; });
        } else {
            const int tn = t - nwide, mt = NL / 128 + (tn >> 3), nt = tn & 7, m0 = mt * 128, n0 = nt * 128;
            gemm_tile(smem, 16, APlain{A, 1024, m0}, BPlain{B + n0, 1024}, acc);
            const float* g2 = mod + (size_t)(4 * 4 + layer) * 6144 + 2 * 1024 + n0;
            const float* rsrc = layer == 0 ? p.ctx - (size_t)NL * 1024 : RES;
            EPI_FOR(acc, { float* rp = RES + (DRY ? (size_t)((m0 + row) & 4095) : (size_t)(m0 + row)) * 1024 + n0 + col; const f32x4 g = *(const f32x4*)(g2 + col); f32x4 o = __builtin_nontemporal_load((const f32x4*)(rsrc + (size_t)(m0 + row) * 1024 + n0 + col));
                o[0] += g[0] * v[0]; o[1] += g[1] * v[1]; o[2] += g[2] * v[2]; o[3] += g[3] * v[3]; *(f32x4*)rp = o; });
        }
    }
}

__device__ __forceinline__ void phase_f1(const Params& p, char* smem, int nrows, int wg, int nwg) {
    const bf16_t* H = WSP(bf16_t, OFF_HREG); bf16_t* Z = WSP(bf16_t, OFF_PREG); const bf16_t* DFTC = (const bf16_t*)(p.ws + OFF_WTS + W_DFTC);
    const int ntot = (nrows / 128) * 8;
    f32x4 accw[4][8];
    for (int t = wg; t < ntot; t += nwg) {
        const int mt = t >> 3, nt = t & 7, g = nt >> 1, cb2 = nt & 1, m0 = mt * 128;
        gemm_tile_w(smem, 8, APlain{H + g * 256, 1024, m0}, BPlain{DFTC + cb2 * 256, 512}, accw);
        { const int gz = g; EPI_FORW2(accw, { st_bf8_pair(Z + (size_t)(m0 + row) * 2048 + gz * 512 + cb2 * 256 + pcol, va, vb, g); }); }
    }
}
struct BZ { const bf16_t* Z; int rowbase, rstride, psh, off;
    __device__ __forceinline__ const bf16_t* ptr(int k, int n) const { const int part = k >> psh, idx = k & ((1 << psh) - 1); return Z + (size_t)(rowbase + idx * rstride) * 2048 + part * 256 + off + n; } };
__device__ __forceinline__ void phase_f2(const Params& p, char* smem, bool with_ctx, int wg, int nwg) {
    const bf16_t* Z = WSP(bf16_t, OFF_PREG); bf16_t* A1 = WSP(bf16_t, OFF_WREG); bf16_t* FO = WSP(bf16_t, OFF_RKVK);
    const bf16_t* TW = (const bf16_t*)(p.ws + OFF_WTS + W_TW); const bf16_t* CS256 = (const bf16_t*)(p.ws + OFF_WTS + W_CS256);
    const int nctx = with_ctx ? 64 : 0, ntot = 512 * 4 + nctx;
    f32x4 acc[4][4]; f32x4 accw[4][8];
    for (int t = wg; t < ntot; t += nwg) {
        if (t >= nctx) {
            const int tl_ = t - nctx, bt = tl_ >> 2, g = tl_ & 3, b = bt >> 7, t2 = bt & 127; const int ch0 = g * 256;
            gemm_tile_w(smem, 4, APlain{TW + (size_t)t2 * 128 * 128, 128, 0}, BZ{Z, b * 8192 + t2, 128, 6, g * 512}, accw);
            EPI_FORW2(accw, { const int pp = row >> 6, f1 = row & 63; st_bf8_pair(A1 + ((((size_t)(b * 64 + f1) * 128 + t2) * 2 + pp) * 1024) + ch0 + pcol, va, vb, g); });
        } else {
            const int u = t, b = u >> 4, mt = (u >> 3) & 1, nt = u & 7; const int ch0 = nt * 128, g = ch0 >> 8, cc = ch0 & 255;
            gemm_tile(smem, 8, APlain{CS256, 512, mt * 128}, BZ{Z, NL + b * 256, 1, 8, g * 512 + cc}, acc);
            EPI_FOR2(acc, { f32x4 oa, ob;
                _Pragma("unroll") for (int e = 0; e < 4; ++e) { oa[e] = va[e] * (1.f / 256.f); ob[e] = vb[e] * (1.f / 256.f); }
                st_bf8_pair(FO + (size_t)(NL + b * 256 + mt * 128 + row) * 1024 + ch0 + pcol, oa, ob, g); });
        }
    }
}
struct BA1 { const bf16_t* base; int off;
    __device__ __forceinline__ const bf16_t* ptr(int k, int n) const { const int part = k >> 7, t2 = k & 127; return base + (size_t)(t2 * 2 + part) * 1024 + off + n; } };
__device__ __forceinline__ void phase_f3(const Params& p, char* smem, int wg, int nwg) {
    const bf16_t* A1 = WSP(bf16_t, OFF_WREG); bf16_t* FO = WSP(bf16_t, OFF_RKVK); const bf16_t* CS128 = (const bf16_t*)(p.ws + OFF_WTS + W_CS128);
    f32x4 acc[4][4];
    const float scl = 0.000690533966f;
    for (int t = wg; t < 256 * 8; t += nwg) {
        const int bf_ = t >> 3, nt = t & 7, b = bf_ >> 6, f1 = bf_ & 63;
        gemm_tile(smem, 4, APlain{CS128, 256, 0}, BA1{A1 + (size_t)(b * 64 + f1) * 128 * 2 * 1024, nt * 128}, acc);
        EPI_FOR(acc, { f32x4 o; o[0] = v[0] * scl; o[1] = v[1] * scl; o[2] = v[2] * scl; o[3] = v[3] * scl;
            st_bf4(FO + (size_t)(b * 8192 + f1 + 64 * row) * 1024 + nt * 128 + col, o); });
    }
}

__device__ __forceinline__ void phase_f3_ring(const Params& p, char* smem, int wg, int nwg) {
    const int tid = ltid(), lane = tid & 63, wid = tid >> 6;
    const bf16_t* A1 = WSP(bf16_t, OFF_WREG); bf16_t* FO = WSP(bf16_t, OFF_RKVK); const bf16_t* CS128 = (const bf16_t*)(p.ws + OFF_WTS + W_CS128);
    const float scl = 0.000690533966f;
    const int ntot = 256 * 8;
    if (wg >= ntot) return;
    const int nmy = (ntot - wg + nwg - 1) / nwg, nsteps = nmy * 4;
    bf16x8 a[8][2];
#pragma unroll
    for (int ks = 0; ks < 8; ++ks)
#pragma unroll
        for (int mt = 0; mt < 2; ++mt) a[ks][mt] = *(const GAS bf16x8*)(CS128 + (size_t)(wid * 32 + mt * 16 + (lane & 15)) * 256 + ks * 32 + (lane >> 4) * 8);
    const int brow = tid >> 4, bnc = (((tid & 15) ^ bswz(brow)) << 3);
    const unsigned lds0 = (unsigned)__builtin_amdgcn_readfirstlane((int)((unsigned)(size_t)smem + (unsigned)(wid * 1024)));
    auto issueB = [&](int g) {
        g = min(g, nsteps - 1);
        const int t = wg + (g >> 2) * nwg, kt = g & 3, bf_ = t >> 3, nt = t & 7, b = bf_ >> 6, f1 = bf_ & 63;
        const bf16_t* base = A1 + (size_t)(b * 64 + f1) * 128 * 2 * 1024 + nt * 128;
#pragma unroll
        for (int q = 0; q < 4; ++q) { const int k = kt * 64 + brow + 16 * q, part = k >> 7, t2 = k & 127;
            glds16_asm(base + (size_t)(t2 * 2 + part) * 1024 + bnc, lds0 + kt * G_BBYTES + q * 4096); }
    };
    const int bg = lane >> 4, bq = (lane & 15) >> 2, bp = lane & 3;
    __syncthreads();
    issueB(0); issueB(1); issueB(2);
    f32x4 acc[2][8];
    for (int i = 0; i < nmy; ++i) {
#pragma unroll
        for (int m_ = 0; m_ < 2; ++m_)
#pragma unroll
            for (int n_ = 0; n_ < 8; ++n_) acc[m_][n_] = (f32x4){0.f, 0.f, 0.f, 0.f};
#pragma unroll
        for (int kt = 0; kt < 4; ++kt) {
            if (kt < 3 && i > 0) asm volatile("s_waitcnt vmcnt(16)" ::: "memory"); else asm volatile("s_waitcnt vmcnt(8)" ::: "memory");
            __syncthreads();
            issueB(i * 4 + kt + 3);
            const char* sb = smem + kt * G_BBYTES;
#pragma unroll
            for (int ks = 0; ks < 2; ++ks) {
#pragma unroll
                for (int nh = 0; nh < 4; ++nh) {
                    bf16x8 b[2];
#pragma unroll
                    for (int n2 = 0; n2 < 2; ++n2) {
                        const int nt = nh * 2 + n2;
                        const int c2 = 2 * nt + (bp >> 1);
                        const int k0 = 32 * ks + 8 * bg + bq, k1 = k0 + 4;
                        const s16x4 lo = __builtin_amdgcn_ds_read_tr16_b64_v4i16((LAS s16x4*)(sb + k0 * 256 + ((c2 ^ bswz(k0)) << 4) + 8 * (bp & 1)));
                        const s16x4 hi = __builtin_amdgcn_ds_read_tr16_b64_v4i16((LAS s16x4*)(sb + k1 * 256 + ((c2 ^ bswz(k1)) << 4) + 8 * (bp & 1)));
                        b[n2] = __builtin_shufflevector(lo, hi, 0, 1, 2, 3, 4, 5, 6, 7);
                    }
#pragma unroll
                    for (int mt = 0; mt < 2; ++mt)
#pragma unroll
                        for (int n2 = 0; n2 < 2; ++n2) acc[mt][nh * 2 + n2] = __builtin_amdgcn_mfma_f32_16x16x32_bf16(b[n2], a[kt * 2 + ks][mt], acc[mt][nh * 2 + n2], 0, 0, 0);
                }
            }
        }
        const int t = wg + i * nwg, bf_ = t >> 3, nt = t & 7, b = bf_ >> 6, f1 = bf_ & 63;
#pragma unroll
        for (int mt = 0; mt < 2; ++mt)
#pragma unroll
            for (int np = 0; np < 4; ++np) {
                const int row = wid * 32 + mt * 16 + (lane & 15); f32x4 oa, ob;
#pragma unroll
                for (int e = 0; e < 4; ++e) { oa[e] = acc[mt][2 * np][e] * scl; ob[e] = acc[mt][2 * np + 1][e] * scl; }
                st_bf8_pair(FO + (size_t)(b * 8192 + f1 + 64 * row) * 1024 + nt * 128 + np * 32, oa, ob, lane >> 4);
            }
    }
    asm volatile("s_waitcnt vmcnt(0)" ::: "memory");
    __syncthreads();
}

__device__ __forceinline__ void moe_convert_idx(const Params& p, int layer, size_t gt, size_t gs) {
    const size_t n4 = (size_t)32 * 1024 * 512 / 4;
    bf16_t* MW = WSP(bf16_t, (layer & 1) ? OFF_WREG : OFF_AD0);
    const float* s1 = p.moe_w1 + (size_t)layer * 32 * 1024 * 512; const float* s3 = p.moe_w3 + (size_t)layer * 32 * 1024 * 512; const float* s2 = p.moe_w2 + (size_t)layer * 32 * 1024 * 512;
    bf16_t* MW2 = WSP(bf16_t, OFF_W2);
    auto cv8 = [&](const float* s, bf16_t* d, size_t i) { const f32x4 a = __builtin_nontemporal_load((const f32x4*)(s + 8 * i)), b = __builtin_nontemporal_load((const f32x4*)(s + 8 * i + 4));
        *(u32x4*)(d + 8 * i) = (u32x4){pk2(a[0], a[1]), pk2(a[2], a[3]), pk2(b[0], b[1]), pk2(b[2], b[3])}; };
    for (size_t i = gt; i < n4 / 2; i += gs) { cv8(s2, MW2, i); cv8(s1, MW, i); cv8(s3, MW + 4 * n4, i); }
}
__device__ __forceinline__ void moe_convert(const Params& p, int layer, int wg, int nwg) { moe_convert_idx(p, layer, (size_t)wg * 256 + ltid(), (size_t)nwg * 256); }
struct ASplit { const bf16_t* H; const bf16_t* HLO; int m0;
    __device__ __forceinline__ int info(int row) const { return m0 + row; }
    __device__ __forceinline__ const bf16_t* ptr(int gr, int, int k) const { return k < 2048 ? H + (size_t)gr * 1024 + (k & 1023) : HLO + (size_t)gr * 1024 + (k - 2048); } };
template <int DRY>
__device__ __forceinline__ void phase_router(const Params& p, char* smem, int layer, int nrows, int wg, int nwg) {
    const bf16_t* H = WSP(bf16_t, OFF_HREG); const bf16_t* HLO = WSP(bf16_t, OFF_KD);
    const bf16_t* RW = (const bf16_t*)(p.ws + OFF_WTS + W_RW) + (size_t)layer * 3072 * 128;
    int* cnt = WSP(int, OFF_CNT) + layer * 32; int* routei = WSP(int, OFF_ROUTEI); float* routeg = WSP(float, OFF_ROUTEG); int* tokl = WSP(int, OFF_TOKL);
    float* LG = (float*)smem;
    f32x4 acc[4][4];
    const int ntot = nrows / 128;
    for (int t = wg; t < ntot; t += nwg) {
        const int m0 = t * 128;
        gemm_tile(smem, ROUTER_NK, ASplit{H, HLO, m0}, BPlain{RW, 128}, acc);
        __syncthreads();
        EPI_FOR(acc, { if (col < 48) { LG[row * 49 + col] = v[0]; LG[row * 49 + col + 1] = v[1]; LG[row * 49 + col + 2] = v[2]; LG[row * 49 + col + 3] = v[3]; } });
        __syncthreads();
        if (ltid() < 128) {
            const int row = ltid(), r = m0 + row; const float* lg = LG + row * 49;
            float c0 = lg[0] + p.router_c_b[layer * 4 + 0], c1 = lg[1] + p.router_c_b[layer * 4 + 1], c2 = lg[2] + p.router_c_b[layer * 4 + 2], c3 = lg[3] + p.router_c_b[layer * 4 + 3];
            int gi = 0; float mx = c0;
            if (c1 > mx) { mx = c1; gi = 1; } if (c2 > mx) { mx = c2; gi = 2; } if (c3 > mx) { mx = c3; gi = 3; }
            const float gval = 1.f / (expf(c0 - mx) + expf(c1 - mx) + expf(c2 - mx) + expf(c3 - mx));
            float lf[8]; float m1 = -3.0e38f, m2 = -3.0e38f; int e1 = 0, e2 = 0;
#pragma unroll
            for (int e = 0; e < 8; ++e) lf[e] = lg[4 + gi * 8 + e] + p.router_f_b[layer * 32 + gi * 8 + e];
#pragma unroll
            for (int e = 0; e < 8; ++e) if (lf[e] > m1) { m1 = lf[e]; e1 = e; }
#pragma unroll
            for (int e = 0; e < 8; ++e) if (e != e1 && lf[e] > m2) { m2 = lf[e]; e2 = e; }
            const float q2 = expf(m2 - m1); const float ga = gval / (1.f + q2), gb = gval * q2 / (1.f + q2);
            const int x1 = gi * 8 + e1, x2 = gi * 8 + e2;
            if (DRY) { asm volatile("" :: "v"(ga), "v"(gb), "v"(x1), "v"(x2)); } else {
            const int p1 = atomicAdd(&cnt[x1], 1), p2 = atomicAdd(&cnt[x2], 1);
            tokl[(size_t)x1 * TOKCAP + p1] = r; tokl[(size_t)x2 * TOKCAP + p2] = r;
            routei[2 * r] = (p1 << 5) | x1; routei[2 * r + 1] = (p2 << 5) | x2; routeg[2 * r] = ga; routeg[2 * r + 1] = gb; }
        }
    }
    if (!(CHUNKED && (layer & 1) == 0)) moe_convert(p, layer, wg, nwg);
}
__device__ __forceinline__ void moe_table(const Params& p, int layer, int* rbs, int* cn, int wg) {
    const int* cnt = WSP(int, OFF_CNTS) + layer * 32 * CNTS_STRIDE;
    __syncthreads();
    if (ltid() < 64) {
        const int lane = ltid() & 63;
        const int c = lane < 32 ? cnt[lane * CNTS_STRIDE] : 0; const int nb = (c + 127) >> 7; int inc = nb;
#pragma unroll
        for (int o = 1; o < 32; o <<= 1) { const int t = __shfl_up(inc, o); if (lane >= o) inc += t; }
        if (lane < 32) { cn[lane] = c; rbs[lane] = inc - nb; if (wg == 0) (WSP(int, OFF_POFF) + layer * 64)[lane] = (inc - nb) * 128; }
        if (lane == 31) rbs[32] = inc;
    }
    __syncthreads();
}
struct AGather { const bf16_t* H; const bf16_t* zero; const int* list; int nvalid;
    __device__ __forceinline__ int info(int row) const { return row < nvalid ? list[row] : -1; }
    __device__ __forceinline__ const bf16_t* ptr(int tok, int, int k) const { return tok >= 0 ? H + (size_t)tok * 1024 + k : zero; } };
struct BW13 { const bf16_t* w1; size_t d3;
    __device__ __forceinline__ const bf16_t* ptr(int k, int n) const { return w1 + (size_t)((n >> 5) & 1) * d3 + (size_t)k * 512 + (n >> 6) * 32 + (n & 31); } };

struct BW13W { const bf16_t* w1; size_t d3;
    __device__ __forceinline__ const bf16_t* ptr(int k, int n) const { return w1 + (size_t)((n >> 6) & 1) * d3 + (size_t)k * 512 + (n >> 7) * 64 + (n & 63); } };
__device__ __forceinline__ void phase_moe1(const Params& p, char* smem, int layer, int wg, int nwg) {
    int* rbs = (int*)(smem + SM_TAB); int* cn = rbs + 40;
    moe_table(p, layer, rbs, cn, wg);
    const bf16_t* H2 = WSP(bf16_t, OFF_HREG); const bf16_t* MW = WSP(bf16_t, (layer & 1) ? OFF_WREG : OFF_AD0); bf16_t* HB = WSP(bf16_t, OFF_BB); const int* tokl = WSP(int, OFF_TOKL);
    const size_t WSZ = (size_t)32 * 1024 * 512;
    const int ntot = rbs[32] * 4; const int nfull0 = (ntot / nwg) * nwg, nfull = (ntot - nfull0) * 2 <= nwg ? nfull0 : ntot, nhalf = (ntot - nfull) * 2;
    f32x4 accw[4][8]; f32x4 acc[4][4];
    int e = 0;
    for (int t = wg; t < nfull; t += nwg) {
        const int rbg = t >> 2, cb = t & 3;
        while (rbs[e + 1] <= rbg) ++e;
        const int rb = rbg - rbs[e]; const int nvalid = cn[e] - rb * 128;
        gemm_tile_w(smem, 32, AGather{H2, WSP(bf16_t, OFF_ZERO), tokl + (size_t)e * TOKCAP + rb * 128, nvalid},
                    BW13W{MW + (size_t)e * 1024 * 512 + cb * 128, WSZ}, accw);
        {
            const int l = ltid() & 63, w = ltid() >> 6, wm = w >> 1, wn = w & 1;
#pragma unroll
            for (int mt = 0; mt < 4; ++mt)
#pragma unroll
                for (int np = 0; np < 2; ++np) {
                    const int row = wm * 64 + mt * 16 + (l & 15), hcol = cb * 128 + wn * 64 + np * 32;
                    f32x4 o0, o1;
#pragma unroll
                    for (int q = 0; q < 4; ++q) { const float x0 = accw[mt][2 * np][q], x1 = accw[mt][2 * np + 1][q]; o0[q] = x0 * sigmoidf_(x0) * accw[mt][2 * np + 4][q]; o1[q] = x1 * sigmoidf_(x1) * accw[mt][2 * np + 5][q]; }
                    st_bf8_pair(HB + ((size_t)rbg * 128 + row) * 512 + hcol, o0, o1, l >> 4);
                }
        }
    }
    for (int u = wg; u < nhalf; u += nwg) {
        const int tw = nfull + (u >> 1), rbg = tw >> 2, cb = (tw & 3) * 2 + (u & 1);
        while (rbs[e + 1] <= rbg) ++e;
        const int rb = rbg - rbs[e]; const int nvalid = cn[e] - rb * 128;
        gemm_tile(smem, 16, AGather{H2, WSP(bf16_t, OFF_ZERO), tokl + (size_t)e * TOKCAP + rb * 128, nvalid},
                  BW13{MW + (size_t)e * 1024 * 512 + cb * 64, WSZ}, acc);
        {
            const int l = ltid() & 63, w = ltid() >> 6, wm = w >> 1, wn = w & 1;
#pragma unroll
            for (int mt = 0; mt < 4; ++mt)
                {
                    const int row = wm * 64 + mt * 16 + (l & 15), hcol = cb * 64 + wn * 32;
                    f32x4 o0, o1;
#pragma unroll
                    for (int q = 0; q < 4; ++q) { const float x0 = acc[mt][0][q], x1 = acc[mt][1][q]; o0[q] = x0 * sigmoidf_(x0) * acc[mt][2][q]; o1[q] = x1 * sigmoidf_(x1) * acc[mt][3][q]; }
                    st_bf8_pair(HB + ((size_t)rbg * 128 + row) * 512 + hcol, o0, o1, l >> 4);
                }
        }
    }
}
__device__ __forceinline__ void phase_moe2(const Params& p, char* smem, int layer, int wg, int nwg) {
    int* rbs = (int*)(smem + SM_TAB); int* cn = rbs + 40;
    moe_table(p, layer, rbs, cn, wg);
    const bf16_t* MW2 = WSP(bf16_t, OFF_W2); const bf16_t* HB = WSP(bf16_t, OFF_BB); bf16_t* YM = WSP(bf16_t, OFF_PREG);
    const int ntot = rbs[32] * 4; const int nfull0 = (ntot / nwg) * nwg, nfull = (ntot - nfull0) * 2 <= nwg ? nfull0 : ntot, nhalf = (ntot - nfull) * 2;
    f32x4 accw[4][8]; f32x4 acc[4][4];
    int e = 0;
    for (int t = wg; t < nfull; t += nwg) {
        const int rbg = t >> 2, nt4 = t & 3;
        while (rbs[e + 1] <= rbg) ++e;
        gemm_tile_w(smem, 16, APlain{HB, 512, rbg * 128}, BPlain{MW2 + (size_t)e * 512 * 1024 + nt4 * 256, 1024}, accw);
        EPI_FORW2(accw, { st_bf8_pair(YM + ((size_t)rbg * 128 + row) * 1024 + nt4 * 256 + pcol, va, vb, g); });
    }
    for (int u = wg; u < nhalf; u += nwg) {
        const int tw = nfull + (u >> 1), rbg = tw >> 2, nt8 = (tw & 3) * 2 + (u & 1);
        while (rbs[e + 1] <= rbg) ++e;
        gemm_tile(smem, 8, APlain{HB, 512, rbg * 128}, BPlain{MW2 + (size_t)e * 512 * 1024 + nt8 * 128, 1024}, acc);
        EPI_FOR2(acc, { st_bf8_pair(YM + ((size_t)rbg * 128 + row) * 1024 + nt8 * 128 + pcol, va, vb, g); });
    }
}

__device__ __forceinline__ void phase_e3p(const Params& p, char* smem, int j, int nrows, int wg, int nwg) {
    const int tid = ltid(), lane = tid & 63, wv = __builtin_amdgcn_readfirstlane(tid >> 6);
    const bf16_t* P = WSP(bf16_t, OFF_PREG);
    bf16_t* R = WSP(bf16_t, OFF_RKVK); bf16_t* K = R + (size_t)NT * 512; bf16_t* V = K + (size_t)NT * 512;
    bf16_t* DIFF = WSP(bf16_t, OFF_DIFF);
    const int c = 8 * lane, q = lane >> 4;
    const int rstep = nwg * 4;
    int r0 = wg * 4;
    if (r0 >= nrows) return;
    const int r0last = r0 + ((nrows - 1 - r0) / rstep) * rstep;
    f32x4 mu[3][2];
#pragma unroll
    for (int n = 0; n < 3; ++n) { mu[n][0] = *(const f32x4*)(p.mu_p + (size_t)(j * 3 + n) * 512 + c); mu[n][1] = *(const f32x4*)(p.mu_p + (size_t)(j * 3 + n) * 512 + c + 4); }
    const unsigned ldsb = (unsigned)__builtin_amdgcn_readfirstlane((int)(unsigned)(size_t)smem);
    constexpr int STG = 20 * 1024;
    auto stage = [&](int rr0, int buf) {
        int t0, T, base;
        if (rr0 < NL) { t0 = rr0 & 8191; T = 8192; base = rr0 - t0; } else { t0 = (rr0 - NL) & 255; T = 256; base = rr0 - t0; }
#pragma unroll
        for (int i5 = 0; i5 < 5; ++i5) { const int i = wv + 4 * i5; const int tt = min(max(t0 - 8 + i, 0), T - 1);
            glds16_asm(P + (size_t)(base + tt) * 2048 + 1536 + c, ldsb + buf * STG + i * 1024); }
    };
    u32x4 pa_[2][3], pb_[2][3];
#define E3_LOADMIX(S, rr0) do { const int r_ = (rr0) + wv; const int s_ = shift_src(r_, q); const int sc_ = s_ >= 0 ? s_ : r_; \
        _Pragma("unroll") for (int n = 0; n < 3; ++n) { pa_[S][n] = *(const u32x4*)(P + (size_t)r_ * 2048 + n * 512 + c); pb_[S][n] = *(const u32x4*)(P + (size_t)sc_ * 2048 + n * 512 + c); } } while (0)
    __syncthreads();
    stage(r0, 0); E3_LOADMIX(0, r0);
    asm volatile("s_waitcnt vmcnt(0)" ::: "memory");
    bool first = true;
    while (r0 < nrows) {
#pragma unroll
      for (int Pq = 0; Pq < 2; ++Pq) {
        if (r0 >= nrows) break;
        if (!first) asm volatile("s_waitcnt vmcnt(4)" ::: "memory");
        first = false;
        __syncthreads();
        { const int rn = min(r0 + rstep, r0last); stage(rn, 1 - Pq); E3_LOADMIX(1 - Pq, rn); }
        __builtin_amdgcn_sched_barrier(0);
        const int r = r0 + wv;
        const int s = shift_src(r, q);
        float val[3][8];
#pragma unroll
        for (int n = 0; n < 3; ++n) {
            const u32x4 a = pa_[Pq][n]; u32x4 b = pb_[Pq][n];
            if (s < 0) b = (u32x4){0u, 0u, 0u, 0u};
#pragma unroll
            for (int e = 0; e < 4; ++e) {
                const float pa0 = bflo(a[e]), pa1 = bfhi(a[e]), pb0 = bflo(b[e]), pb1 = bfhi(b[e]);
                const float mu0 = mu[n][(2 * e) >> 2][(2 * e) & 3], mu1 = mu[n][(2 * e + 1) >> 2][(2 * e + 1) & 3];
                val[n][2 * e] = pa0 + (pb0 - pa0) * mu0; val[n][2 * e + 1] = pa1 + (pb1 - pa1) * mu1;
            }
        }
        u32x4 o;
#pragma unroll
        for (int e = 0; e < 4; ++e) o[e] = pk2(val[0][2 * e], val[0][2 * e + 1]);
        *(u32x4*)(R + (size_t)r * 512 + c) = o;
#pragma unroll
        for (int e = 0; e < 4; ++e) o[e] = pk2(val[1][2 * e], val[1][2 * e + 1]);
        *(u32x4*)(K + (size_t)r * 512 + c) = o;
#pragma unroll
        for (int e = 0; e < 4; ++e) o[e] = pk2(val[2][2 * e], val[2][2 * e + 1]);
        *(u32x4*)(V + (size_t)r * 512 + c) = o;
        int t, T;
        if (r < NL) { t = r & 8191; T = 8192; } else { t = (r - NL) & 255; T = 256; }
        const int half = 1 << q; const int lo = max(t - half, 0), hi = min(t + half, T);
        const char* sp = smem + Pq * STG + wv * 1024 + lane * 16;
        float sum[8];
#pragma unroll
        for (int e = 0; e < 8; ++e) sum[e] = 0.f;
#pragma unroll
        for (int i = 0; i < 16; ++i) { const int tt = t + i - 8; const bool ok = tt >= lo && tt < hi; const u32x4 w = *(const u32x4*)(sp + i * 1024);
#pragma unroll
            for (int e = 0; e < 4; ++e) { sum[2 * e] += ok ? bflo(w[e]) : 0.f; sum[2 * e + 1] += ok ? bfhi(w[e]) : 0.f; } }
        const float inv = 1.0f / (float)(hi - lo);
        const u32x4 u = *(const u32x4*)(sp + 8 * 1024);
#pragma unroll
        for (int e = 0; e < 4; ++e) o[e] = pk2(sum[2 * e] * inv - bflo(u[e]), sum[2 * e + 1] * inv - bfhi(u[e]));
        *(u32x4*)(DIFF + (size_t)r * 512 + c) = o;
        r0 += rstep;
      }
    }
#undef E3_LOADMIX
    asm volatile("s_waitcnt vmcnt(0)" ::: "memory");
    __syncthreads();
}

__device__ __forceinline__ void phase_e4z(const Params& p, char* smem, int j, int nrows, int wg, int nwg) {
    const int tid = ltid(), lane = tid & 63, wid = tid >> 6, wm = wid >> 1, wn = wid & 1;
    const bf16_t* LR1 = WSP(bf16_t, OFF_LR1); bf16_t* KD = WSP(bf16_t, OFF_KD); bf16_t* BB = WSP(bf16_t, OFF_BB);
    const bf16_t* WL2 = (const bf16_t*)(p.ws + OFF_WTS + W_LR2) + (size_t)j * 384 * 512;
    const int ntot = (nrows / 128) * 16;
    if (wg >= ntot) return;
    const int u = wg & 15, ob = u >> 2, n0 = (u & 3) * 128, koff = ob * 64;
    const int nmy = (ntot - wg + nwg - 1) / nwg;
    const int arow = tid >> 3, akc = (((tid & 7) ^ (arow & 7)) << 3), brow = tid >> 4, bnc = (((tid & 15) ^ bswz(brow)) << 3);
    const unsigned lds0 = (unsigned)__builtin_amdgcn_readfirstlane((int)((unsigned)(size_t)smem + (unsigned)(wid * 1024)));
    constexpr int EZ_B = 3 * G_ABYTES, EZ_BIAS = 65536;
    __syncthreads();
    {
        const bf16_t* bsrc = WL2 + (size_t)koff * 512 + n0;
#pragma unroll
        for (int i = 0; i < 4; ++i) glds16_asm(bsrc + (size_t)(brow + 16 * i) * 512 + bnc, lds0 + EZ_B + i * 4096);
        if (tid < 128) ((float*)(smem + EZ_BIAS))[tid] = (ob < 2 ? p.decay_w0 + (size_t)(j * 2 + ob) * 512 : p.lr_a0 + (size_t)(j * 2 + ob - 2) * 512)[n0 + tid];
    }
    auto issueA = [&](int i, int buf) {
        const int m0 = ((wg + i * nwg) >> 4) * 128;
#pragma unroll
        for (int q = 0; q < 4; ++q) glds16_asm(LR1 + (size_t)(m0 + arow + 32 * q) * 384 + koff + akc, lds0 + buf * G_ABYTES + q * 4096);
    };
    issueA(0, 0); issueA(min(1, nmy - 1), 1);
    const int ar = wm * 64 + (lane & 15), ax = lane & 7, ag = lane >> 4;
    const int bg = lane >> 4, bq = (lane & 15) >> 2, bp = lane & 3;
    bf16_t* outp = ob < 2 ? KD + (size_t)ob * NT * 512 : BB + (size_t)(ob - 2) * NT * 512;
    int buf = 0;
    for (int i = 0; i < nmy; ++i) {
        if (i == 0) asm volatile("s_waitcnt vmcnt(4)" ::: "memory"); else asm volatile("s_waitcnt vmcnt(12)" ::: "memory");
        __syncthreads();
        { int b2 = buf + 2; if (b2 >= 3) b2 -= 3; issueA(min(i + 2, nmy - 1), b2); }
        const char* sa = smem + buf * G_ABYTES; const char* sb = smem + EZ_B;
        f32x4 acc[4][4];
#pragma unroll
        for (int a_ = 0; a_ < 4; ++a_)
#pragma unroll
            for (int b_ = 0; b_ < 4; ++b_) acc[a_][b_] = (f32x4){0.f, 0.f, 0.f, 0.f};
#pragma unroll
        for (int ks = 0; ks < 2; ++ks) {
            bf16x8 a[4], b[4];
#pragma unroll
            for (int mt = 0; mt < 4; ++mt) a[mt] = *(const bf16x8*)(sa + (ar + mt * 16) * 128 + (((4 * ks + ag) ^ ax) << 4));
#pragma unroll
            for (int nt = 0; nt < 4; ++nt) {
                const int c2 = 2 * (wn * 4 + nt) + (bp >> 1);
                const int k0 = 32 * ks + 8 * bg + bq, k1 = k0 + 4;
                const s16x4 lo = __builtin_amdgcn_ds_read_tr16_b64_v4i16((LAS s16x4*)(sb + k0 * 256 + ((c2 ^ bswz(k0)) << 4) + 8 * (bp & 1)));
                const s16x4 hi = __builtin_amdgcn_ds_read_tr16_b64_v4i16((LAS s16x4*)(sb + k1 * 256 + ((c2 ^ bswz(k1)) << 4) + 8 * (bp & 1)));
                b[nt] = __builtin_shufflevector(lo, hi, 0, 1, 2, 3, 4, 5, 6, 7);
            }
#pragma unroll
            for (int mt = 0; mt < 4; ++mt)
#pragma unroll
                for (int nt = 0; nt < 4; ++nt) acc[mt][nt] = __builtin_amdgcn_mfma_f32_16x16x32_bf16(b[nt], a[mt], acc[mt][nt], 0, 0, 0);
        }
        const int m0 = ((wg + i * nwg) >> 4) * 128;
        if (ob < 2) {
            EPI_FOR2(acc, { const f32x4 ba = *(const f32x4*)(smem + EZ_BIAS + (pcol + 4 * g) * 4), bb = *(const f32x4*)(smem + EZ_BIAS + (pcol + 16 + 4 * g) * 4); f32x4 oa, ob;
                _Pragma("unroll") for (int e = 0; e < 4; ++e) { oa[e] = va[e] + ba[e]; ob[e] = vb[e] + bb[e]; }
                st_bf8_pair(outp + (size_t)(m0 + row) * 512 + n0 + pcol, oa, ob, g); });
        } else {
            EPI_FOR2(acc, { const f32x4 ba = *(const f32x4*)(smem + EZ_BIAS + (pcol + 4 * g) * 4), bb = *(const f32x4*)(smem + EZ_BIAS + (pcol + 16 + 4 * g) * 4); f32x4 oa, ob;
                _Pragma("unroll") for (int e = 0; e < 4; ++e) { oa[e] = sigmoidf_(va[e] + ba[e]); ob[e] = sigmoidf_(vb[e] + bb[e]); }
                st_bf8_pair(outp + (size_t)(m0 + row) * 512 + n0 + pcol, oa, ob, g); });
        }
        if (++buf == 3) buf = 0;
    }
    asm volatile("s_waitcnt vmcnt(0)" ::: "memory");
    __syncthreads();
}

template <int PH>
__device__ __forceinline__ void do_phase(const Params& pin, char* smem, int layer, int wg, int nwg) {
    Params p = pin; { size_t zoff = 0; asm volatile("" : "+s"(zoff)); p.ws = pin.ws + zoff; } asm volatile("" : "+s"(layer));
    const int j = layer >> 1;
    const bool ctx_in = layer <= 2, ctx_out = layer < 2;
    const int rows_in = ctx_in ? NT : NL, rows_out = ctx_out ? NT : NL;
    const char* wts = p.ws + OFF_WTS;
    if constexpr (PH == PH_PROLOGUE) phase_prologue(p, smem, wg, nwg);
    else if constexpr (PH == PH_MOD_MIX) { if (layer == 0) phase_modpipe<0, false>(p, layer, rows_in, wg, nwg); else phase_modpipe<0, true>(p, layer, rows_in, wg, nwg); }
    else if constexpr (PH == PH_E2) phase_e2(p, smem, j, rows_in, layer, wg, nwg);
    else if constexpr (PH == PH_E3) { phase_e3p(p, smem, j, rows_in, wg, nwg); if ((nwg & 15) == 0) phase_e4z(p, smem, j, rows_in, wg, nwg); else phase_e4(p, smem, j, rows_in, 0, wg, nwg); }
    else if constexpr (PH == PH_E4) phase_e4(p, smem, j, rows_in, 0, wg, nwg);
    else if constexpr (PH == PH_SCAN) phase_scan<0>(p, smem, wg, nwg);
    else if constexpr (PH == PH_SCANV) phase_scan<SCANVAR>(p, smem, wg, nwg);
    else if constexpr (PH == PH_POST) phase_post<CHUNKED>(p, j, rows_out, wg, nwg);
    else if constexpr (PH == PH_S1A) phase_s1(p, smem, j, 0, wg, nwg);
    else if constexpr (PH == PH_S2A) { if (nwg <= 128) { phase_s2(p, smem, 0, wg, nwg); phase_s1(p, smem, j, 1, wg, nwg); } else if (wg < 128) phase_s2(p, smem, 0, wg, nwg); else phase_s1(p, smem, j, 1, wg - 128, nwg - 128); }
    else if constexpr (PH == PH_S2B) { if (nwg <= 128) { phase_s2(p, smem, 1, wg, nwg); phase_e4(p, smem, j, rows_in, 1, wg, nwg); moe_convert(p, layer, wg, nwg); } else {
            const size_t nx = (size_t)(nwg - 128) * 256, gs_ = nx + (size_t)128 * 192;
            if (wg < 128) { phase_s2(p, smem, 1, wg, nwg); const int wv_ = ltid() >> 6; if (wv_ != 0) moe_convert_idx(p, layer, nx + (size_t)wg * 192 + (wv_ - 1) * 64 + (ltid() & 63), gs_); }
            else { phase_e4(p, smem, j, rows_in, 1, wg - 128, nwg - 128); moe_convert_idx(p, layer, (size_t)(wg - 128) * 256 + ltid(), gs_); } } }
    else if constexpr (PH == PH_WOUT) phase_resgemm(p, smem, WSP(bf16_t, OFF_HREG), (const bf16_t*)(wts + W_WOUT) + (size_t)j * 1024 * 1024, layer, rows_out, wg, nwg);
    else if constexpr (PH == PH_F1) phase_f1(p, smem, rows_out, wg, nwg);
    else if constexpr (PH == PH_F2) phase_f2(p, smem, ctx_out, wg, nwg);
    else if constexpr (PH == PH_F3) phase_f3_ring(p, smem, wg, nwg);
    else if constexpr (PH == PH_WF) phase_resgemm(p, smem, WSP(bf16_t, OFF_RKVK), (const bf16_t*)(wts + W_WF) + (size_t)j * 1024 * 1024, layer, rows_out, wg, nwg);
    else if constexpr (PH == PH_FFNR) { phase_ffn_route(p, smem, layer, rows_out, wg, nwg); if (layer & 1) moe_convert(p, layer, wg, nwg); }
    else if constexpr (PH == PH_MOD_FFN) phase_modulate<1>(p, layer, rows_out, false, false, wg, nwg);
    else if constexpr (PH == PH_ROUTER) phase_router<0>(p, smem, layer, rows_out, wg, nwg);
    else if constexpr (PH == PH_ROUTERV) phase_router<1>(p, smem, layer, rows_out, wg, nwg);
    else if constexpr (PH == PH_WOUTV) phase_resgemm<1>(p, smem, WSP(bf16_t, OFF_HREG), (const bf16_t*)(wts + W_WOUT) + (size_t)j * 1024 * 1024, layer, rows_out, wg, nwg);
    else if constexpr (PH == PH_MOE1) phase_moe1(p, smem, layer, wg, nwg);
    else if constexpr (PH == PH_MOE2) phase_moe2(p, smem, layer, wg, nwg);
    else if constexpr (PH == PH_FINAL) phase_modpipe<2, true>(p, 4, NL, wg, nwg);
}

#if MEGA
#ifndef PROF
#define PROF 0
#endif
#if PROF
#define PH_RUN(PHID, CAT) do { const unsigned long long _t0 = wall_clock64(); do_phase<PHID>(p, smem, layer, wg, nwg); xcd_barrier(bar); if ((CAT) == PROF || PROF == 99) tacc += wall_clock64() - _t0; } while (0)
#else
#ifndef DUP_CAT
#define DUP_CAT 0
#endif
#define PH_RUN(PHID, CAT) do { do_phase<PHID>(p, smem, layer, wg, nwg); xcd_barrier(bar); if ((CAT) == DUP_CAT) { do_phase<((PHID) == PH_SCAN ? PH_SCANV : (PHID) == PH_ROUTER ? PH_ROUTERV : (PHID) == PH_WOUT ? PH_WOUTV : (PHID))>(p, smem, layer, wg, nwg); xcd_barrier(bar); } } while (0)
#endif
__global__ void __launch_bounds__(256, 2) k_mega(Params p) {
    extern __shared__ __attribute__((aligned(16))) char smem[];
    if (threadIdx.x == 0) *(u32x4*)(smem + SM_BAR) = (u32x4){0u, 0u, 0u, 0u};
    __syncthreads();
    XcdBarrier bar = xcd_barrier_post(WSP(unsigned, OFF_BAR), (volatile LAS unsigned*)(smem + SM_BAR));
    const int wg = blockIdx.x, nwg = gridDim.x;
#if PROF
    unsigned long long tacc = 0;
#endif
    { int layer = 0; PH_RUN(PH_PROLOGUE, 1); }
    for (int layer = 0; layer < 4; ++layer) {
        PH_RUN(PH_MOD_MIX, 2);
        if ((layer & 1) == 0) {
            PH_RUN(PH_E2, 3); PH_RUN(PH_E3, 4);
#if CHUNKED
            PH_RUN(PH_S1A, 16); PH_RUN(PH_S2A, 17); PH_RUN(PH_S2B, 18);
#else
            PH_RUN(PH_SCAN, 6);
#endif
            PH_RUN(PH_POST, 7); PH_RUN(PH_WOUT, 8);
        } else {
            PH_RUN(PH_F1, 9); PH_RUN(PH_F2, 10); PH_RUN(PH_F3, 11); PH_RUN(PH_WF, 8);
        }
        PH_RUN(PH_FFNR, 12); PH_RUN(PH_MOE1, 14); PH_RUN(PH_MOE2, 15);
    }
#if PROF
    {
        float* slot = (float*)(p.ws + OFF_POFF + 2048);
        if (wg == 0 && threadIdx.x == 0) *slot = rintf(logf((float)tacc * 0.01f) * 20.f) * 0.05f;
        xcd_barrier(bar);
        const float c = *slot;
        for (size_t i = (size_t)wg * 256 + threadIdx.x; i < (size_t)NL * 1024; i += (size_t)nwg * 256) p.out[i] = c;
    }
#else
    do_phase<PH_FINAL>(p, smem, 4, wg, nwg);
#endif
}
#else
template <int PH>
__global__ void __launch_bounds__(256, 2) k_phase(Params p, int layer) {
    extern __shared__ __attribute__((aligned(16))) char smem[];
    do_phase<PH>(p, smem, layer, blockIdx.x, gridDim.x);
}
template <int PH> static void launch_phase(const Params& p, int layer, hipStream_t stream) {
    static bool attr = false;
    if (!attr) { (void)hipFuncSetAttribute((const void*)k_phase<PH>, hipFuncAttributeMaxDynamicSharedMemorySize, SMEM_BYTES); attr = true; }
    hipLaunchKernelGGL(k_phase<PH>, dim3(512), dim3(256), SMEM_BYTES, stream, p, layer);
}
#endif


#if DIAG >= 2
__global__ void k_census(Params p, int what) {
}
__global__ void k_census1(char* ws, size_t off, size_t nbytes, int isf32, int idx) {
    const unsigned* u = (const unsigned*)(ws + off); const size_t n = nbytes / 4; bool bad = false;
    for (size_t i = (size_t)blockIdx.x * 256 + threadIdx.x; i < n; i += (size_t)gridDim.x * 256) {
        const unsigned x = u[i];
        if (isf32) { if ((x & 0x7f800000u) >= (141u << 23)) bad = true; }
        else { if ((x & 0x7f80u) >= (141u << 7) || (x & 0x7f800000u) >= (141u << 23)) bad = true; }
    }
    if (bad) atomicOr((unsigned*)(ws + OFF_CNT) + 192, 1u << idx);
}
__global__ void k_report(Params p) {
    const unsigned f = *((const unsigned*)(p.ws + OFF_CNT) + 192);
    int idx = 0; for (int b = 1; b < 32; ++b) if (f & (1u << b)) { idx = b; break; }
    const float c = sqrtf(0.5f * (float)idx);
    for (size_t i = (size_t)blockIdx.x * 256 + threadIdx.x; i < (size_t)NL * 1024; i += (size_t)gridDim.x * 256) p.out[i] = c;
}
#endif

#if DIAG == 3
__global__ void __launch_bounds__(256, 2) k_gemmtest(Params p) {
    extern __shared__ __attribute__((aligned(16))) char smem[];
    bf16_t* A = WSP(bf16_t, OFF_PREG); bf16_t* B = A + 128 * 128; float* C = (float*)(B + 128 * 128);
    unsigned* cnt = (unsigned*)(p.ws + OFF_CNT) + 192;
    const int tid = threadIdx.x;
    for (int i = tid; i < 128 * 128; i += 256) { const int m = i >> 7, k = i & 127; A[i] = f2bf((float)(((m * 7 + k * 3) % 9) - 4)); B[i] = f2bf((float)(((m * 5 + k * 11) % 7) - 3)); }
    __threadfence(); __syncthreads();
    f32x4 acc[4][4];
    gemm_tile(smem, 2, APlain{A, 128, 0}, BPlain{B, 128}, acc);
    EPI_FOR(acc, { *(f32x4*)(C + (size_t)row * 128 + col) = v; });
    __threadfence(); __syncthreads();
    unsigned bad = 0, nonfin = 0, tr = 0;
    for (int i = tid; i < 128 * 128; i += 256) { const int m = i >> 7, n = i & 127; float s = 0.f, st = 0.f;
        for (int k = 0; k < 128; ++k) { s += bf2f(A[m * 128 + k]) * bf2f(B[k * 128 + n]); st += bf2f(A[n * 128 + k]) * bf2f(B[k * 128 + m]); }
        const float c = C[i]; if (c != s) ++bad; if (!(fabsf(c) < 3e38f)) ++nonfin; if (c == st) ++tr; }
    atomicAdd(cnt + 1, bad); atomicAdd(cnt + 2, nonfin); atomicAdd(cnt + 3, tr);
}
__global__ void k_report3(Params p) {
    const unsigned* cnt = (const unsigned*)(p.ws + OFF_CNT) + 192;
    float c2 = 8.f * (float)cnt[1] / 16384.f; if (cnt[2]) c2 += 20.f; if (cnt[3] > 8000) c2 += 50.f;
    const float c = sqrtf(c2);
    for (size_t i = (size_t)blockIdx.x * 256 + threadIdx.x; i < (size_t)NL * 1024; i += (size_t)gridDim.x * 256) p.out[i] = c;
}
#endif

#if DIAG == 4 || DIAG == 5
__device__ __forceinline__ bool close_(float a, float b, float tol) { return fabsf(a - b) <= tol * (1.f + fabsf(b)); }
__global__ void k_check(Params p) {
    unsigned* flag = (unsigned*)(p.ws + OFF_CNT) + 192;
    const float* mod = WSP(float, OFF_MOD); const bf16_t* H = WSP(bf16_t, OFF_HREG); const bf16_t* P = WSP(bf16_t, OFF_PREG); const bf16_t* LR1 = WSP(bf16_t, OFF_LR1);
    const bf16_t* WIN = (const bf16_t*)(p.ws + OFF_WTS + W_WIN); const bf16_t* WL1 = (const bf16_t*)(p.ws + OFF_WTS + W_LR1);
    const size_t gt = (size_t)blockIdx.x * 256 + threadIdx.x, gs = (size_t)gridDim.x * 256;
    unsigned bad = 0;
    for (size_t i = gt; i < 5 * 6144; i += gs) { const int mb = (int)(i / 6144), n = (int)(i % 6144); float s = 0.f;
        for (int k = 0; k < 1024; ++k) { const float cv = mb < 4 ? p.c[mb * 1024 + k] : p.c_ctx[k]; s += cv / (1.f + expf(-cv)) * p.ada_w[(size_t)k * 6144 + n]; }
        s += p.ada_b[n]; if (!close_(mod[(size_t)(mb * 4) * 6144 + n], s, 1e-3f)) bad |= 1u; }
    { const int rows[6] = {0, 1, 8191, 8192, NL, NT - 1};
      for (size_t i = gt; i < 6 * 1024; i += gs) { const int r = rows[i >> 10], c = (int)(i & 1023); const float* xr = r < NL ? p.x + (size_t)r * 1024 : p.ctx + (size_t)(r - NL) * 1024;
        float ss = 0.f; for (int k = 0; k < 1024; ++k) ss += xr[k] * xr[k]; const float rinv = 1.f / sqrtf(ss / 1024.f + 1e-6f); const int mb = r < NL ? r >> 13 : 4;
        const float h = xr[c] * rinv * p.norm_mix[c] * (1.f + mod[(size_t)(mb * 4) * 6144 + 1024 + c]) + mod[(size_t)(mb * 4) * 6144 + c];
        if (!close_(bf2f(H[(size_t)r * 1024 + c]), h, 2e-2f)) bad |= 2u; } }
    for (size_t i = gt; i < (size_t)1024 * 2048; i += gs) if (!close_(bf2f(WIN[i]), p.w_in[i], 1e-2f)) bad |= 4u;
    { const int rows[6] = {0, 1, 127, 128, 5000, NT - 1};
      for (size_t i = gt; i < 6 * 2048; i += gs) { const int r = rows[i >> 11], n = (int)(i & 2047); float s = 0.f;
        for (int k = 0; k < 1024; ++k) s += bf2f(H[(size_t)r * 1024 + k]) * bf2f(WIN[(size_t)k * 2048 + n]);
        if (!close_(bf2f(P[(size_t)r * 2048 + n]), s, 2e-2f)) bad |= 8u; } }
    { const int rows[6] = {0, 1, 63, 64, 8191, NT - 1};
      for (size_t i = gt; i < 6 * 384; i += gs) { const int r = rows[i / 384], n = (int)(i % 384); float s = 0.f;
        for (int k = 0; k < 1024; ++k) s += bf2f(H[(size_t)r * 1024 + k]) * bf2f(WL1[(size_t)k * 384 + n]);
        for (int k = 0; k < 1024; ++k) { const int sr = shift_src(r, k >> 8); if (sr >= 0) s += bf2f(H[(size_t)sr * 1024 + k]) * bf2f(WL1[(size_t)(1024 + k) * 384 + n]); }
        const float a = n < 128 ? tanhf(s) : (n < 256 ? s : 1.f / (1.f + expf(-s)));
        if (!close_(bf2f(LR1[(size_t)r * 384 + n]), a, 2e-2f)) bad |= 16u; } }
    if (bad) atomicOr(flag, bad);
}
__global__ void k_report4(Params p) {
    const unsigned f = *((const unsigned*)(p.ws + OFF_CNT) + 192);
    const float c = sqrtf(0.25f * (float)f);
    for (size_t i = (size_t)blockIdx.x * 256 + threadIdx.x; i < (size_t)NL * 1024; i += (size_t)gridDim.x * 256) p.out[i] = c;
}
#endif

#if DIAG == 5
__global__ void __launch_bounds__(256, 2) k_projtest(Params p) {
    extern __shared__ __attribute__((aligned(16))) char smem[];
    const bf16_t* H = WSP(bf16_t, OFF_HREG); const bf16_t* WIN = (const bf16_t*)(p.ws + OFF_WTS + W_WIN);
    float* C = WSP(float, OFF_PREG) + (size_t)blockIdx.x * 128 * 128;
    unsigned* flag = (unsigned*)(p.ws + OFF_CNT) + 192;
    const int m0s[4] = {0, 0, 128 * 263, 128 * 100}, n0s[4] = {0, 1920, 0, 640};
    const int m0 = m0s[blockIdx.x], n0 = n0s[blockIdx.x];
    f32x4 acc[4][4];
    gemm_tile(smem, 16, APlain{H, 1024, m0}, BPlain{WIN + n0, 2048}, acc);
    EPI_FOR(acc, { *(f32x4*)(C + (size_t)row * 128 + col) = v; });
    __threadfence(); __syncthreads();
    unsigned bad = 0;
    for (int i = threadIdx.x; i < 128 * 128; i += 256) { const int m = i >> 7, n = i & 127; float s = 0.f;
        for (int k = 0; k < 1024; ++k) s += bf2f(H[(size_t)(m0 + m) * 1024 + k]) * bf2f(WIN[(size_t)k * 2048 + n0 + n]);
        if (!(fabsf(C[i] - s) <= 1e-2f * (1.f + fabsf(s)))) bad = 1; }
    if (bad) atomicOr(flag, 1u << blockIdx.x);
}
#endif

extern "C" void kernel_launch(void* const* d_in, const int* in_sizes, int n_in, void* d_out, int out_size, void* d_ws, size_t ws_size, hipStream_t stream) {
    if (n_in != 36 || ws_size < WS_END) { fprintf(stderr, "kernel_launch: unexpected n_in %d or workspace %zu < %zu\n", n_in, ws_size, (size_t)WS_END); return; }
    Params p{};
    const float** pf = (const float**)&p;
    for (int i = 0; i < 36; ++i) pf[i] = (const float*)d_in[i];
    p.out = (float*)d_out; p.ws = (char*)d_ws;
    (void)hipMemsetAsync(d_ws, 0, ZERO_REGION, stream);
#if MEGA
    static int grid = 0;
    if (grid == 0) {
        int dev = 0, cus = 0, per_cu = 0;
        (void)hipGetDevice(&dev); (void)hipDeviceGetAttribute(&cus, hipDeviceAttributeMultiprocessorCount, dev);
        (void)hipFuncSetAttribute((const void*)k_mega, hipFuncAttributeMaxDynamicSharedMemorySize, SMEM_BYTES);
        (void)hipOccupancyMaxActiveBlocksPerMultiprocessor(&per_cu, (const void*)k_mega, 256, SMEM_BYTES);
        (void)hipGetLastError();
        if (per_cu < 1) per_cu = 1;
        grid = cus * (per_cu < 2 ? per_cu : 2);
    }
    hipLaunchKernelGGL(k_mega, dim3(grid), dim3(256), SMEM_BYTES, stream, p);
#else
#if DIAG == 1
    launch_phase<PH_MOD_MIX>(p, 0, stream); launch_phase<PH_FINAL>(p, 4, stream); return;
#endif
#if DIAG == 5
    launch_phase<PH_PROLOGUE>(p, 0, stream); launch_phase<PH_MOD_MIX>(p, 0, stream);
    (void)hipFuncSetAttribute((const void*)k_projtest, hipFuncAttributeMaxDynamicSharedMemorySize, SMEM_BYTES);
    hipLaunchKernelGGL(k_projtest, dim3(4), dim3(256), SMEM_BYTES, stream, p);
    hipLaunchKernelGGL(k_report4, dim3(1024), dim3(256), 0, stream, p); return;
#endif
#if DIAG == 4
    launch_phase<PH_PROLOGUE>(p, 0, stream); launch_phase<PH_MOD_MIX>(p, 0, stream); launch_phase<PH_E2>(p, 0, stream);
    hipLaunchKernelGGL(k_check, dim3(512), dim3(256), 0, stream, p);
    hipLaunchKernelGGL(k_report4, dim3(1024), dim3(256), 0, stream, p); return;
#endif
#if DIAG == 3
    (void)hipFuncSetAttribute((const void*)k_gemmtest, hipFuncAttributeMaxDynamicSharedMemorySize, SMEM_BYTES);
    hipLaunchKernelGGL(k_gemmtest, dim3(1), dim3(256), SMEM_BYTES, stream, p);
    hipLaunchKernelGGL(k_report3, dim3(1024), dim3(256), 0, stream, p); return;
#endif
#if DIAG == 2
#define CEN(off, bytes, isf, idx) hipLaunchKernelGGL(k_census1, dim3(1024), dim3(256), 0, stream, p.ws, (size_t)(off), (size_t)(bytes), isf, idx)
    launch_phase<PH_PROLOGUE>(p, 0, stream); launch_phase<PH_MOD_MIX>(p, 0, stream);
    CEN(OFF_MOD, 491520, 1, 1); CEN(OFF_HREG, (size_t)NT * 2048, 0, 2); CEN(OFF_WTS, W_END, 0, 3);
    launch_phase<PH_E2>(p, 0, stream);
    CEN(OFF_PREG, (size_t)NT * 4096, 0, 4); CEN(OFF_LR1, (size_t)NT * 768, 0, 5);
    launch_phase<PH_E3>(p, 0, stream);
    CEN(OFF_RKVK, (size_t)NT * 1024, 0, 6); CEN(OFF_RKVK + (size_t)NT * 1024, (size_t)NT * 1024, 0, 7); CEN(OFF_RKVK + (size_t)NT * 2048, (size_t)NT * 1024, 0, 8);
    CEN(OFF_RKVK + (size_t)NT * 3072, (size_t)NT * 1024, 0, 9); CEN(OFF_DIFF, (size_t)NT * 1024, 0, 10);
    launch_phase<PH_E4>(p, 0, stream);
    CEN(OFF_WREG, (size_t)NT * 4096, 1, 11); CEN(OFF_KD, (size_t)NT * 2048, 0, 12); CEN(OFF_BB, (size_t)NT * 2048, 0, 13); CEN(OFF_G, (size_t)NT * 1024, 0, 14);
    launch_phase<PH_SCAN>(p, 0, stream);
    CEN(OFF_PREG, (size_t)NT * 4096, 1, 15);
    launch_phase<PH_POST>(p, 0, stream);
    CEN(OFF_HREG, (size_t)NT * 2048, 0, 16);
    launch_phase<PH_WOUT>(p, 0, stream);
    CEN(OFF_RES, (size_t)NT * 4096, 1, 17);
    hipLaunchKernelGGL(k_report, dim3(1024), dim3(256), 0, stream, p); return;
#endif
    launch_phase<PH_PROLOGUE>(p, 0, stream);
    for (int layer = 0; layer < 4; ++layer) {
        launch_phase<PH_MOD_MIX>(p, layer, stream);
        if ((layer & 1) == 0) {
            launch_phase<PH_E2>(p, layer, stream); launch_phase<PH_E3>(p, layer, stream); launch_phase<PH_E4>(p, layer, stream);
            launch_phase<PH_SCAN>(p, layer, stream); launch_phase<PH_POST>(p, layer, stream); launch_phase<PH_WOUT>(p, layer, stream);
        } else {
            launch_phase<PH_F1>(p, layer, stream); launch_phase<PH_F2>(p, layer, stream); launch_phase<PH_F3>(p, layer, stream); launch_phase<PH_WF>(p, layer, stream);
        }
        launch_phase<PH_MOD_FFN>(p, layer, stream); launch_phase<PH_ROUTER>(p, layer, stream); launch_phase<PH_MOE1>(p, layer, stream); launch_phase<PH_MOE2>(p, layer, stream);
    }
    launch_phase<PH_FINAL>(p, 4, stream);
#endif
}
```
